# Optimizing an MI355X kernel written in HIP

```python
import math
import jax, jax.numpy as jnp
from jax import lax
import numpy as np

D_MODEL = 1024
BATCH = 8
SEQ = 4096
DEPTH = 4
DEC_BATCH = 4
DEC_SEQ = 8192
PAST_LEN = 128

GRID_W = 64
N_MIXERS = 4
Q_BLOCK = 128
LN_EPS = 1e-5
RMS_EPS = 1e-6
ALPHA = (2.0 * DEPTH) ** 0.25
BETA = (8.0 * DEPTH) ** -0.25

A_HEADS = 16
A_KV_HEADS = 4
A_HEAD_DIM = 64
ROPE_BASE = 10000.0

B_PATTERNS = ((128, 1), (512, 4), (2048, 16))
B_HEADS_PER_GROUP = 4
B_HEADS = B_HEADS_PER_GROUP * len(B_PATTERNS)
B_HEAD_DIM = 64

C_GROUP = 16
C_N_GROUPS = D_MODEL // C_GROUP
C_STATE = 64
C_GROUPS_PER_BLOCK = 8

D_HEADS = 12
D_QK_DIM = 32
D_V_DIM = 64

REL_BUCKETS = 32
REL_MAX_DIST = 128
REL_HEADS = 12

MEM_LEN = 256
X_HEADS = 4
X_HEAD_DIM = D_MODEL // X_HEADS

N_EXPERTS = 16
D_EXPERT = 1024
EC_CAPACITY = 2

N_A = (DEPTH + 3) // N_MIXERS
N_B = (DEPTH + 2) // N_MIXERS
N_C = (DEPTH + 1) // N_MIXERS
N_D = DEPTH // N_MIXERS

kernel_name = 'hybrid_bidir_encoder_two_groups'


def _layer_norm(x, g, b):
    xf = x.astype(jnp.float32)
    mu = jnp.mean(xf, -1, keepdims=True)
    var = jnp.mean(jnp.square(xf - mu), -1, keepdims=True)
    return ((xf - mu) * lax.rsqrt(var + LN_EPS) * g + b).astype(x.dtype)


def _rms_norm(x, g):
    xf = x.astype(jnp.float32)
    return (xf * lax.rsqrt(jnp.mean(xf * xf, -1, keepdims=True) + RMS_EPS) * g).astype(x.dtype)


def _rel_bucket(rel):
    half = REL_BUCKETS // 2
    max_exact = half // 2
    n = jnp.abs(rel)
    large = max_exact + (jnp.log(jnp.maximum(n, 1).astype(jnp.float32) / max_exact)
                         / math.log(REL_MAX_DIST / max_exact) * (half - max_exact)).astype(jnp.int32)
    large = jnp.minimum(large, half - 1)
    return jnp.where(rel > 0, half, 0) + jnp.where(n < max_exact, n, large)


def _blocks(t):
    b, s = t.shape[:2]
    return jnp.moveaxis(t.reshape(b, s // Q_BLOCK, Q_BLOCK, *t.shape[2:]), 1, 0)


def _unblocks(t):
    nb, b, q = t.shape[:3]
    return jnp.moveaxis(t, 0, 1).reshape(b, nb * q, *t.shape[3:])


def _axial_rope_tables(s):
    n_rows = s // GRID_W
    rows, cols = jnp.meshgrid(jnp.arange(n_rows), jnp.arange(GRID_W), indexing='ij')
    half = A_HEAD_DIM // 2
    freqs = ROPE_BASE ** (-jnp.arange(0, half, 2, dtype=jnp.float32) / half)
    ang_r = rows.reshape(-1)[:, None].astype(jnp.float32) * freqs
    ang_c = cols.reshape(-1)[:, None].astype(jnp.float32) * freqs
    return jnp.cos(ang_r), jnp.sin(ang_r), jnp.cos(ang_c), jnp.sin(ang_c)


def _rotate(x, cos, sin):
    x1, x2 = jnp.split(x, 2, axis=-1)
    c, s = cos[:, None, :], sin[:, None, :]
    return jnp.concatenate([x1 * c - x2 * s, x1 * s + x2 * c], -1).astype(x.dtype)


def _axial_rope(x, tabs):
    cr, sr, cc, sc = tabs
    x_row, x_col = jnp.split(x, 2, axis=-1)
    return jnp.concatenate([_rotate(x_row, cr, sr), _rotate(x_col, cc, sc)], -1)


def _axial_gqa(x, w_qkv, q_gain, k_gain, w_o):
    b, s, _ = x.shape
    qkv = x @ w_qkv
    q, k, v = jnp.split(qkv, [A_HEADS * A_HEAD_DIM, (A_HEADS + A_KV_HEADS) * A_HEAD_DIM], -1)
    q = q.reshape(b, s, A_HEADS, A_HEAD_DIM)
    k = k.reshape(b, s, A_KV_HEADS, A_HEAD_DIM)
    v = v.reshape(b, s, A_KV_HEADS, A_HEAD_DIM)
    tabs = _axial_rope_tables(s)
    q = _axial_rope(_rms_norm(q, q_gain), tabs)
    k = _axial_rope(_rms_norm(k, k_gain), tabs)
    q = q.reshape(b, s, A_KV_HEADS, A_HEADS // A_KV_HEADS, A_HEAD_DIM)
    scale = A_HEAD_DIM ** -0.5

    def blk(qb):
        logits = jnp.einsum('bqgrd,bkgd->bgrqk', qb, k).astype(jnp.float32) * scale
        p = jax.nn.softmax(logits, -1).astype(v.dtype)
        return jnp.einsum('bgrqk,bkgd->bqgrd', p, v)

    o = _unblocks(lax.map(blk, _blocks(q)))
    return o.reshape(b, s, A_HEADS * A_HEAD_DIM) @ w_o


def _dilated_attention(x, w_qkv, w_o, rel_bias):
    b, s, _ = x.shape
    n_g = len(B_PATTERNS)
    q, k, v = jnp.split(x @ w_qkv, 3, -1)
    q = q.reshape(b, s, n_g, B_HEADS_PER_GROUP, B_HEAD_DIM)
    k = k.reshape(b, s, n_g, B_HEADS_PER_GROUP, B_HEAD_DIM)
    v = v.reshape(b, s, n_g, B_HEADS_PER_GROUP, B_HEAD_DIM)
    ks = [k[:, :, g] for g in range(n_g)]
    vs = [v[:, :, g] for g in range(n_g)]
    scale = B_HEAD_DIM ** -0.5
    t_blocks = jnp.arange(s, dtype=jnp.int32).reshape(-1, Q_BLOCK)

    def blk(args):
        qb, t = args
        outs, lses = [], []
        for g, (window, dil) in enumerate(B_PATTERNS):
            n_side = window // (2 * dil)
            offs = dil * jnp.arange(-n_side, n_side + 1, dtype=jnp.int32)
            idx = t[:, None] + offs[None, :]
            valid = (idx >= 0) & (idx < s)
            idx_c = jnp.clip(idx, 0, s - 1)
            kg = jnp.take(ks[g], idx_c, axis=1)
            vg = jnp.take(vs[g], idx_c, axis=1)
            bias = rel_bias[_rel_bucket(offs)][:, g * B_HEADS_PER_GROUP:(g + 1) * B_HEADS_PER_GROUP]
            logits = (jnp.einsum('bqhd,bqjhd->bhqj', qb[:, :, g], kg).astype(jnp.float32) * scale
                      + bias.T[None, :, None, :])
            logits = jnp.where(valid[None, None], logits, -jnp.inf)
            lse = jax.nn.logsumexp(logits, -1)
            p = jnp.exp(logits - lse[..., None]).astype(vg.dtype)
            outs.append(jnp.einsum('bhqj,bqjhd->bqhd', p, vg))
            lses.append(lse)
        w = jax.nn.softmax(jnp.stack(lses, 0), axis=0)
        w = jnp.transpose(w, (1, 3, 0, 2))[..., None]
        return (jnp.stack(outs, 2) * w).astype(qb.dtype)

    o = _unblocks(lax.map(blk, (_blocks(q), t_blocks)))
    return o.reshape(b, s, B_HEADS * B_HEAD_DIM) @ w_o


def _s5_direction(u, lam_re, lam_im, log_dt, b_re, b_im, c_re, c_im):
    f32 = jnp.float32
    lr, li = lam_re.astype(f32), lam_im.astype(f32)
    dt = jnp.exp(log_dt.astype(f32))[:, None]
    mag = jnp.exp(lr * dt)
    ar, ai = mag * jnp.cos(li * dt), mag * jnp.sin(li * dt)
    den = lr * lr + li * li
    zr = ((ar - 1.0) * lr + ai * li) / den
    zi = (ai * lr - (ar - 1.0) * li) / den
    br, bi = b_re.astype(f32), b_im.astype(f32)
    bbr = zr[..., None] * br - zi[..., None] * bi
    bbi = zr[..., None] * bi + zi[..., None] * br
    bu_r = jnp.einsum('bsgc,gpc->bsgp', u, bbr)
    bu_i = jnp.einsum('bsgc,gpc->bsgp', u, bbi)
    a_r = jnp.broadcast_to(ar, bu_r.shape)
    a_i = jnp.broadcast_to(ai, bu_i.shape)

    def combine(e1, e2):
        a1r, a1i, b1r, b1i = e1
        a2r, a2i, b2r, b2i = e2
        return (a2r * a1r - a2i * a1i, a2r * a1i + a2i * a1r,
                a2r * b1r - a2i * b1i + b2r, a2r * b1i + a2i * b1r + b2i)

    _, _, hr, hi = lax.associative_scan(combine, (a_r, a_i, bu_r, bu_i), axis=1)
    return (jnp.einsum('bsgp,gcp->bsgc', hr, c_re.astype(f32))
            - jnp.einsum('bsgp,gcp->bsgc', hi, c_im.astype(f32)))


def _group_blocks(t):
    nb = C_N_GROUPS // C_GROUPS_PER_BLOCK
    return jnp.moveaxis(t.reshape(t.shape[0], nb, C_GROUPS_PER_BLOCK, *t.shape[2:]), 1, 0)


def _bidir_s5(x, lam_re, lam_im, log_dt, b_re, b_im, c_re, c_im, d_skip, w_glu):
    b, s, d = x.shape
    nb = C_N_GROUPS // C_GROUPS_PER_BLOCK
    u = x.astype(jnp.float32).reshape(b, s, nb, C_GROUPS_PER_BLOCK, C_GROUP)
    u = jnp.moveaxis(u, 2, 0)

    def blk(args):
        ub, lr, li, ldt, br, bi, cr, ci = args
        fwd = _s5_direction(ub, lr[0], li[0], ldt[0], br[0], bi[0], cr[0], ci[0])
        bwd = jnp.flip(_s5_direction(jnp.flip(ub, 1), lr[1], li[1], ldt[1], br[1], bi[1], cr[1], ci[1]), 1)
        return fwd + bwd

    y = lax.map(blk, (u, _group_blocks(lam_re), _group_blocks(lam_im), _group_blocks(log_dt),
                      _group_blocks(b_re), _group_blocks(b_im), _group_blocks(c_re), _group_blocks(c_im)))
    y = jnp.moveaxis(y, 0, 2).reshape(b, s, d) + d_skip * x
    z = jax.nn.gelu(y).astype(x.dtype)
    a, g = jnp.split(z @ w_glu, 2, -1)
    return a * jax.nn.sigmoid(g)


def _diff_attention(x, w_qkv, lam, norm_gain, w_o, rel_bias, lambda_init):
    b, s, _ = x.shape
    qk_w = D_HEADS * 2 * D_QK_DIM
    q, k, v = jnp.split(x @ w_qkv, [qk_w, 2 * qk_w], -1)
    q = q.reshape(b, s, D_HEADS, 2, D_QK_DIM)
    k = k.reshape(b, s, D_HEADS, 2, D_QK_DIM)
    v = v.reshape(b, s, D_HEADS, D_V_DIM)
    lf = lam.astype(jnp.float32)
    lam_val = jnp.exp(jnp.sum(lf[0] * lf[1])) - jnp.exp(jnp.sum(lf[2] * lf[3])) + lambda_init
    scale = D_QK_DIM ** -0.5
    pos = jnp.arange(s, dtype=jnp.int32)
    t_blocks = pos.reshape(-1, Q_BLOCK)

    def blk(args):
        qb, t = args
        bias = jnp.transpose(rel_bias[_rel_bucket(pos[None, :] - t[:, None])], (2, 0, 1))
        logits = jnp.einsum('bqhmd,bkhmd->bmhqk', qb, k).astype(jnp.float32) * scale + bias
        p = jax.nn.softmax(logits, -1)
        a = (p[:, 0] - lam_val * p[:, 1]).astype(v.dtype)
        return jnp.einsum('bhqk,bkhd->bqhd', a, v)

    o = _unblocks(lax.map(blk, (_blocks(q), t_blocks)))
    o = _rms_norm(o, norm_gain) * (1.0 - lambda_init)
    return o.reshape(b, s, D_HEADS * D_V_DIM) @ w_o


def _memory_attention(x, mem, w_q, w_kv, w_o):
    b, s, d = x.shape
    q = (x @ w_q).reshape(b, s, X_HEADS, X_HEAD_DIM)
    k, v = jnp.split(mem @ w_kv, 2, -1)
    k = k.reshape(b, mem.shape[1], X_HEADS, X_HEAD_DIM)
    v = v.reshape(b, mem.shape[1], X_HEADS, X_HEAD_DIM)
    logits = jnp.einsum('bshd,bmhd->bhsm', q, k).astype(jnp.float32) * (X_HEAD_DIM ** -0.5)
    p = jax.nn.softmax(logits, -1).astype(v.dtype)
    return jnp.einsum('bhsm,bmhd->bshd', p, v).reshape(b, s, d) @ w_o


def _expert_choice_ffn(x, w_router, w_gate, w_up, w_down):
    b, s, d = x.shape
    xt = x.reshape(b * s, d)
    cap = EC_CAPACITY * (b * s) // N_EXPERTS
    aff = jax.nn.softmax((xt @ w_router).astype(jnp.float32), -1)
    gate, idx = lax.top_k(aff.T, cap)
    xe = jnp.take(xt, idx, axis=0)
    h = jax.nn.silu(jnp.einsum('ecd,edf->ecf', xe, w_gate)) * jnp.einsum('ecd,edf->ecf', xe, w_up)
    ye = jnp.einsum('ecf,efd->ecd', h, w_down) * gate[..., None].astype(x.dtype)
    out = jnp.zeros_like(xt).at[idx.reshape(-1)].add(ye.reshape(-1, d).astype(xt.dtype))
    return out.reshape(b, s, d)


def _trunk(x, mem, p):
    for i in range(DEPTH):
        m, j = i % N_MIXERS, i // N_MIXERS
        if m == 0:
            h = _axial_gqa(x, p['a_w_qkv'][j], p['a_q_gain'][j], p['a_k_gain'][j], p['a_w_o'][j])
        elif m == 1:
            h = _dilated_attention(x, p['b_w_qkv'][j], p['b_w_o'][j], p['rel_bias'])
        elif m == 2:
            h = _bidir_s5(x, p['c_lam_re'][j], p['c_lam_im'][j], p['c_log_dt'][j], p['c_b_re'][j],
                          p['c_b_im'][j], p['c_c_re'][j], p['c_c_im'][j], p['c_d'][j], p['c_w_glu'][j])
        else:
            h = _diff_attention(x, p['d_w_qkv'][j], p['d_lam'][j], p['d_norm_gain'][j], p['d_w_o'][j],
                                p['rel_bias'], 0.8 - 0.6 * math.exp(-0.3 * i))
        x = _layer_norm(ALPHA * x + h, p['ln_g'][i, 0], p['ln_b'][i, 0])
        h = _memory_attention(x, mem, p['x_w_q'][i], p['x_w_kv'][i], p['x_w_o'][i])
        x = _layer_norm(ALPHA * x + h, p['ln_g'][i, 1], p['ln_b'][i, 1])
        h = _expert_choice_ffn(x, p['moe_w_router'][i], p['moe_w_gate'][i], p['moe_w_up'][i], p['moe_w_down'][i])
        x = _layer_norm(ALPHA * x + h, p['ln_g'][i, 2], p['ln_b'][i, 2])
    return x


def setup_inputs(seed: int = 0) -> dict:
    key = jax.random.key(seed)
    ks = iter(jax.random.split(key, 40))
    D, P, G = D_MODEL, C_STATE, C_N_GROUPS

    def nrm(shape, scale):
        return jax.random.normal(next(ks), shape, jnp.float32) * scale

    return {
        'x_prompt': nrm((BATCH, SEQ, D), 1.0),
        'x_sample': nrm((DEC_BATCH, DEC_SEQ, D), 1.0),
        'mem_prompt': nrm((BATCH, MEM_LEN, D), 1.0),
        'mem_sample': nrm((DEC_BATCH, MEM_LEN, D), 1.0),
        'rel_bias': nrm((REL_BUCKETS, REL_HEADS), 0.2),
        'ln_g': 1.0 + nrm((DEPTH, 3, D), 0.02),
        'ln_b': nrm((DEPTH, 3, D), 0.02),
        'a_w_qkv': nrm((N_A, D, (A_HEADS + 2 * A_KV_HEADS) * A_HEAD_DIM), D ** -0.5),
        'a_q_gain': 1.0 + nrm((N_A, A_HEAD_DIM), 0.02),
        'a_k_gain': 1.0 + nrm((N_A, A_HEAD_DIM), 0.02),
        'a_w_o': nrm((N_A, A_HEADS * A_HEAD_DIM, D), (A_HEADS * A_HEAD_DIM) ** -0.5 * BETA),
        'b_w_qkv': nrm((N_B, D, 3 * B_HEADS * B_HEAD_DIM), D ** -0.5),
        'b_w_o': nrm((N_B, B_HEADS * B_HEAD_DIM, D), (B_HEADS * B_HEAD_DIM) ** -0.5 * BETA),
        'c_lam_re': -0.5 + nrm((N_C, 2, G, P), 0.01),
        'c_lam_im': jnp.pi * jnp.arange(P, dtype=jnp.float32) + nrm((N_C, 2, G, P), 0.01),
        'c_log_dt': jax.random.uniform(next(ks), (N_C, 2, G), jnp.float32, math.log(1e-3), math.log(1e-1)),
        'c_b_re': nrm((N_C, 2, G, P, C_GROUP), (2.0 * C_GROUP) ** -0.5),
        'c_b_im': nrm((N_C, 2, G, P, C_GROUP), (2.0 * C_GROUP) ** -0.5),
        'c_c_re': nrm((N_C, 2, G, C_GROUP, P), (2.0 * P) ** -0.5),
        'c_c_im': nrm((N_C, 2, G, C_GROUP, P), (2.0 * P) ** -0.5),
        'c_d': nrm((N_C, D), 1.0),
        'c_w_glu': nrm((N_C, D, 2 * D), D ** -0.5 * BETA),
        'd_w_qkv': nrm((N_D, D, 2 * D_HEADS * 2 * D_QK_DIM + D_HEADS * D_V_DIM), D ** -0.5),
        'd_lam': nrm((N_D, 4, D_QK_DIM), 0.1),
        'd_norm_gain': 1.0 + nrm((N_D, D_V_DIM), 0.02),
        'd_w_o': nrm((N_D, D_HEADS * D_V_DIM, D), (D_HEADS * D_V_DIM) ** -0.5 * BETA),
        'x_w_q': nrm((DEPTH, D, D), D ** -0.5),
        'x_w_kv': nrm((DEPTH, D, 2 * D), D ** -0.5),
        'x_w_o': nrm((DEPTH, D, D), D ** -0.5 * BETA),
        'moe_w_router': nrm((DEPTH, D, N_EXPERTS), D ** -0.5),
        'moe_w_gate': nrm((DEPTH, N_EXPERTS, D, D_EXPERT), D ** -0.5),
        'moe_w_up': nrm((DEPTH, N_EXPERTS, D, D_EXPERT), D ** -0.5),
        'moe_w_down': nrm((DEPTH, N_EXPERTS, D_EXPERT, D), D_EXPERT ** -0.5 * BETA),
    }


def reference(x_prompt, x_sample, mem_prompt, mem_sample, rel_bias, ln_g, ln_b,
              a_w_qkv, a_q_gain, a_k_gain, a_w_o, b_w_qkv, b_w_o,
              c_lam_re, c_lam_im, c_log_dt, c_b_re, c_b_im, c_c_re, c_c_im, c_d, c_w_glu,
              d_w_qkv, d_lam, d_norm_gain, d_w_o, x_w_q, x_w_kv, x_w_o,
              moe_w_router, moe_w_gate, moe_w_up, moe_w_down):
    p = dict(rel_bias=rel_bias, ln_g=ln_g, ln_b=ln_b,
             a_w_qkv=a_w_qkv, a_q_gain=a_q_gain, a_k_gain=a_k_gain, a_w_o=a_w_o,
             b_w_qkv=b_w_qkv, b_w_o=b_w_o,
             c_lam_re=c_lam_re, c_lam_im=c_lam_im, c_log_dt=c_log_dt, c_b_re=c_b_re, c_b_im=c_b_im,
             c_c_re=c_c_re, c_c_im=c_c_im, c_d=c_d, c_w_glu=c_w_glu,
             d_w_qkv=d_w_qkv, d_lam=d_lam, d_norm_gain=d_norm_gain, d_w_o=d_w_o,
             x_w_q=x_w_q, x_w_kv=x_w_kv, x_w_o=x_w_o,
             moe_w_router=moe_w_router, moe_w_gate=moe_w_gate, moe_w_up=moe_w_up, moe_w_down=moe_w_down)
    y_prompt = _trunk(x_prompt, mem_prompt, p)
    y_sample = _trunk(x_sample, mem_sample, p)
    return (y_prompt, y_sample)
```

```cpp
#include <hip/hip_runtime.h>
#include <stdint.h>
#include <stdio.h>

#define LAS __attribute__((address_space(3)))
#define DI __device__ __forceinline__
typedef unsigned short bf16_t;
typedef short bf16x8 __attribute__((ext_vector_type(8)));
typedef short s16x4 __attribute__((ext_vector_type(4)));
typedef float f32x4 __attribute__((ext_vector_type(4)));
typedef float f32x2 __attribute__((ext_vector_type(2)));
typedef float f32x16 __attribute__((ext_vector_type(16)));
typedef unsigned u32x4 __attribute__((ext_vector_type(4)));
typedef unsigned u32x2 __attribute__((ext_vector_type(2)));

constexpr int DM = 1024;
constexpr int NTOK = 65536;
constexpr int NGRP_TOK = 32768;
constexpr int NSEQ = 12;
constexpr int MEMLEN = 256;
constexpr int NEXP = 16, CAP = 4096;
constexpr float ALPHA = 1.681792830507429f;
constexpr float LN_EPS = 1e-5f;
constexpr float LOG2E = 1.4426950408889634f;

typedef __bf16 bf16x2_t __attribute__((ext_vector_type(2)));
DI unsigned cvt_pk_bf16(float lo, float hi) { const f32x2 f = {lo, hi}; const bf16x2_t v = __builtin_convertvector(f, bf16x2_t); return __builtin_bit_cast(unsigned, v); }
DI float bf2f(unsigned b) { return __uint_as_float(b << 16); }
typedef _Float16 f16x2_t __attribute__((ext_vector_type(2)));
typedef _Float16 f16x8 __attribute__((ext_vector_type(8)));
DI unsigned cvt_pk_f16(float lo, float hi) { const f32x2 f = {lo, hi}; const f16x2_t v = __builtin_convertvector(f, f16x2_t); return __builtin_bit_cast(unsigned, v); }
typedef int i32x8 __attribute__((ext_vector_type(8)));
DI unsigned cvt_pk4_fp8(float a, float b, float c2, float d) { int p_ = __builtin_amdgcn_cvt_pk_fp8_f32(a, b, 0, false); p_ = __builtin_amdgcn_cvt_pk_fp8_f32(c2, d, p_, true); return (unsigned)p_; }
typedef short s16x2_ __attribute__((ext_vector_type(2)));
DI unsigned cvt_pk4_fp8_sc(unsigned old, float a, float b, float c2, float d, float sc) { s16x2_ r = __builtin_bit_cast(s16x2_, old); r = __builtin_amdgcn_cvt_scalef32_pk_fp8_f32(r, a, b, sc, false); r = __builtin_amdgcn_cvt_scalef32_pk_fp8_f32(r, c2, d, sc, true); return __builtin_bit_cast(unsigned, r); }
DI unsigned cvt_pk2_fp8(float a, float b) { return (unsigned)__builtin_amdgcn_cvt_pk_fp8_f32(a, b, 0, false) & 0xffffu; }
#ifndef MOE_DOWN_FP8
#define MOE_DOWN_FP8 1
#endif
constexpr float W8_SCALE = 64.0f;
DI f32x2 unpk_f16(unsigned w) { const f16x2_t h = __builtin_bit_cast(f16x2_t, w); return (f32x2){(float)h[0], (float)h[1]}; }
DI float wave_sum(float v) {
#pragma unroll
    for (int o = 32; o >= 1; o >>= 1) v += __shfl_xor(v, o);
    return v; }
DI float wave_max(float v) {
#pragma unroll
    for (int o = 32; o >= 1; o >>= 1) v = fmaxf(v, __shfl_xor(v, o));
    return v; }
DI float fast_exp2(float x) { return __builtin_amdgcn_exp2f(x); }
DI float fast_rcp(float x) { return __builtin_amdgcn_rcpf(x); }
DI float sigmoidf_(float x) { return fast_rcp(1.0f + fast_exp2(-x * LOG2E)); }
DI float gelu_tanh(float y) { const float u = 0.7978845608028654f * (y + 0.044715f * y * y * y); return y * sigmoidf_(2.0f * u); }
DI int seq_of_row(int n) { return n < NGRP_TOK ? (n >> 12) : 8 + ((n - NGRP_TOK) >> 13); }
DI int seq_len(int s) { return s < 8 ? 4096 : 8192; }
DI int seq_base(int s) { return s < 8 ? s * 4096 : NGRP_TOK + (s - 8) * 8192; }

#define XB_TMO      128
#define XB_XCNT(j)  (256  + 64 * (j))
#define XB_XSUB(j)  (1280 + 64 * (j))
#define XB_XGEN(j)  (2304 + 64 * (j))
#define XB_TOP      3328
#define XB_TOPGEN   3392
#define XCD_BAR_WORDS 3456
#define XB_SPIN_CAP (1u << 20)

DI unsigned xb_ld(unsigned* p)              { return __hip_atomic_load(p, __ATOMIC_RELAXED, __HIP_MEMORY_SCOPE_AGENT); }
DI unsigned xb_add(unsigned* p, unsigned v) { return __hip_atomic_fetch_add(p, v, __ATOMIC_RELAXED, __HIP_MEMORY_SCOPE_AGENT); }
DI unsigned xb_xcc_id() { return (unsigned)__builtin_amdgcn_s_getreg((3 << 11) | 20) & 0xFu; }
#define XB_SPIN(cond, bar) do { unsigned _sp = 0; while (cond) { __builtin_amdgcn_s_sleep(1); \
    if ((++_sp & 255u) == 0u) { if (xb_ld(&(bar)[XB_TMO])) break; if (_sp > XB_SPIN_CAP) { atomicAdd(&(bar)[XB_TMO], 1u); break; } } } } while (0)

struct XcdBarrier { unsigned* bar; unsigned x; volatile LAS unsigned* st; };

DI XcdBarrier xcd_barrier_post(unsigned* bar, volatile LAS unsigned* st) {
    XcdBarrier b; b.bar = bar; b.x = xb_xcc_id(); b.st = st;
    if (threadIdx.x == 0) (void)xb_add(&bar[XB_XCNT(b.x)], 1u);
    return b;
}
DI void xcd_barrier_complete(unsigned* bar, unsigned x, unsigned& nloc, unsigned& nx) {
    const unsigned G = gridDim.x * gridDim.y * gridDim.z;
    unsigned sum, cnt, mine, sp = 0u;
    for (;;) {
        sum = 0u; cnt = 0u; mine = 0u;
#pragma unroll
        for (unsigned j = 0; j < 16; ++j) { const unsigned c = xb_ld(&bar[XB_XCNT(j)]); sum += c; cnt += (c > 0u) ? 1u : 0u; mine = (j == x) ? c : mine; }
        if (sum == G) break;
        __builtin_amdgcn_s_sleep(1);
        if ((++sp & 255u) == 0u) { if (xb_ld(&bar[XB_TMO])) break; if (sp > XB_SPIN_CAP) { atomicAdd(&bar[XB_TMO], 1u); break; } }
    }
    nloc = mine > 0u ? mine : 1u; nx = cnt > 0u ? cnt : 1u;
}
DI void xcd_barrier(const XcdBarrier& b) {
    asm volatile("s_waitcnt vmcnt(0)" ::: "memory");
    __syncthreads();
    if (threadIdx.x == 0) {
        unsigned* bar = b.bar;
        __builtin_amdgcn_s_waitcnt(0);
        unsigned nloc = b.st[0], nx = b.st[1];
        if (nloc == 0u) { xcd_barrier_complete(bar, b.x, nloc, nx); b.st[0] = nloc; b.st[1] = nx; }
        const unsigned old = xb_add(&bar[XB_XSUB(b.x)], 1u);
        const unsigned gen = old / nloc;
        if (old + 1u == (gen + 1u) * nloc) {
            __builtin_amdgcn_fence(__ATOMIC_RELEASE, "agent");
            asm volatile("s_waitcnt vmcnt(0)" ::: "memory");
            const unsigned og = xb_add(&bar[XB_TOP], 1u);
            const unsigned tg = og / nx;
            if (og + 1u == (tg + 1u) * nx) xb_add(&bar[XB_TOPGEN], 1u);
            else XB_SPIN(xb_ld(&bar[XB_TOPGEN]) == tg, bar);
            __builtin_amdgcn_fence(__ATOMIC_ACQUIRE, "agent");
            xb_add(&bar[XB_XGEN(b.x)], 1u);
            asm volatile("s_waitcnt vmcnt(0)" ::: "memory");
        } else {
            XB_SPIN(xb_ld(&bar[XB_XGEN(b.x)]) == gen, bar);
            __builtin_amdgcn_fence(__ATOMIC_ACQUIRE, "agent");
            asm volatile("s_waitcnt vmcnt(0)" ::: "memory");
        }
    }
    __syncthreads();
}
namespace pg8 {
constexpr int BM = 256, BK = 64, HALF = 128, HTB = HALF * BK * 2, STAGE_BYTES = 8 * HTB;

DI int lds_byte(int r, int c) { const int st = (r >> 4) * 2 + (c >> 5), rr = r & 15, cc = c & 31, ob = rr * 64 + cc * 2; return st * 1024 + (ob ^ (((ob >> 9) & 1) << 5)); }
DI void stage_rc(int b, int& R, int& C) { const int st = b / 1024, sb = b % 1024, swz = sb ^ (((sb >> 9) & 1) << 5); R = (st >> 1) * 16 + swz / 64; C = (st & 1) * 32 + (swz % 64) / 2; }
DI int perm32(int rho) { const int n = rho >> 4, i = rho & 15; return 8 * (i >> 2) + 4 * n + (i & 3); }

struct Unit { const char* a; const char* b; const int* gi; int pm, pn, b1, b2; };

DI int cross_batch(int pm) { return pm < 128 ? (pm >> 4) : 8 + ((pm - 128) >> 5); }

struct Sched {
    const char* A; const char* B; const int* GI;
    long aS1, aS2, bS1, bS2; int giS1, giS2;
    unsigned lda, ldb;
    int nb2, nM, nN, total, G, c, cross, gather;
    DI bool next(int i, Unit& u) const {
        const long L = (long)i * G + c; if (L >= total) return false;
        int w = (int)L; { const int q = total / 8, r = total % 8, xcd = w % 8, off = w / 8; w = (xcd < r ? xcd * (q + 1) : r * (q + 1) + (xcd - r) * q) + off; }
        const int per = nM * nN, bz = w / per, l = w % per;
        const int nig = 8 * nN, gid = l / nig, fm = gid * 8, gsz = (nM - fm) < 8 ? (nM - fm) : 8;
        u.pm = fm + ((l % nig) % gsz); u.pn = (l % nig) / gsz;
        u.b1 = bz / nb2; u.b2 = bz % nb2;
        const int bb = cross ? cross_batch(u.pm) : u.b1;
        u.a = A + (long)u.b1 * aS1 + (long)u.b2 * aS2 + (gather ? 0l : (long)u.pm * 256 * lda);
        u.gi = GI + (long)u.b1 * giS1 + (long)u.b2 * giS2 + u.pm * 256;
        u.b = B + (long)bb * bS1 + (long)u.b2 * bS2 + (long)u.pn * 256 * ldb;
        return true;
    }
};
DI Sched make_sched_(int G, int bid, const void* A, unsigned lda, const void* B, unsigned ldb, int nM, int nN) {
    Sched s; s.A = (const char*)A; s.B = (const char*)B; s.GI = nullptr; s.aS1 = s.aS2 = s.bS1 = s.bS2 = 0; s.giS1 = s.giS2 = 0; s.lda = lda; s.ldb = ldb;
    s.nb2 = 1; s.nM = nM; s.nN = nN; s.total = nM * nN; s.G = G; s.c = bid; s.cross = 0; s.gather = 0; return s; }

typedef f32x4 Acc[2][2][4][2];

template <class Epi, bool GATHER, int OPM = 0  >
DI void gemm_phase(LAS unsigned char* lds, const Sched& S, const Epi& E, const int K, const int tid_in) {
    const int tid = tid_in, wid = __builtin_amdgcn_readfirstlane(tid >> 6), lane = tid & 63, wr = wid >> 2, wc = wid & 3, fr = lane & 15, fq = lane >> 4;
    const int nt = K / BK;
    const unsigned lda = S.lda, ldb = S.ldb;
    unsigned voffA[2], voffB[2];
#pragma unroll
    for (int i = 0; i < 2; ++i) { int R, C; stage_rc(tid * 16 + i * 8192, R, C); const int Rb = Epi::PERM ? ((R & ~31) + perm32(R & 31)) : R;
        voffA[i] = (unsigned)R * lda + (unsigned)C * 2u; voffB[i] = (unsigned)Rb * ldb + (unsigned)C * 2u; }
    const unsigned hstepA = 128u * lda, hstepB = 128u * ldb;
    const size_t kstep = (size_t)(BK * 2);
    const unsigned ldsw = (unsigned)wid * 1024u;
    const int aoff = lds_byte(wr * 64 + fr, fq * 8), boff = lds_byte(wc * 32 + fr, fq * 8);
#define PG8_SA(b, h) (((b) * 2 + (h)) * HTB)
#define PG8_SB(b, h) ((4 + (b) * 2 + (h)) * HTB)
#define PG8_GLDS(bufoff, gp, _i) __builtin_amdgcn_global_load_lds((const unsigned*)(gp), (LAS unsigned*)(lds + (bufoff) + ldsw + (_i) * 8192), 16, 0, 0)
#define PG8_STAGE_A(b, h, base, OFF) do { _Pragma("unroll") for (int _i = 0; _i < 2; ++_i) \
        PG8_GLDS(PG8_SA(b, h), (base) + (GATHER ? OFF[h][_i] : (voffA[_i] + (unsigned)(h) * hstepA)), _i); } while (0)
#define PG8_STAGE_B(b, h, base) do { _Pragma("unroll") for (int _i = 0; _i < 2; ++_i) \
        PG8_GLDS(PG8_SB(b, h), (base) + (voffB[_i] + (unsigned)(h) * hstepB), _i); } while (0)
#define PG8_LDA(dst, b, h) do { _Pragma("unroll") for (int m = 0; m < 4; ++m) _Pragma("unroll") for (int k = 0; k < 2; ++k) dst[m][k] = *(const LAS bf16x8*)(lds + PG8_SA(b, h) + aoff + m * 2048 + k * 1024); } while (0)
#define PG8_LDB(dst, b, h) do { _Pragma("unroll") for (int n = 0; n < 2; ++n) _Pragma("unroll") for (int k = 0; k < 2; ++k) dst[n][k] = *(const LAS bf16x8*)(lds + PG8_SB(b, h) + boff + n * 2048 + k * 1024); } while (0)
#define PG8_MMA(ai, bj, At, Bt) do { __builtin_amdgcn_s_setprio(1); \
        if (OPM == 2) { _Pragma("unroll") for (int m = 0; m < 4; ++m) _Pragma("unroll") for (int n = 0; n < 2; ++n) { \
            typedef short s16x16_ __attribute__((ext_vector_type(16))); \
            const i32x8 a8_ = __builtin_bit_cast(i32x8, (s16x16_)__builtin_shufflevector(At[m][0], At[m][1], 0, 1, 2, 3, 4, 5, 6, 7, 8, 9, 10, 11, 12, 13, 14, 15)); \
            const i32x8 b8_ = __builtin_bit_cast(i32x8, (s16x16_)__builtin_shufflevector(Bt[n][0], Bt[n][1], 0, 1, 2, 3, 4, 5, 6, 7, 8, 9, 10, 11, 12, 13, 14, 15)); \
            acc[ai][bj][m][n] = __builtin_amdgcn_mfma_scale_f32_16x16x128_f8f6f4(b8_, a8_, acc[ai][bj][m][n], 0, 0, 0, 127, 0, 127); } } \
        else { _Pragma("unroll") for (int m = 0; m < 4; ++m) _Pragma("unroll") for (int n = 0; n < 2; ++n) _Pragma("unroll") for (int k = 0; k < 2; ++k) \
        acc[ai][bj][m][n] = OPM == 1 ? __builtin_amdgcn_mfma_f32_16x16x32_f16(__builtin_bit_cast(f16x8, Bt[n][k]), __builtin_bit_cast(f16x8, At[m][k]), acc[ai][bj][m][n], 0, 0, 0) \
                                : __builtin_amdgcn_mfma_f32_16x16x32_bf16(Bt[n][k], At[m][k], acc[ai][bj][m][n], 0, 0, 0); } __builtin_amdgcn_s_setprio(0); } while (0)
#define PG8_GOFF(dst, gi_) do { int _t = tid; asm volatile("" : "+v"(_t)); _Pragma("unroll") for (int _i = 0; _i < 2; ++_i) { int _R, _C; stage_rc(_t * 16 + _i * 8192, _R, _C); \
        _Pragma("unroll") for (int _h = 0; _h < 2; ++_h) dst[_h][_i] = (unsigned)(gi_)[_h * 128 + _R] * lda + (unsigned)_C * 2u; } } while (0)
#define PG8_WAIT_V(n) asm volatile("s_waitcnt vmcnt(" #n ")" ::: "memory")
#define PG8_WAIT_L(n) asm volatile("s_waitcnt lgkmcnt(" #n ")" ::: "memory")
#define PG8_BAR __builtin_amdgcn_s_barrier()
#define PG8_SCHED __builtin_amdgcn_sched_barrier(0)
    Unit cur, nxt; int ui = 0;
    if (!S.next(0, cur)) return;
    Acc acc;
#pragma unroll
    for (int a = 0; a < 2; ++a)
#pragma unroll
        for (int b = 0; b < 2; ++b)
#pragma unroll
            for (int m = 0; m < 4; ++m)
#pragma unroll
                for (int n = 0; n < 2; ++n) acc[a][b][m][n] = (f32x4){0.f, 0.f, 0.f, 0.f};
    bf16x8 At[4][2], B0[2][2], B1[2][2];
    unsigned cO[2][2], nO[2][2];
#pragma unroll
    for (int h = 0; h < 2; ++h)
#pragma unroll
        for (int i = 0; i < 2; ++i) { cO[h][i] = 0u; nO[h][i] = 0u; }
    if (GATHER) { PG8_GOFF(cO, cur.gi); }
    const char* cA = cur.a; const char* cB = cur.b;
    PG8_STAGE_B(0, 0, cB); PG8_STAGE_A(0, 0, cA, cO); PG8_STAGE_B(0, 1, cB); PG8_STAGE_A(0, 1, cA, cO);
    if (wr == 1) PG8_BAR;
    PG8_WAIT_V(4); PG8_BAR;
    PG8_STAGE_B(1, 0, cB + kstep); PG8_STAGE_A(1, 0, cA + kstep, cO); PG8_STAGE_B(1, 1, cB + kstep);
    PG8_WAIT_V(6); PG8_BAR;
    for (;;) {
        const bool has_next = S.next(ui + 1, nxt);
        const char* nA = has_next ? nxt.a : cA; const char* nB = has_next ? nxt.b : cB;
        if (GATHER) {
            if (has_next) { PG8_GOFF(nO, nxt.gi); }
        }
        for (int t = 0; t < nt; t += 2) {
            const bool last = (t == nt - 2);
            const char* a1 = cA + (size_t)(t + 1) * kstep;
            const char* a2 = last ? nA : cA + (size_t)(t + 2) * kstep; const char* b2 = last ? nB : cB + (size_t)(t + 2) * kstep;
            const char* a3 = a2 + kstep; const char* b3 = b2 + kstep;
            PG8_LDB(B0, 0, 0); PG8_SCHED; PG8_LDA(At, 0, 0); PG8_STAGE_A(1, 1, a1, cO);
            if (GATHER) { if (last) {
#pragma unroll
                for (int h = 0; h < 2; ++h)
#pragma unroll
                    for (int i = 0; i < 2; ++i) cO[h][i] = nO[h][i]; } }
            PG8_WAIT_L(8); PG8_BAR; PG8_WAIT_L(0); PG8_MMA(0, 0, At, B0); PG8_BAR; PG8_SCHED;
            PG8_LDB(B1, 0, 1); PG8_STAGE_B(0, 0, b2);
            PG8_BAR; PG8_WAIT_L(0); PG8_MMA(0, 1, At, B1); PG8_BAR;
            PG8_LDA(At, 0, 1); PG8_STAGE_A(0, 0, a2, cO);
            PG8_BAR; PG8_WAIT_L(0); PG8_MMA(1, 0, At, B0); PG8_BAR; PG8_SCHED;
            PG8_STAGE_B(0, 1, b2);
            PG8_WAIT_V(6); PG8_BAR; PG8_MMA(1, 1, At, B1); PG8_BAR;
            PG8_LDB(B0, 1, 0); PG8_SCHED; PG8_LDA(At, 1, 0); PG8_STAGE_A(0, 1, a2, cO);
            PG8_WAIT_L(8); PG8_BAR; PG8_WAIT_L(0); PG8_MMA(0, 0, At, B0); PG8_BAR; PG8_SCHED;
            PG8_LDB(B1, 1, 1); PG8_STAGE_B(1, 0, b3);
            PG8_BAR; PG8_WAIT_L(0); PG8_MMA(0, 1, At, B1); PG8_BAR;
            PG8_LDA(At, 1, 1); PG8_STAGE_A(1, 0, a3, cO);
            PG8_BAR; PG8_WAIT_L(0); PG8_MMA(1, 0, At, B0); PG8_BAR; PG8_SCHED;
            PG8_STAGE_B(1, 1, b3);
            PG8_WAIT_V(6); PG8_BAR; PG8_MMA(1, 1, At, B1); PG8_BAR;
        }
        E(acc, cur, wr, wc, fr, fq, lds, ui);
        if (!has_next) break;
#pragma unroll
        for (int a = 0; a < 2; ++a)
#pragma unroll
            for (int b = 0; b < 2; ++b)
#pragma unroll
                for (int m = 0; m < 4; ++m)
#pragma unroll
                    for (int n = 0; n < 2; ++n) acc[a][b][m][n] = (f32x4){0.f, 0.f, 0.f, 0.f};
        cur = nxt; cA = nA; cB = nB; ++ui;
    }
    PG8_WAIT_V(0);
    if (wr == 0) PG8_BAR;
    PG8_BAR;
#undef PG8_SA
#undef PG8_SB
#undef PG8_GLDS
#undef PG8_STAGE_A
#undef PG8_STAGE_B
#undef PG8_LDA
#undef PG8_LDB
#undef PG8_MMA
#undef PG8_GOFF
#undef PG8_WAIT_V
#undef PG8_WAIT_L
#undef PG8_SCHED
}
#define PG8_BAR_ASM asm volatile("s_waitcnt lgkmcnt(0)\n\ts_barrier" ::: "memory")

template <bool F16OUT> struct EpiPk16 {
    static constexpr bool PERM = true;
    bf16_t* O; long oS1, oS2; int ldo; const float* rs; int rsS1, rsS2; int slim; float sval;
    DI void operator()(const Acc& acc, const Unit& u, int wr, int wc, int fr, int fq, LAS unsigned char*, int) const {
        __builtin_amdgcn_sched_barrier(0);
        bf16_t* base = O + u.b1 * oS1 + u.b2 * oS2 + (long)(u.pm * 256 + wr * 64 + fr) * ldo + u.pn * 256 + wc * 32 + 8 * fq;
        const float* rsp = rs ? rs + u.b1 * rsS1 + u.b2 * rsS2 + u.pm * 256 + wr * 64 + fr : nullptr;
#pragma unroll
        for (int ai = 0; ai < 2; ++ai)
#pragma unroll
            for (int m = 0; m < 4; ++m) {
                bf16_t* rowp = base + (long)(ai * HALF + m * 16) * ldo;
                const float rsc = rsp ? rsp[ai * HALF + m * 16] : 1.0f;
#pragma unroll
                for (int bj = 0; bj < 2; ++bj) {
                    const float sc = rsc * ((u.pn * 256 + bj * HALF + wc * 32) < slim ? sval : 1.0f);
                    const f32x4 v0 = acc[ai][bj][m][0] * sc, v1 = acc[ai][bj][m][1] * sc;
                    u32x4 w;
                    if (F16OUT) { w.x = cvt_pk_f16(v0[0], v0[1]); w.y = cvt_pk_f16(v0[2], v0[3]); w.z = cvt_pk_f16(v1[0], v1[1]); w.w = cvt_pk_f16(v1[2], v1[3]); }
                    else { w.x = cvt_pk_bf16(v0[0], v0[1]); w.y = cvt_pk_bf16(v0[2], v0[3]); w.z = cvt_pk_bf16(v1[0], v1[1]); w.w = cvt_pk_bf16(v1[2], v1[3]); }
                    *(u32x4*)(rowp + bj * HALF) = w; } }
    }
};
typedef EpiPk16<false> EpiBf16;
struct EpiF8 {
    static constexpr bool PERM = true;
    unsigned char* O; long oS1, oS2; int ldo; float sc;
    DI void operator()(const Acc& acc, const Unit& u, int wr, int wc, int fr, int fq, LAS unsigned char*, int) const {
        __builtin_amdgcn_sched_barrier(0);
        unsigned char* base = O + u.b1 * oS1 + u.b2 * oS2 + (long)(u.pm * 256 + wr * 64 + fr) * ldo + u.pn * 256 + wc * 32 + 8 * fq;
#pragma unroll
        for (int ai = 0; ai < 2; ++ai)
#pragma unroll
            for (int m = 0; m < 4; ++m) {
                unsigned char* rowp = base + (long)(ai * HALF + m * 16) * ldo;
#pragma unroll
                for (int bj = 0; bj < 2; ++bj) {
                    const f32x4 v0 = acc[ai][bj][m][0], v1 = acc[ai][bj][m][1];
                    u32x2 w; w.x = cvt_pk4_fp8_sc(0u, v0[0], v0[1], v0[2], v0[3], sc); w.y = cvt_pk4_fp8_sc(0u, v1[0], v1[1], v1[2], v1[3], sc);
                    *(u32x2*)(rowp + bj * HALF) = w; } }
    }
};
typedef EpiPk16<true> EpiF16;
struct EpiResid {
    static constexpr bool PERM = false;
    float* X;
    DI void operator()(const Acc& acc, const Unit& u, int wr, int wc, int fr, int fq, LAS unsigned char*, int) const {
        float* base = X + (long)(u.pm * 256 + wr * 64 + fr) * DM + u.pn * 256 + wc * 32 + 4 * fq;
#pragma unroll
        for (int ai = 0; ai < 2; ++ai)
#pragma unroll
            for (int m = 0; m < 4; ++m) { float* rowp = base + (long)(ai * HALF + m * 16) * DM;
#pragma unroll
                for (int bj = 0; bj < 2; ++bj)
#pragma unroll
                    for (int n = 0; n < 2; ++n) { f32x4* p = (f32x4*)(rowp + bj * HALF + n * 16); *p = *p * ALPHA + acc[ai][bj][m][n]; } }
    }
};
struct EpiGluResid {
    static constexpr bool PERM = false;
    float* X;
    DI void operator()(const Acc& acc, const Unit& u, int wr, int wc, int fr, int fq, LAS unsigned char*, int) const {
        float* base = X + (long)(u.pm * 256 + wr * 64 + fr) * DM + u.pn * 128 + wc * 32 + 4 * fq;
#pragma unroll
        for (int ai = 0; ai < 2; ++ai)
#pragma unroll
            for (int m = 0; m < 4; ++m) { float* rowp = base + (long)(ai * HALF + m * 16) * DM;
#pragma unroll
                for (int n = 0; n < 2; ++n) { f32x4* p = (f32x4*)(rowp + n * 16); const f32x4 a = acc[ai][0][m][n], g = acc[ai][1][m][n]; f32x4 x = *p;
#pragma unroll
                    for (int j = 0; j < 4; ++j) x[j] = x[j] * ALPHA + a[j] * sigmoidf_(g[j]);
                    *p = x; } }
    }
};
struct EpiGluBf16 {
    static constexpr bool PERM = true;
    bf16_t* H;
    DI void operator()(const Acc& acc, const Unit& u, int wr, int wc, int fr, int fq, LAS unsigned char*, int) const {
        bf16_t* base = H + (long)(u.pm * 256 + wr * 64 + fr) * DM + u.pn * 128 + wc * 32 + 8 * fq;
#pragma unroll
        for (int ai = 0; ai < 2; ++ai)
#pragma unroll
            for (int m = 0; m < 4; ++m) { bf16_t* rowp = base + (long)(ai * HALF + m * 16) * DM;
                float h[8];
#pragma unroll
                for (int n = 0; n < 2; ++n)
#pragma unroll
                    for (int j = 0; j < 4; ++j) h[n * 4 + j] = acc[ai][0][m][n][j] * sigmoidf_(acc[ai][1][m][n][j]);
                u32x4 w; w.x = cvt_pk_bf16(h[0], h[1]); w.y = cvt_pk_bf16(h[2], h[3]); w.z = cvt_pk_bf16(h[4], h[5]); w.w = cvt_pk_bf16(h[6], h[7]);
                *(u32x4*)rowp = w; }
    }
};
template <bool F8OUT> struct EpiSwiGLU_ {
    static constexpr bool PERM = true;
    bf16_t* H;
    DI void operator()(const Acc& acc, const Unit& u, int wr, int wc, int fr, int fq, LAS unsigned char*, int) const {
        const long row0 = (long)(u.b1 * 16 + u.b2) * CAP + u.pm * 256 + wr * 64 + fr; const int col0 = u.pn * 128 + wc * 32 + 8 * fq;
#pragma unroll
        for (int ai = 0; ai < 2; ++ai)
#pragma unroll
            for (int m = 0; m < 4; ++m) {
                float h[8];
#pragma unroll
                for (int n = 0; n < 2; ++n)
#pragma unroll
                    for (int j = 0; j < 4; ++j) { const float g = acc[ai][0][m][n][j] * (1.0f / W8_SCALE); h[n * 4 + j] = g * sigmoidf_(g) * (acc[ai][1][m][n][j] * (1.0f / W8_SCALE)); }
                const long r = row0 + ai * HALF + m * 16;
                if (F8OUT) { u32x2 w; w.x = cvt_pk4_fp8(h[0], h[1], h[2], h[3]); w.y = cvt_pk4_fp8(h[4], h[5], h[6], h[7]); *(u32x2*)((unsigned char*)H + r * DM + col0) = w; }
                else { u32x4 w; w.x = cvt_pk_bf16(h[0], h[1]); w.y = cvt_pk_bf16(h[2], h[3]); w.z = cvt_pk_bf16(h[4], h[5]); w.w = cvt_pk_bf16(h[6], h[7]); *(u32x4*)(H + r * DM + col0) = w; }
                __builtin_amdgcn_sched_barrier(0); }
    }
};
typedef EpiSwiGLU_<false> EpiSwiGLU;
typedef EpiSwiGLU_<true> EpiSwiGLU8;
struct EpiF32 {
    static constexpr bool PERM = false;
    float* C; long oS1; int ldo;
    DI void operator()(const Acc& acc, const Unit& u, int wr, int wc, int fr, int fq, LAS unsigned char*, int) const {
        float* base = C + u.b1 * oS1 + (long)(u.pm * 256 + wr * 64 + fr) * ldo + u.pn * 256 + wc * 32 + 4 * fq;
#pragma unroll
        for (int ai = 0; ai < 2; ++ai)
#pragma unroll
            for (int m = 0; m < 4; ++m) { float* rowp = base + (long)(ai * HALF + m * 16) * ldo;
#pragma unroll
                for (int bj = 0; bj < 2; ++bj)
#pragma unroll
                    for (int n = 0; n < 2; ++n) *(f32x4*)(rowp + bj * HALF + n * 16) = acc[ai][bj][m][n]; }
    }
};
template <bool F8> struct EpiSoftmax256_ {
    static constexpr bool PERM = true;
    bf16_t* Pm;
    DI void operator()(const Acc& acc, const Unit& u, int wr, int wc, int fr, int fq, LAS unsigned char* lds, int ui) const {
        LAS f32x2* T = (LAS f32x2*)(lds + STAGE_BYTES + (ui & 1) * 8192);
        float mloc[2][4];
#pragma unroll
        for (int ai = 0; ai < 2; ++ai)
#pragma unroll
            for (int m = 0; m < 4; ++m) {
                float mx = -3.0e38f;
#pragma unroll
                for (int bj = 0; bj < 2; ++bj)
#pragma unroll
                    for (int n = 0; n < 2; ++n) { const f32x4 x = acc[ai][bj][m][n]; mx = fmaxf(fmaxf(mx, fmaxf(x[0], x[1])), fmaxf(x[2], x[3])); }
                mx = fmaxf(mx, __shfl_xor(mx, 16)); mx = fmaxf(mx, __shfl_xor(mx, 32));
                float s = 0.f;
#pragma unroll
                for (int bj = 0; bj < 2; ++bj)
#pragma unroll
                    for (int n = 0; n < 2; ++n) { const f32x4 x = acc[ai][bj][m][n]; s += (fast_exp2(x[0] - mx) + fast_exp2(x[1] - mx)) + (fast_exp2(x[2] - mx) + fast_exp2(x[3] - mx)); }
                s += __shfl_xor(s, 16); s += __shfl_xor(s, 32);
                mloc[ai][m] = mx;
                if (fq == 0) T[(ai * HALF + wr * 64 + m * 16 + fr) * 4 + wc] = (f32x2){mx, s};
            }
        PG8_BAR_ASM;
        bf16_t* base = Pm + (long)(u.pm * 256 + wr * 64 + fr) * DM + u.pn * 256 + wc * 32 + 8 * fq;
#pragma unroll
        for (int ai = 0; ai < 2; ++ai)
#pragma unroll
            for (int m = 0; m < 4; ++m) {
                const int row = ai * HALF + wr * 64 + m * 16 + fr;
                const f32x2 t0 = T[row * 4 + 0], t1 = T[row * 4 + 1], t2 = T[row * 4 + 2], t3 = T[row * 4 + 3];
                const float M = fmaxf(fmaxf(t0.x, t1.x), fmaxf(t2.x, t3.x));
                const float Lsum = t0.y * fast_exp2(t0.x - M) + t1.y * fast_exp2(t1.x - M) + t2.y * fast_exp2(t2.x - M) + t3.y * fast_exp2(t3.x - M);
                const float inv = fast_rcp(Lsum) * (F8 ? 256.0f : 1.0f);
                bf16_t* rowp = base + (long)(ai * HALF + m * 16) * DM;
                unsigned char* rowp8 = (unsigned char*)Pm + (long)(u.pm * 256 + row) * DM + u.pn * 256 + wc * 32 + 8 * fq;
#pragma unroll
                for (int bj = 0; bj < 2; ++bj) { const f32x4 x0 = acc[ai][bj][m][0], x1 = acc[ai][bj][m][1]; float p[8];
#pragma unroll
                    for (int j = 0; j < 4; ++j) { p[j] = fast_exp2(x0[j] - M) * inv; p[4 + j] = fast_exp2(x1[j] - M) * inv; }
                    if (F8) { u32x2 w8; w8.x = cvt_pk4_fp8(p[0], p[1], p[2], p[3]); w8.y = cvt_pk4_fp8(p[4], p[5], p[6], p[7]); *(u32x2*)(rowp8 + bj * HALF) = w8; }
                    else { u32x4 w; w.x = cvt_pk_bf16(p[0], p[1]); w.y = cvt_pk_bf16(p[2], p[3]); w.z = cvt_pk_bf16(p[4], p[5]); w.w = cvt_pk_bf16(p[6], p[7]);
                        *(u32x4*)(rowp + bj * HALF) = w; } } }
        (void)mloc;
    }
};
typedef EpiSoftmax256_<false> EpiSoftmax256;
typedef EpiSoftmax256_<true> EpiSoftmax256F8;
struct EpiS5Out {
    static constexpr bool PERM = true;
    bf16_t* Z; const bf16_t* X16; const float* dskip;
    DI void operator()(const Acc& acc, const Unit& u, int wr, int wc, int fr, int fq, LAS unsigned char*, int) const {
        const int g = u.b1;
#pragma unroll
        for (int ai = 0; ai < 2; ++ai)
#pragma unroll
            for (int m = 0; m < 4; ++m) {
                const int chunk = u.pm * 256 + ai * HALF + wr * 64 + m * 16 + fr;
#pragma unroll
                for (int bj = 0; bj < 2; ++bj) {
                    const int col = u.pn * 256 + bj * HALF + wc * 32 + 8 * fq, i = col >> 4, j = col & 15;
                    const long off = (long)(chunk * 32 + i) * DM + g * 16 + j;
                    const u32x4 xw = *(const u32x4*)(X16 + off); const f32x2 x01 = unpk_f16(xw.x), x23 = unpk_f16(xw.y), x45 = unpk_f16(xw.z), x67 = unpk_f16(xw.w);
                    const f32x4 xa = {x01.x, x01.y, x23.x, x23.y}, xb = {x45.x, x45.y, x67.x, x67.y};
                    const f32x4 da = *(const f32x4*)(dskip + g * 16 + j), db = *(const f32x4*)(dskip + g * 16 + j + 4);
                    float y[8];
#pragma unroll
                    for (int q = 0; q < 4; ++q) { y[q] = gelu_tanh(acc[ai][bj][m][0][q] + da[q] * xa[q]); y[4 + q] = gelu_tanh(acc[ai][bj][m][1][q] + db[q] * xb[q]); }
                    u32x4 w; w.x = cvt_pk_bf16(y[0], y[1]); w.y = cvt_pk_bf16(y[2], y[3]); w.z = cvt_pk_bf16(y[4], y[5]); w.w = cvt_pk_bf16(y[6], y[7]);
                    *(u32x4*)(Z + off) = w; } }
    }
};
}
struct Ctx { LAS unsigned char* lds; int tid, lane, wave, G, bid, gw, ngw; };

DI void cvt_copy_bf16(const Ctx& c, const float* src, bf16_t* dst, long n) {
    for (long i = ((long)c.bid * 512 + c.tid) * 4; i < n; i += (long)c.G * 512 * 4) {
        const f32x4 v = *(const f32x4*)(src + i); u32x2 w; w.x = cvt_pk_bf16(v[0], v[1]); w.y = cvt_pk_bf16(v[2], v[3]); *(u32x2*)(dst + i) = w; }
}
DI void init_x(const Ctx& c, const float* xp, const float* xs, bf16_t* X16, bf16_t* X8_) {
    const long half = (long)NGRP_TOK * DM;
    for (long i = ((long)c.bid * 512 + c.tid) * 4; i < 2 * half; i += (long)c.G * 512 * 4) {
        const f32x4 v = i < half ? *(const f32x4*)(xp + i) : *(const f32x4*)(xs + (i - half));
        u32x2 w; w.x = cvt_pk_f16(v[0], v[1]); w.y = cvt_pk_f16(v[2], v[3]); *(u32x2*)(X16 + i) = w;
        *(unsigned*)((unsigned char*)X8_ + i) = cvt_pk4_fp8(v[0], v[1], v[2], v[3]); }
}
DI long il_row(int n, int which) { return (long)(n >> 7) * 256 + which * 128 + (n & 127); }
struct TJob { const float* W; bf16_t* Wt; int tn  , ldw, ldt, mode, nit, f16; };
DI TJob tjob(const float* W, int K, int N, int ldw, bf16_t* Wt, int ldt, int mode, int f16 = 0) { TJob j; j.W = W; j.Wt = Wt; j.tn = N / 256; j.ldw = ldw; j.ldt = ldt; j.mode = mode; j.nit = (K / 64) * (N / 256); j.f16 = f16; return j; }
#define CONV_DECODE(it_, W_, Wt_, ldw_, ldt_, mode_, k0_, n0_, f16_) do { int tn_, r_; \
    if ((it_) < n3) { const bool b0 = (it_) < n0, b1 = (it_) < n1, b2 = (it_) < n2; \
        W_ = b0 ? j0.W : (b1 ? j1.W : (b2 ? j2.W : j3.W)); Wt_ = b0 ? j0.Wt : (b1 ? j1.Wt : (b2 ? j2.Wt : j3.Wt)); \
        tn_ = b0 ? j0.tn : (b1 ? j1.tn : (b2 ? j2.tn : j3.tn)); ldw_ = b0 ? j0.ldw : (b1 ? j1.ldw : (b2 ? j2.ldw : j3.ldw)); \
        ldt_ = b0 ? j0.ldt : (b1 ? j1.ldt : (b2 ? j2.ldt : j3.ldt)); mode_ = b0 ? j0.mode : (b1 ? j1.mode : (b2 ? j2.mode : j3.mode)); \
        r_ = (it_) - (b0 ? 0 : (b1 ? n0 : (b2 ? n1 : n2))); f16_ = b0 ? j0.f16 : (b1 ? j1.f16 : (b2 ? j2.f16 : j3.f16)); \
    } else { const int q_ = (it_) - n3, e_ = q_ / 192, m_ = (q_ % 192) >> 6; r_ = q_ & 63; \
        W_ = (m_ == 0 ? wg : (m_ == 1 ? wu : wd)) + (size_t)e_ * 1024 * 1024; \
        Wt_ = m_ == 2 ? (MOE_DOWN_FP8 ? (bf16_t*)((unsigned char*)WD + (size_t)e_ * 1024 * 1024) : WD + (size_t)e_ * 1024 * 1024) : (bf16_t*)((unsigned char*)WGU + (size_t)e_ * 2048 * 1024); \
        tn_ = 4; ldw_ = 1024; ldt_ = 1024; mode_ = m_ == 2 ? 0 : m_ + 1; f16_ = (m_ == 2 && !MOE_DOWN_FP8) ? 0 : 2; }        \
    k0_ = (r_ / tn_) * 64; n0_ = (r_ % tn_) * 256; } while (0)
DI void convert_layer_weights(const Ctx& c, const TJob& j0, const TJob& j1, const TJob& j2, const TJob& j3, const float* wg, const float* wu, const float* wd, bf16_t* WGU, bf16_t* WD) {
    const int n0 = j0.nit, n1 = n0 + j1.nit, n2 = n1 + j2.nit, n3 = n2 + j3.nit, total = n3 + 16 * 3 * 64;
    LAS float* scr = (LAS float*)c.lds;
    int it = c.bid;
    if (it >= total) return;
    const float* cW; bf16_t* cWt; int cldw, cldt, cmode, ck0, cn0, cf16;
    CONV_DECODE(it, cW, cWt, cldw, cldt, cmode, ck0, cn0, cf16);
    f32x4 a[8];
    { const float* src = cW + (long)(ck0 + c.wave * 8) * cldw + cn0 + c.lane * 4;
#pragma unroll
      for (int i = 0; i < 8; ++i) a[i] = *(const f32x4*)(src + (long)i * cldw); }
    for (;;) {
#pragma unroll
        for (int i = 0; i < 8; ++i) { const int k = c.wave * 8 + i;
#pragma unroll
            for (int q = 0; q < 4; ++q) scr[k * 257 + c.lane * 4 + q] = a[i][q]; }
        __syncthreads();
        const int itn = it + c.G; const bool more = itn < total;
        const float* nW = cW; bf16_t* nWt = cWt; int nldw = cldw, nldt = cldt, nmode = cmode, nk0 = ck0, nn0 = cn0, nf16 = cf16;
        if (more) { CONV_DECODE(itn, nW, nWt, nldw, nldt, nmode, nk0, nn0, nf16);
            const float* src = nW + (long)(nk0 + c.wave * 8) * nldw + nn0 + c.lane * 4;
#pragma unroll
            for (int i = 0; i < 8; ++i) a[i] = *(const f32x4*)(src + (long)i * nldw); }
        const int sub = c.lane >> 5, kk = (c.lane & 31) * 2;
#pragma unroll 4
        for (int j = 0; j < 16; ++j) { const int n = c.wave * 32 + 2 * j + sub;
            const float v0 = scr[kk * 257 + n], v1 = scr[(kk + 1) * 257 + n];
            const long orow = cmode == 0 ? (long)(cn0 + n) : il_row(cn0 + n, cmode - 1);
            if (cf16 >= 2) { const float ws_ = cf16 == 2 ? W8_SCALE : 1.0f; *(unsigned short*)((unsigned char*)cWt + orow * cldt + ck0 + kk) = (unsigned short)cvt_pk2_fp8(v0 * ws_, v1 * ws_); continue; }
            *(unsigned*)(cWt + orow * cldt + ck0 + kk) = cf16 ? cvt_pk_f16(v0, v1) : cvt_pk_bf16(v0, v1); }
        __syncthreads();
        if (!more) break;
        it = itn; cW = nW; cWt = nWt; cldw = nldw; cldt = nldt; cmode = nmode; ck0 = nk0; cn0 = nn0; cf16 = nf16;
    }
}
#undef CONV_DECODE

template <int MODE>
DI void ln_phase(const Ctx& c, float* OUTF, bf16_t* X16, const float* g, const float* b,
                 const bf16_t* YE, const int* INV_in, const float* wr_lds_src  , float* AFFT, int* INV_out, bf16_t* UH, const bf16_t* HB_in = nullptr, const float* GATE_in = nullptr) {
    LAS float* wT = (LAS float*)c.lds;
    if (MODE & 2) {
        for (int i = c.tid; i < 16 * 1024; i += 512) { const int cc = i >> 4, e = i & 15; wT[e * 1024 + cc] = wr_lds_src[i]; }
        __syncthreads();
    }
    f32x4 gv[4], bv[4];
#pragma unroll
    for (int j = 0; j < 4; ++j) { gv[j] = *(const f32x4*)(g + j * 256 + c.lane * 4); bv[j] = *(const f32x4*)(b + j * 256 + c.lane * 4); }
    f32x4 vprev[4]; int rowprev = 0, itn = 0;
#pragma unroll
    for (int j = 0; j < 4; ++j) vprev[j] = (f32x4){0.f, 0.f, 0.f, 0.f};
    for (int row = c.gw; row < NTOK; row += c.ngw, ++itn) {
        bf16_t* xr = X16 + (long)row * DM + c.lane * 4;
        f32x4 v[4];
#pragma unroll
        for (int j = 0; j < 4; ++j) { const u32x2 w = *(const u32x2*)(xr + j * 256); const f32x2 a = unpk_f16(w.x), bq = unpk_f16(w.y); v[j] = (f32x4){a.x, a.y, bq.x, bq.y}; }
        if ((MODE & 8) && (MODE & 64)) {
            const unsigned char* hr = (const unsigned char*)HB_in + (long)row * DM + c.lane * 4;
#pragma unroll
            for (int j = 0; j < 4; ++j) { const unsigned w = *(const unsigned*)(hr + j * 256);
                const f32x2 lo = __builtin_amdgcn_cvt_pk_f32_fp8((int)w, false), hi2 = __builtin_amdgcn_cvt_pk_f32_fp8((int)w, true);
                v[j][0] = v[j][0] * ALPHA + lo[0] * (1.0f / 64.0f); v[j][1] = v[j][1] * ALPHA + lo[1] * (1.0f / 64.0f); v[j][2] = v[j][2] * ALPHA + hi2[0] * (1.0f / 64.0f); v[j][3] = v[j][3] * ALPHA + hi2[1] * (1.0f / 64.0f); }
        } else if (MODE & 8) {
            const bf16_t* hr = HB_in + (long)row * DM + c.lane * 4;
#pragma unroll
            for (int j = 0; j < 4; ++j) { const u32x2 w = *(const u32x2*)(hr + j * 256);
                v[j][0] = v[j][0] * ALPHA + bf2f(w.x & 0xffffu); v[j][1] = v[j][1] * ALPHA + bf2f(w.x >> 16); v[j][2] = v[j][2] * ALPHA + bf2f(w.y & 0xffffu); v[j][3] = v[j][3] * ALPHA + bf2f(w.y >> 16); }
        }
        if (MODE & 1) {
#pragma unroll
            for (int j = 0; j < 4; ++j) v[j] = v[j] * ALPHA;
            const int grp = row >> 15;
            const int myp = c.lane < 16 ? INV_in[(long)row * 16 + c.lane] : -1;
            unsigned long long msk = __ballot(myp >= 0);
            while (msk) {
                int pos[4]; bool ok[4]; float gt[4];
#pragma unroll
                for (int q = 0; q < 4; ++q) { ok[q] = msk != 0ull; const int e = ok[q] ? __builtin_ctzll(msk) : 0; msk &= msk - 1ull; const int pz = __builtin_amdgcn_readlane(myp, e); pos[q] = ok[q] ? ((grp * 16 + e) * CAP + pz) : 0;
                    gt[q] = GATE_in ? GATE_in[pos[q]] * 0.125f : 1.0f; }
                unsigned w[4][4];
#pragma unroll
                for (int q = 0; q < 4; ++q) if (ok[q]) { const unsigned char* yr = (const unsigned char*)YE + (long)pos[q] * DM + c.lane * 4;
#pragma unroll
                    for (int j = 0; j < 4; ++j) w[q][j] = *(const unsigned*)(yr + j * 256); }
#pragma unroll
                for (int q = 0; q < 4; ++q) if (ok[q]) {
#pragma unroll
                    for (int j = 0; j < 4; ++j) { const f32x2 lo = __builtin_amdgcn_cvt_pk_f32_fp8((int)w[q][j], false), hi2 = __builtin_amdgcn_cvt_pk_f32_fp8((int)w[q][j], true);
                        v[j][0] += gt[q] * lo[0]; v[j][1] += gt[q] * lo[1]; v[j][2] += gt[q] * hi2[0]; v[j][3] += gt[q] * hi2[1]; } }
            }
        }
        float s = 0.f;
#pragma unroll
        for (int j = 0; j < 4; ++j) s += (v[j][0] + v[j][1]) + (v[j][2] + v[j][3]);
        const float mean = wave_sum(s) * (1.0f / DM);
        float q = 0.f;
#pragma unroll
        for (int j = 0; j < 4; ++j) { const f32x4 d = v[j] - mean; q += (d[0] * d[0] + d[1] * d[1]) + (d[2] * d[2] + d[3] * d[3]); }
        const float rstd = rsqrtf(wave_sum(q) * (1.0f / DM) + LN_EPS);
#pragma unroll
        for (int j = 0; j < 4; ++j) { v[j] = (v[j] - mean) * rstd * gv[j] + bv[j]; if (MODE & 16) *(f32x4*)(OUTF + (long)row * DM + c.lane * 4 + j * 256) = v[j]; }
#pragma unroll
        for (int j = 0; j < 4; ++j) { u32x2 w; w.x = cvt_pk_f16(v[j][0], v[j][1]); w.y = cvt_pk_f16(v[j][2], v[j][3]); if (!(MODE & 16)) *(u32x2*)(xr + j * 256) = w;
            if (MODE & (2 | 32)) *(unsigned*)((unsigned char*)UH + (long)row * DM + c.lane * 4 + j * 256) = cvt_pk4_fp8(v[j][0], v[j][1], v[j][2], v[j][3]);
            if (MODE & 4) { const int gi = j * 16 + (c.lane >> 2);
                u32x2 wb; wb.x = cvt_pk_bf16(v[j][0], v[j][1]); wb.y = cvt_pk_bf16(v[j][2], v[j][3]);
                *(u32x2*)(UH + ((long)gi * 2048 + (row >> 5)) * 768 + (row & 31) * 16 + (c.lane & 3) * 4) = wb; } }
        if ((MODE & 2) && !(itn & 1)) {
#pragma unroll
            for (int j = 0; j < 4; ++j) vprev[j] = v[j];
            rowprev = row;
        }
        if ((MODE & 2) && (itn & 1)) {
            float pe2[2][16];
            f32x2 xy[4][4];
#pragma unroll
            for (int j = 0; j < 4; ++j)
#pragma unroll
                for (int k = 0; k < 4; ++k) xy[j][k] = (f32x2){vprev[j][k], v[j][k]};
#pragma unroll
            for (int e = 0; e < 16; ++e) { f32x2 a = {0.f, 0.f};
#pragma unroll
                for (int j = 0; j < 4; ++j) { const f32x4 w = *(const LAS f32x4*)(wT + e * 1024 + j * 256 + c.lane * 4);
#pragma unroll
                    for (int k = 0; k < 4; ++k) a = xy[j][k] * (f32x2){w[k], w[k]} + a; }
                pe2[0][e] = a.x; pe2[1][e] = a.y; if (e & 1) __builtin_amdgcn_sched_barrier(0); }
#pragma unroll
            for (int hh = 0; hh < 2; ++hh) { const int rrow = hh == 0 ? rowprev : row;
            float pe[16];
#pragma unroll
            for (int e = 0; e < 16; ++e) pe[e] = pe2[hh][e];
            float q8[8], q4[4], q2[2], q1;
            { const bool up = (c.lane & 32) != 0;
#pragma unroll
              for (int k = 0; k < 8; ++k) { const float keep = up ? pe[k + 8] : pe[k], give = up ? pe[k] : pe[k + 8]; q8[k] = keep + __shfl_xor(give, 32); } }
            { const bool up = (c.lane & 16) != 0;
#pragma unroll
              for (int k = 0; k < 4; ++k) { const float keep = up ? q8[k + 4] : q8[k], give = up ? q8[k] : q8[k + 4]; q4[k] = keep + __shfl_xor(give, 16); } }
            { const bool up = (c.lane & 8) != 0;
#pragma unroll
              for (int k = 0; k < 2; ++k) { const float keep = up ? q4[k + 2] : q4[k], give = up ? q4[k] : q4[k + 2]; q2[k] = keep + __shfl_xor(give, 8); } }
            { const bool up = (c.lane & 4) != 0; const float keep = up ? q2[1] : q2[0], give = up ? q2[0] : q2[1]; q1 = keep + __shfl_xor(give, 4); }
            q1 += __shfl_xor(q1, 2); q1 += __shfl_xor(q1, 1);
            float mx = q1;
#pragma unroll
            for (int o = 32; o >= 4; o >>= 1) mx = fmaxf(mx, __shfl_xor(mx, o));
            const float ex = __expf(q1 - mx);
            float den = ex;
#pragma unroll
            for (int o = 32; o >= 4; o >>= 1) den += __shfl_xor(den, o);
            if ((c.lane & 3) == 0) { const int e = c.lane >> 2;
                AFFT[((long)(rrow >> 15) * 16 + e) * NGRP_TOK + (rrow & (NGRP_TOK - 1))] = ex / den; INV_out[(long)rrow * 16 + e] = -1; }
            }
        }
    }
    if (MODE & 2) __syncthreads();
}

DI void topk_phase(const Ctx& c, const float* AFFT, int* IDX, float* GATE, int* INV) {
    LAS unsigned* hist = (LAS unsigned*)c.lds;
    LAS unsigned* sel = hist + 8192;
    LAS unsigned* wsum = hist + 8196;
    for (int prob = c.bid; prob < 2 * NEXP; prob += c.G) {
        const unsigned* a = (const unsigned*)(AFFT + (long)prob * NGRP_TOK + c.tid * 64);
        unsigned prefix = 0u, mask = 0u; unsigned krem = CAP;
#pragma unroll 1
        for (int pass = 0; pass < 4; ++pass) {
            const int shift = 24 - 8 * pass;
            for (int i = c.tid; i < 8192; i += 512) hist[i] = 0u;
            __syncthreads();
#pragma unroll 2
            for (int i = 0; i < 16; ++i) { const u32x4 v = *(const u32x4*)(a + i * 4);
#pragma unroll
                for (int q = 0; q < 4; ++q) if ((v[q] & mask) == prefix) __hip_atomic_fetch_add(&hist[(((v[q] >> shift) & 255u) << 5) | (c.lane & 31)], 1u, __ATOMIC_RELAXED, __HIP_MEMORY_SCOPE_WORKGROUP); }
            __syncthreads();
            if (c.tid < 256) { unsigned t_ = 0u;
#pragma unroll 8
                for (int r = 0; r < 32; ++r) t_ += hist[(c.tid << 5) | ((r + c.tid) & 31)];
                sel[16 + c.tid] = t_; }
            __syncthreads();
            if (c.wave == 0) {
                const unsigned c0 = sel[16 + 4 * c.lane], c1 = sel[16 + 4 * c.lane + 1], c2 = sel[16 + 4 * c.lane + 2], c3 = sel[16 + 4 * c.lane + 3];
                const unsigned s = c0 + c1 + c2 + c3;
                unsigned suf = s;
#pragma unroll
                for (int o = 1; o < 64; o <<= 1) { const unsigned t = __shfl_down(suf, o); if (c.lane + o < 64) suf += t; }
                unsigned above = suf - s;
                if (above < krem && krem <= above + c3) { sel[0] = 4 * c.lane + 3; sel[1] = krem - above; } above += c3;
                if (above < krem && krem <= above + c2) { sel[0] = 4 * c.lane + 2; sel[1] = krem - above; } above += c2;
                if (above < krem && krem <= above + c1) { sel[0] = 4 * c.lane + 1; sel[1] = krem - above; } above += c1;
                if (above < krem && krem <= above + c0) { sel[0] = 4 * c.lane + 0; sel[1] = krem - above; }
            }
            __syncthreads();
            prefix |= sel[0] << shift; mask |= 255u << shift; krem = sel[1];
            __syncthreads();
        }
        unsigned cg = 0u, ce = 0u;
#pragma unroll 2
        for (int i = 0; i < 16; ++i) { const u32x4 v = *(const u32x4*)(a + i * 4);
#pragma unroll
            for (int q = 0; q < 4; ++q) { cg += v[q] > prefix ? 1u : 0u; ce += v[q] == prefix ? 1u : 0u; } }
        const unsigned pk = cg | (ce << 16); unsigned inc = pk;
#pragma unroll
        for (int o = 1; o < 64; o <<= 1) { const unsigned t = __shfl_up(inc, o); if (c.lane >= o) inc += t; }
        if (c.lane == 63) wsum[c.wave] = inc;
        __syncthreads();
        unsigned wbase = 0u;
        for (int w = 0; w < c.wave; ++w) wbase += wsum[w];
        const unsigned exc = wbase + inc - pk;
        unsigned pg = exc & 0xffffu, pe = exc >> 16;
        const unsigned ngt = CAP - krem;
        int* idx = IDX + (long)prob * CAP; float* gate = GATE + (long)prob * CAP;
        const int grp = prob >> 4, e = prob & 15;
#pragma unroll 1
        for (int i = 0; i < 16; ++i) { const u32x4 v = *(const u32x4*)(a + i * 4);
#pragma unroll
            for (int q = 0; q < 4; ++q) {
                int pos = -1;
                if (v[q] > prefix) pos = (int)(pg++);
                else if (v[q] == prefix) { if (pe < krem) pos = (int)(ngt + pe); ++pe; }
                if (pos >= 0) { const int n = c.tid * 64 + i * 4 + q; idx[pos] = n; gate[pos] = __uint_as_float(v[q]); INV[((long)grp * NGRP_TOK + n) * 16 + e] = pos; }
            } }
        __syncthreads();
    }
}

DI void prep_a(const Ctx& c, const bf16_t* QKV, const float* qgain, const float* kgain, unsigned char* Q8, unsigned char* K8, unsigned char* V8T) {
    LAS float* CS = (LAS float*)c.lds;
    for (int i = c.tid; i < 2048; i += 512) { const int pos = i >> 4, j = i & 15; float sn, cs; sincosf((float)pos * exp2f(-(float)j * (13.287712379549449f / 16.0f)), &sn, &cs); CS[i] = cs; CS[2048 + i] = sn; }
    __syncthreads();
    const int hl = c.lane >> 3, half = (c.lane >> 2) & 1, jq = c.lane & 3;
    const int d1 = half * 32 + jq * 4;
    const long nitem = (long)NTOK * 5 / 2;
    for (long it = c.gw; it < nitem; it += c.ngw) {
        const long hg = it * 8 + hl;
        const int row = (int)(hg / 20), hd = (int)(hg % 20);
        const int s = seq_of_row(row), t = row - seq_base(s);
        const int pos = half == 0 ? (t >> 6) : (t & 63);
        const bf16_t* p = QKV + (long)row * 1536 + hd * 64 + d1;
        const u32x2 a = *(const u32x2*)p, b = *(const u32x2*)(p + 16);
        float x1[4] = {bf2f(a.x & 0xffffu), bf2f(a.x >> 16), bf2f(a.y & 0xffffu), bf2f(a.y >> 16)}, x2[4] = {bf2f(b.x & 0xffffu), bf2f(b.x >> 16), bf2f(b.y & 0xffffu), bf2f(b.y >> 16)};
        float ss = 0.f;
#pragma unroll
        for (int q = 0; q < 4; ++q) ss += x1[q] * x1[q] + x2[q] * x2[q];
        ss += __shfl_xor(ss, 1); ss += __shfl_xor(ss, 2); ss += __shfl_xor(ss, 4);
        const float rinv = rsqrtf(ss * (1.0f / 64.0f) + 1e-6f) * (hd < 16 ? 0.125f * LOG2E : 1.0f);
        const float* gn = (hd < 16 ? qgain : kgain) + d1;
        const f32x4 g1 = *(const f32x4*)gn, g2 = *(const f32x4*)(gn + 16);
        const f32x4 cs = *(const LAS f32x4*)(CS + pos * 16 + jq * 4), sn = *(const LAS f32x4*)(CS + 2048 + pos * 16 + jq * 4);
        float o1[4], o2[4];
#pragma unroll
        for (int q = 0; q < 4; ++q) { const float y1 = x1[q] * rinv * g1[q], y2 = x2[q] * rinv * g2[q]; o1[q] = y1 * cs[q] - y2 * sn[q]; o2[q] = y1 * sn[q] + y2 * cs[q]; }
        unsigned char* o8 = hd < 16 ? Q8 + (long)row * 1024 + hd * 64 + d1 : K8 + (long)row * 256 + (hd - 16) * 64 + d1;
        *(unsigned*)o8 = cvt_pk4_fp8(o1[0], o1[1], o1[2], o1[3]); *(unsigned*)(o8 + 16) = cvt_pk4_fp8(o2[0], o2[1], o2[2], o2[3]);
    }
    for (int it = c.gw; it < (NTOK / 64) * 4; it += c.ngw) {
        const int tile = it >> 2, kh = it & 3, row = tile * 64 + c.lane;
        const int sq = seq_of_row(row); const long rb = seq_base(sq); const int S = seq_len(sq), tl = (int)(tile * 64 - rb);
        const int k = c.lane, w = k & 31, pos = ((w >> 2) & 1) * 32 + (k >> 5) * 16 + (w >> 3) * 4 + (w & 3);
        const bf16_t* vp = QKV + (long)row * 1536 + 1280 + kh * 64;
        unsigned char* dst = V8T + rb * 256 + (long)(kh * 64) * S + tl + pos;
#pragma unroll
        for (int q = 0; q < 8; ++q) { const u32x4 v = *(const u32x4*)(vp + q * 8);
            const unsigned p0 = cvt_pk4_fp8(bf2f(v.x & 0xffffu), bf2f(v.x >> 16), bf2f(v.y & 0xffffu), bf2f(v.y >> 16)), p1 = cvt_pk4_fp8(bf2f(v.z & 0xffffu), bf2f(v.z >> 16), bf2f(v.w & 0xffffu), bf2f(v.w >> 16));
#pragma unroll
            for (int e = 0; e < 4; ++e) { dst[(long)(q * 8 + e) * S] = (unsigned char)(p0 >> (8 * e)); dst[(long)(q * 8 + 4 + e) * S] = (unsigned char)(p1 >> (8 * e)); } }
    }
    __syncthreads();
}
#define MFMA32(a, b, c) __builtin_amdgcn_mfma_f32_32x32x16_bf16((a), (b), (c), 0, 0, 0)
typedef short v4i16_t __attribute__((ext_vector_type(4)));
constexpr int KST = 144;
DI s16x4 vtr(const LAS char* p) { return __builtin_bit_cast(s16x4, __builtin_amdgcn_ds_read_tr16_b64_v4i16((LAS v4i16_t*)p)); }
DI bf16x8 pack8(const f32x16& p, int s) {
    u32x4 w; w.x = cvt_pk_bf16(p[8 * s], p[8 * s + 1]); w.y = cvt_pk_bf16(p[8 * s + 2], p[8 * s + 3]); w.z = cvt_pk_bf16(p[8 * s + 4], p[8 * s + 5]); w.w = cvt_pk_bf16(p[8 * s + 6], p[8 * s + 7]);
    return __builtin_bit_cast(bf16x8, w); }
DI float max16(const f32x16& s) {
    float a = fmaxf(fmaxf(s[0], s[1]), fmaxf(s[2], s[3])), b = fmaxf(fmaxf(s[4], s[5]), fmaxf(s[6], s[7]));
    float cc = fmaxf(fmaxf(s[8], s[9]), fmaxf(s[10], s[11])), d = fmaxf(fmaxf(s[12], s[13]), fmaxf(s[14], s[15]));
    return fmaxf(fmaxf(a, b), fmaxf(cc, d)); }
DI float sum16(const f32x16& s) {
    return ((s[0] + s[1]) + (s[2] + s[3])) + ((s[4] + s[5]) + (s[6] + s[7])) + ((s[8] + s[9]) + (s[10] + s[11])) + ((s[12] + s[13]) + (s[14] + s[15])); }
DI f32x16 zero16() { f32x16 z;
#pragma unroll
    for (int i = 0; i < 16; ++i) z[i] = 0.f;
    return z; }
DI void pv_block(const LAS char* Vt, const f32x16& p, f32x16& O0, f32x16& O1, int lane) {
    const int hi = lane >> 5, blk = (lane >> 4) & 1, q4 = (lane & 15) >> 2, pp = lane & 3;
#pragma unroll
    for (int s = 0; s < 2; ++s) {
        const bf16x8 pf = pack8(p, s);
        const LAS char* r0 = Vt + (16 * s + 4 * hi + q4) * KST + 32 * blk + 8 * pp;
        const s16x4 a0 = vtr(r0), a1 = vtr(r0 + 8 * KST), b0 = vtr(r0 + 64), b1 = vtr(r0 + 8 * KST + 64);
        const bf16x8 v0 = __builtin_shufflevector(a0, a1, 0, 1, 2, 3, 4, 5, 6, 7), v1 = __builtin_shufflevector(b0, b1, 0, 1, 2, 3, 4, 5, 6, 7);
        O0 = MFMA32(v0, pf, O0); O1 = MFMA32(v1, pf, O1);
    }
}
constexpr float ATT_THR = 8.0f;
#define LDS_BARRIER() asm volatile("s_waitcnt lgkmcnt(0)\n\ts_barrier" ::: "memory")
#define MX3(a, b, c) __builtin_fmaxf(__builtin_fmaxf((a), (b)), (c))
DI float rowmax32x(const f32x16& p0, const f32x16& p1) {
    float a = MX3(p0[0], p0[1], p1[0]), b = MX3(p0[2], p0[3], p1[1]); a = MX3(a, p1[2], p1[3]);
#pragma unroll
    for (int r = 4; r < 16; r += 4) { a = MX3(a, p0[r], p0[r + 1]); b = MX3(b, p0[r + 2], p0[r + 3]); a = MX3(a, p1[r], p1[r + 1]); b = MX3(b, p1[r + 2], p1[r + 3]); }
    const float mm = __builtin_fmaxf(a, b);
    const auto rr = __builtin_amdgcn_permlane32_swap(__float_as_uint(mm), __float_as_uint(mm), false, false);
    return __builtin_fmaxf(__uint_as_float(rr[0]), __uint_as_float(rr[1])); }
DI float make_qx(float m, int hi, bf16x8& qx) {
    const unsigned h = cvt_pk_bf16(-m, 0.f) & 0xffffu; const float hf = bf2f(h);
    const unsigned lo = cvt_pk_bf16(-m - hf, 0.f) & 0xffffu; const float lf = bf2f(lo);
    u32x4 w; w.x = hi == 0 ? (h | (lo << 16)) : 0u; w.y = 0u; w.z = 0u; w.w = 0u; qx = __builtin_bit_cast(bf16x8, w);
    return -(hf + lf); }
DI void qk_tile_x(const LAS char* Klane, const bf16x8 (&qf)[4], const bf16x8& kx, const bf16x8& qx, f32x16& s0, f32x16& s1) {
    s0 = MFMA32(kx, qx, zero16()); s1 = MFMA32(kx, qx, zero16());
#pragma unroll
    for (int ks = 0; ks < 4; ++ks) {
        const bf16x8 k0 = *(const LAS bf16x8*)(Klane + ks * 32), k1 = *(const LAS bf16x8*)(Klane + 32 * KST + ks * 32);
        s0 = MFMA32(k0, qf[ks], s0); s1 = MFMA32(k1, qf[ks], s1); }
}
DI void exp_pack_x(f32x16& s0, f32x16& s1, bf16x8 (&pf)[4]) {
#pragma unroll
    for (int r = 0; r < 16; ++r) { s0[r] = fast_exp2(s0[r]); s1[r] = fast_exp2(s1[r]); }
    pf[0] = pack8(s0, 0); pf[1] = pack8(s0, 1); pf[2] = pack8(s1, 0); pf[3] = pack8(s1, 1);
}
DI void pv_tile_x(const LAS char* Vlane, const bf16x8 (&pf)[4], const bf16x8& ones, f32x16& O0, f32x16& O1, f32x16& Ls) {
#pragma unroll
    for (int ks = 0; ks < 4; ++ks) {
        const LAS char* r0 = Vlane + 16 * ks * KST;
        const s16x4 a0 = vtr(r0), a1 = vtr(r0 + 8 * KST), b0 = vtr(r0 + 64), b1 = vtr(r0 + 8 * KST + 64);
        const bf16x8 v0 = __builtin_shufflevector(a0, a1, 0, 1, 2, 3, 4, 5, 6, 7), v1 = __builtin_shufflevector(b0, b1, 0, 1, 2, 3, 4, 5, 6, 7);
        O0 = MFMA32(v0, pf[ks], O0); O1 = MFMA32(v1, pf[ks], O1); Ls = MFMA32(ones, pf[ks], Ls);
    }
}
DI void pv_tile(const LAS char* Vt, const bf16x8 (&pf)[4], f32x16& O0, f32x16& O1, int lane) {
    const int hi = lane >> 5, blk = (lane >> 4) & 1, q4 = (lane & 15) >> 2, pp = lane & 3;
#pragma unroll
    for (int ks = 0; ks < 4; ++ks) {
        const LAS char* r0 = Vt + (16 * ks + 4 * hi + q4) * KST + 32 * blk + 8 * pp;
        const s16x4 a0 = vtr(r0), a1 = vtr(r0 + 8 * KST), b0 = vtr(r0 + 64), b1 = vtr(r0 + 8 * KST + 64);
        const bf16x8 v0 = __builtin_shufflevector(a0, a1, 0, 1, 2, 3, 4, 5, 6, 7), v1 = __builtin_shufflevector(b0, b1, 0, 1, 2, 3, 4, 5, 6, 7);
        O0 = MFMA32(v0, pf[ks], O0); O1 = MFMA32(v1, pf[ks], O1);
    }
}
#define MFMA_ACC(acc, a, b) acc = MFMA32(a, b, acc)
constexpr int KST8 = 80;
constexpr float A8_TGT = 6.0f, A8_HI = 8.0f;
#define MFMA8(a, b, c) __builtin_amdgcn_mfma_scale_f32_32x32x64_f8f6f4((a), (b), (c), 0, 0, 0, 127, 0, 127)
DI i32x8 cat8(const u32x4& lo, const u32x4& hi) { return __builtin_bit_cast(i32x8, __builtin_shufflevector(lo, hi, 0, 1, 2, 3, 4, 5, 6, 7)); }
DI void attn_a_phase(const Ctx& c, const unsigned char* Q8, const unsigned char* K8, const unsigned char* V8T, bf16_t* OB) {
    constexpr int SLOT8 = 64 * KST8, NK = 3, NV = 4;
    const int r32 = c.lane & 31, hi = c.lane >> 5;
    LAS char* KB = (LAS char*)c.lds; LAS char* VB = KB + NK * SLOT8;
    const LAS char* Klane = KB + r32 * KST8 + hi * 32;
    const LAS char* Vlane = VB + r32 * KST8 + hi * 32;
    i32x8 ones8 = {0x38383838, 0x38383838, 0x38383838, 0x38383838, 0x38383838, 0x38383838, 0x38383838, 0x38383838};
    asm volatile("" : "+v"(ones8));
    const bool kld = c.wave < 4;
    const int pr = (c.tid & 255) >> 2, pc4 = (c.tid & 3) * 16, ldp = pr * KST8 + pc4;
    for (int L = c.bid; L < 4096; L += c.G) {
        int s, kh, qblk;
        if (L < 2048) { s = L >> 8; kh = (L >> 6) & 3; qblk = L & 63; } else { const int u = L - 2048; s = 8 + (u >> 9); kh = (u >> 7) & 3; qblk = u & 127; }
        const int S = seq_len(s); const long rb = seq_base(s);
        const int hq = kh * 4 + (c.wave >> 1), q0 = qblk * 64 + (c.wave & 1) * 32;
        i32x8 qf8;
        { const unsigned char* qp = Q8 + (rb + q0 + r32) * 1024 + hq * 64 + hi * 32; qf8 = cat8(*(const u32x4*)qp, *(const u32x4*)(qp + 16)); }
        const unsigned char* src = kld ? K8 + (rb + pr) * 256 + kh * 64 + pc4 : V8T + rb * 256 + (long)(kh * 64 + pr) * S + pc4;
        const long tstep = kld ? 64l * 256 : 64l;
        const int NT = S >> 6;
#define A_LOAD(tile) do { preg = *(const u32x4*)(src + (long)(tile) * tstep); } while (0)
#define A_STORE(tile) do { if (kld) *(LAS u32x4*)(KB + ((tile) % NK) * SLOT8 + ldp) = preg; else *(LAS u32x4*)(VB + ((tile) % NV) * SLOT8 + ldp) = preg; } while (0)
        u32x4 preg;
        A_LOAD(0); A_STORE(0); A_LOAD(1); A_STORE(1); A_LOAD(2);
        __syncthreads();
        f32x16 O0 = zero16(), O1 = zero16(), Ls = zero16(), sa0, sa1, sb0, sb1;
        i32x8 p8 = {0, 0, 0, 0, 0, 0, 0, 0};
        u32x4 vl0, vh0, vl1, vh1;
        float m, msc;
#define A_KFR(kbase) const u32x4 kl0_ = *(const LAS u32x4*)(kbase), kh0_ = *(const LAS u32x4*)((kbase) + 16), kl1_ = *(const LAS u32x4*)((kbase) + 32 * KST8), kh1_ = *(const LAS u32x4*)((kbase) + 32 * KST8 + 16)
#define A_QK(S0, S1) do { __builtin_amdgcn_s_setprio(1); S0 = MFMA8(cat8(kl0_, kh0_), qf8, zero16()); S1 = MFMA8(cat8(kl1_, kh1_), qf8, zero16()); __builtin_amdgcn_s_setprio(0); } while (0)
#define A_VFR(vbase) do { vl0 = *(const LAS u32x4*)(vbase); vh0 = *(const LAS u32x4*)((vbase) + 16); vl1 = *(const LAS u32x4*)((vbase) + 32 * KST8); vh1 = *(const LAS u32x4*)((vbase) + 32 * KST8 + 16); } while (0)
#define A_EXP(S0, S1) do { \
            _Pragma("unroll") for (int r = 0; r < 16; ++r) { S0[r] = fast_exp2(S0[r]); S1[r] = fast_exp2(S1[r]); } \
            _Pragma("unroll") for (int w = 0; w < 4; ++w) { p8[w] = (int)cvt_pk4_fp8_sc((unsigned)p8[w], S0[4 * w], S0[4 * w + 1], S0[4 * w + 2], S0[4 * w + 3], msc); \
                                                            p8[4 + w] = (int)cvt_pk4_fp8_sc((unsigned)p8[4 + w], S1[4 * w], S1[4 * w + 1], S1[4 * w + 2], S1[4 * w + 3], msc); } } while (0)
#define A_PV() do { __builtin_amdgcn_s_setprio(1); O0 = MFMA8(cat8(vl0, vh0), p8, O0); O1 = MFMA8(cat8(vl1, vh1), p8, O1); Ls = MFMA8(ones8, p8, Ls); __builtin_amdgcn_s_setprio(0); } while (0)
#define A_TAIL(t_) do { A_STORE((t_) + 2); asm volatile("" ::: "memory"); A_VFR(Vlane + ((t_) % NV) * SLOT8); asm volatile("s_waitcnt lgkmcnt(4)\n\ts_barrier" ::: "memory"); } while (0)
        { A_KFR(Klane); A_QK(sa0, sa1); }
        { const float mx = rowmax32x(sa0, sa1); m = __builtin_floorf(mx) - A8_TGT; msc = __int_as_float(((int)m + 127) << 23); }
        { A_KFR(Klane + SLOT8); A_EXP(sa0, sa1); A_QK(sb0, sb1); }
        A_TAIL(0);
#define A_BLOCK(t_, SI0, SI1, SO0, SO1) do { \
            { const int tl_ = (t_) + 2 < NT ? (t_) + 2 : NT - 1; A_LOAD(tl_); } \
            A_KFR(Klane + (((t_) + 1) % NK) * SLOT8); \
            A_PV(); \
            const float mx = rowmax32x(SI0, SI1); \
            if (__any(mx - m > A8_HI)) { \
                const float mn = __builtin_fmaxf(__builtin_floorf(mx) - A8_TGT, m), al = fast_exp2(m - mn); m = mn; msc = __int_as_float(((int)m + 127) << 23); \
                _Pragma("unroll") for (int r = 0; r < 16; ++r) { O0[r] *= al; O1[r] *= al; Ls[r] *= al; } } \
            A_EXP(SI0, SI1); \
            A_QK(SO0, SO1); \
            A_TAIL(t_); } while (0)
        for (int t = 1; t + 1 < NT; t += 2) { A_BLOCK(t, sb0, sb1, sa0, sa1); A_BLOCK(t + 1, sa0, sa1, sb0, sb1); }
        A_BLOCK(NT - 1, sb0, sb1, sa0, sa1);
        A_PV();
#undef A_KFR
#undef A_QK
#undef A_VFR
#undef A_EXP
#undef A_PV
#undef A_TAIL
#undef A_BLOCK
#undef A_LOAD
#undef A_STORE
        const float inv = fast_rcp(Ls[0]) * 64.0f;
        unsigned char* op = (unsigned char*)OB + (rb + q0 + r32) * DM + hq * 64 + 4 * hi;
#pragma unroll
        for (int j = 0; j < 4; ++j) {
            *(unsigned*)(op + 8 * j) = cvt_pk4_fp8(O0[4 * j] * inv, O0[4 * j + 1] * inv, O0[4 * j + 2] * inv, O0[4 * j + 3] * inv);
            *(unsigned*)(op + 32 + 8 * j) = cvt_pk4_fp8(O1[4 * j] * inv, O1[4 * j + 1] * inv, O1[4 * j + 2] * inv, O1[4 * j + 3] * inv); }
        __syncthreads();
    }
}

DI int t5_bucket(int rel) {
    const int n = rel < 0 ? -rel : rel;
    int large = 8 + (int)(logf((float)(n < 1 ? 1 : n) / 8.0f) / 2.772588722239781f * 8.0f);
    large = large < 15 ? large : 15;
    return (rel > 0 ? 16 : 0) + (n < 8 ? n : large);
}
DI void attn_d_phase(const Ctx& c, const bf16_t* QKV, bf16_t* OB, const float* rel_bias, const float* dlam, const float* ngain, float lambda_init) {
    constexpr int LQ = 2304, SLOT = 64 * KST;
    const int r32 = c.lane & 31, hi = c.lane >> 5;
    LAS char* KB = (LAS char*)c.lds; LAS char* VB = KB + 2 * SLOT;
    LAS float* LUT = (LAS float*)(c.lds + 4 * SLOT);
    for (int i = c.tid; i < 12 * 256; i += 512) { const int h = i >> 8, e = i & 255; const int rel = (e < 255 ? e : 254) - 127; LUT[i] = rel_bias[t5_bucket(rel) * 12 + h] * LOG2E; }
    float lam;
    { const int i = c.lane & 31; const float a = wave_sum(c.lane < 32 ? dlam[i] * dlam[32 + i] : 0.f), b = wave_sum(c.lane < 32 ? dlam[64 + i] * dlam[96 + i] : 0.f);
      lam = __expf(a) - __expf(b) + lambda_init; }
    const LAS char* Klane = KB + r32 * KST + hi * 16;
    const LAS char* Vlane = VB + (4 * hi + ((c.lane & 15) >> 2)) * KST + 32 * ((c.lane >> 4) & 1) + 8 * (c.lane & 3);
    bf16x8 kx;
    { u32x4 w; w.x = hi == 0 ? 0x3F803F80u : 0u; w.y = 0u; w.z = 0u; w.w = 0u; kx = __builtin_bit_cast(bf16x8, w); }
    __syncthreads();
    for (int L = c.bid; L < 3072; L += c.G) {
        int s, h, qblk;
        if (L < 1536) { s = L / 192; const int r = L % 192; h = r >> 4; qblk = r & 15; } else { const int u = L - 1536; s = 8 + u / 384; const int r = u % 384; h = r >> 5; qblk = r & 31; }
        const int S = seq_len(s); const long rb = seq_base(s);
        const int q0 = qblk * 256 + c.wave * 32;
        bf16x8 qf[2][2];
        { const bf16_t* qp = QKV + (rb + q0 + r32) * LQ + h * 64 + hi * 8;
#pragma unroll
          for (int mm = 0; mm < 2; ++mm)
#pragma unroll
              for (int ks = 0; ks < 2; ++ks) qf[mm][ks] = *(const bf16x8*)(qp + mm * 32 + ks * 16); }
        const bf16_t* kg = QKV + (rb + (c.tid >> 3)) * LQ + 768 + h * 64 + (c.tid & 7) * 8;
        const int ldst = (c.tid >> 3) * KST + (c.tid & 7) * 16;
        u32x4 kr = *(const u32x4*)kg, vr = *(const u32x4*)(kg + 768);
        *(LAS u32x4*)(KB + ldst) = kr; *(LAS u32x4*)(VB + ldst) = vr;
        asm volatile("" :: "v"(qf[0][0]), "v"(qf[0][1]), "v"(qf[1][0]), "v"(qf[1][1]));
        __syncthreads();
        f32x16 Oa0 = zero16(), Oa1 = zero16(), Ob0 = zero16(), Ob1 = zero16();
        const LAS float* lut = LUT + h * 256;
        const float bneg = lut[0], bpos = lut[254];
        bf16x8 qxa, qxb; float ra = make_qx(-100.f, hi, qxa), rbb = make_qx(-100.f, hi, qxb), la = 0.f, lb = 0.f, boff = 0.f;
        const int NT = S >> 6;
        for (int t = 0; t < NT; ++t) {
            const int buf = t & 1;
            if (t + 1 < NT) { const bf16_t* kn = kg + (long)(t + 1) * 64 * LQ; kr = *(const u32x4*)kn; vr = *(const u32x4*)(kn + 768); }
            const LAS char* Kt = Klane + buf * SLOT; const LAS char* Vt = Vlane + buf * SLOT;
            const int k0 = t * 64, dmin = k0 - (q0 + 31), dmax = k0 + 63 - q0;
            const bool near = (dmax > -127) && (dmin < 127);
            const float bnew = near ? 0.f : (dmax <= -127 ? bneg : bpos);
            if (bnew != boff) { ra = make_qx(ra + boff - bnew, hi, qxa); rbb = make_qx(rbb + boff - bnew, hi, qxb); boff = bnew; }
            bf16x8 pa[4], pb[4];
#define D_BRANCH(KOFF, QF, QX, RR, LL, O0_, O1_, PP) do { \
                f32x16 s0 = MFMA32(kx, QX, zero16()), s1 = MFMA32(kx, QX, zero16()); \
                _Pragma("unroll") for (int ks = 0; ks < 2; ++ks) { \
                    const bf16x8 k0_ = *(const LAS bf16x8*)(Kt + (KOFF) + ks * 32), k1_ = *(const LAS bf16x8*)(Kt + 32 * KST + (KOFF) + ks * 32); \
                    s0 = MFMA32(k0_, QF[ks], s0); s1 = MFMA32(k1_, QF[ks], s1); } \
                if (near) { int relb = k0 + 4 * hi - (q0 + r32); asm volatile("" : "+v"(relb)); \
                    _Pragma("unroll") for (int r = 0; r < 16; ++r) { int rel = relb + (r & 3) + 8 * (r >> 2); int r1 = rel + 32; \
                        rel = rel < -127 ? -127 : (rel > 127 ? 127 : rel); r1 = r1 < -127 ? -127 : (r1 > 127 ? 127 : r1); s0[r] += lut[rel + 127]; s1[r] += lut[r1 + 127]; \
                        if ((r & 3) == 3) __builtin_amdgcn_sched_barrier(0); } } \
                const float mx = rowmax32x(s0, s1); \
                if (__any(mx > ATT_THR)) { \
                    const float ro = RR; RR = make_qx(RR + __builtin_fmaxf(mx, 0.f), hi, QX); const float d = RR - ro, al = fast_exp2(-d); LL *= al; \
                    _Pragma("unroll") for (int r = 0; r < 16; ++r) { s0[r] -= d; s1[r] -= d; O0_[r] *= al; O1_[r] *= al; } } \
                exp_pack_x(s0, s1, PP); { const f32x16 t_ = s0 + s1; LL += sum16(t_); } } while (0)
            D_BRANCH(0, qf[0], qxa, ra, la, Oa0, Oa1, pa);
            D_BRANCH(64, qf[1], qxb, rbb, lb, Ob0, Ob1, pb);
#undef D_BRANCH
#pragma unroll
            for (int ks = 0; ks < 4; ++ks) {
                const LAS char* r0 = Vt + 16 * ks * KST;
                const s16x4 x0 = vtr(r0), x1 = vtr(r0 + 8 * KST), y0 = vtr(r0 + 64), y1 = vtr(r0 + 8 * KST + 64);
                const bf16x8 v0 = __builtin_shufflevector(x0, x1, 0, 1, 2, 3, 4, 5, 6, 7), v1 = __builtin_shufflevector(y0, y1, 0, 1, 2, 3, 4, 5, 6, 7);
                Oa0 = MFMA32(v0, pa[ks], Oa0); Oa1 = MFMA32(v1, pa[ks], Oa1); Ob0 = MFMA32(v0, pb[ks], Ob0); Ob1 = MFMA32(v1, pb[ks], Ob1);
            }
            if (t + 1 < NT) { *(LAS u32x4*)(KB + (buf ^ 1) * SLOT + ldst) = kr; *(LAS u32x4*)(VB + (buf ^ 1) * SLOT + ldst) = vr; }
            __syncthreads();
        }
        la += __shfl_xor(la, 32); lb += __shfl_xor(lb, 32);
        const float ia = fast_rcp(la), ib = lam * fast_rcp(lb);
        float ss = 0.f;
#pragma unroll
        for (int r = 0; r < 16; ++r) { Oa0[r] = Oa0[r] * ia - Ob0[r] * ib; Oa1[r] = Oa1[r] * ia - Ob1[r] * ib; ss += Oa0[r] * Oa0[r] + Oa1[r] * Oa1[r]; }
        ss += __shfl_xor(ss, 32);
        const float rn = rsqrtf(ss * (1.0f / 64.0f) + 1e-6f) * (1.0f - lambda_init);
        bf16_t* op = OB + (rb + q0 + r32) * 768 + h * 64 + 4 * hi;
#pragma unroll
        for (int j = 0; j < 4; ++j) {
            const f32x4 g0 = *(const f32x4*)(ngain + 8 * j + 4 * hi), g1 = *(const f32x4*)(ngain + 32 + 8 * j + 4 * hi);
            u32x2 w0, w1;
            w0.x = cvt_pk_bf16(Oa0[4 * j] * rn * g0[0], Oa0[4 * j + 1] * rn * g0[1]); w0.y = cvt_pk_bf16(Oa0[4 * j + 2] * rn * g0[2], Oa0[4 * j + 3] * rn * g0[3]);
            w1.x = cvt_pk_bf16(Oa1[4 * j] * rn * g1[0], Oa1[4 * j + 1] * rn * g1[1]); w1.y = cvt_pk_bf16(Oa1[4 * j + 2] * rn * g1[2], Oa1[4 * j + 3] * rn * g1[3]);
            *(u32x2*)(op + 8 * j) = w0; *(u32x2*)(op + 32 + 8 * j) = w1; }
    }
    __syncthreads();
}

DI void attn_b_phase(const Ctx& c, const bf16_t* QKV, bf16_t* OB, const float* rel_bias) {
    constexpr int LQ = 2304;
    const int r32 = c.lane & 31, hi = c.lane >> 5;
    LAS float* LUT = (LAS float*)c.lds;
    LAS char* Vw = (LAS char*)c.lds + 8192 + c.wave * (32 * KST);
    for (int i = c.tid; i < 12 * 132; i += 512) { const int gh = i / 132, jj = i % 132; const int g = gh >> 2, d = g == 0 ? 1 : (g == 1 ? 4 : 16);
        LUT[i] = jj <= 128 ? rel_bias[t5_bucket(d * (jj - 64)) * 12 + gh] * LOG2E : 0.f; }
    __syncthreads();
    for (int L = c.bid; L < 1024; L += c.G) {
        int s, rem;
        if (L < 512) { s = L >> 6; rem = L & 63; } else { s = 8 + ((L - 512) >> 7); rem = (L - 512) & 127; }
        const int S = seq_len(s); const long rb = seq_base(s);
        const int hh = rem & 3, rhalf = (rem >> 2) & 1, blk = rem >> 3;
        const int t0 = blk * 512 + rhalf * 8 + c.wave;
        const int qpos = t0 + 16 * r32;
        f32x16 O[3][2]; float mg[3], lg[3];
#pragma unroll
        for (int g = 0; g < 3; ++g) {
            const int d = g == 0 ? 1 : (g == 1 ? 4 : 16), dsh = g == 0 ? 0 : (g == 1 ? 2 : 4), ntile = g == 0 ? 20 : (g == 1 ? 8 : 5);
            const int head = g * 4 + hh;
            bf16x8 qf[4];
            { const bf16_t* qp = QKV + (rb + qpos) * LQ + head * 64 + hi * 8;
#pragma unroll
              for (int ks = 0; ks < 4; ++ks) qf[ks] = *(const bf16x8*)(qp + ks * 16); }
            const LAS float* lut = LUT + (g * 4 + hh) * 132;
            f32x16 O0 = zero16(), O1 = zero16(); float m = -INFINITY, l = 0.f;
            const int kbase = t0 - 64 * d;
#pragma unroll 1
            for (int j = 0; j < ntile; ++j) {
                int kp = kbase + d * (32 * j + r32); kp = kp < 0 ? 0 : (kp >= S ? S - 1 : kp);
                const bf16_t* kr = QKV + (rb + kp) * LQ + 768 + head * 64 + hi * 8;
                bf16x8 kf[4];
#pragma unroll
                for (int ks = 0; ks < 4; ++ks) kf[ks] = *(const bf16x8*)(kr + ks * 16);
                u32x4 vv[4];
#pragma unroll
                for (int i = 0; i < 4; ++i) { const int id = c.lane + 64 * i, e = id >> 3; int vp = kbase + d * (32 * j + e); vp = vp < 0 ? 0 : (vp >= S ? S - 1 : vp);
                    vv[i] = *(const u32x4*)(QKV + (rb + vp) * LQ + 1536 + head * 64 + (id & 7) * 8); }
                f32x16 sc = zero16();
#pragma unroll
                for (int ks = 0; ks < 4; ++ks) sc = MFMA32(kf[ks], qf[ks], sc);
                float mx = -INFINITY;
                if ((kbase + d * 32 * j >= 0) && (kbase + d * (32 * j + 31) < S)) {
                    const int JB = 32 * j + 4 * hi - (16 >> dsh) * r32;
#pragma unroll
                    for (int r = 0; r < 16; ++r) {
                        const int jj = JB + (r & 3) + 8 * (r >> 2);
                        const bool ok = (unsigned)jj <= 128u;
                        const float bv = lut[ok ? jj : 0];
                        sc[r] = ok ? sc[r] * (0.125f * LOG2E) + bv : -INFINITY;
                        mx = fmaxf(mx, sc[r]);
                    }
                } else {
#pragma unroll
                for (int r = 0; r < 16; ++r) {
                    const int e = (r & 3) + 8 * (r >> 2) + 4 * hi;
                    const int kpos = kbase + d * (32 * j + e), rel = kpos - qpos;
                    const int jj = (rel >> dsh) + 64;
                    const bool ok = (jj >= 0) && (jj <= 128) && (kpos >= 0) && (kpos < S);
                    const float bv = lut[ok ? jj : 0];
                    sc[r] = ok ? sc[r] * (0.125f * LOG2E) + bv : -INFINITY;
                    mx = fmaxf(mx, sc[r]);
                }
                }
                { const auto rr = __builtin_amdgcn_permlane32_swap(__float_as_uint(mx), __float_as_uint(mx), false, false); mx = fmaxf(__uint_as_float(rr[0]), __uint_as_float(rr[1])); }
                const float mn = fmaxf(m, mx), msafe = (mn == -INFINITY) ? 0.f : mn, alpha = fast_exp2(m - msafe);
                m = mn;
#pragma unroll
                for (int r = 0; r < 16; ++r) sc[r] = fast_exp2(sc[r] - msafe);
                l = l * alpha + sum16(sc);
                O0 = O0 * alpha; O1 = O1 * alpha;
#pragma unroll
                for (int i = 0; i < 4; ++i) { const int id = c.lane + 64 * i; *(LAS u32x4*)(Vw + (id >> 3) * KST + (id & 7) * 16) = vv[i]; }
                asm volatile("s_waitcnt lgkmcnt(0)" ::: "memory");
                pv_block(Vw, sc, O0, O1, c.lane);
                asm volatile("s_waitcnt lgkmcnt(0)" ::: "memory");
            }
            l += __shfl_xor(l, 32);
            O[g][0] = O0; O[g][1] = O1; mg[g] = m; lg[g] = l;
        }
        const float M = fmaxf(fmaxf(mg[0], mg[1]), mg[2]);
        const float e0 = fast_exp2(mg[0] - M), e1 = fast_exp2(mg[1] - M), e2 = fast_exp2(mg[2] - M);
        const float inv = fast_rcp(lg[0] * e0 + lg[1] * e1 + lg[2] * e2);
        const float wg[3] = {e0 * inv, e1 * inv, e2 * inv};
#pragma unroll
        for (int g = 0; g < 3; ++g) {
            bf16_t* op = OB + (rb + qpos) * 768 + (g * 4 + hh) * 64 + 4 * hi;
#pragma unroll
            for (int j = 0; j < 4; ++j) {
                u32x2 w0, w1;
                w0.x = cvt_pk_bf16(O[g][0][4 * j] * wg[g], O[g][0][4 * j + 1] * wg[g]); w0.y = cvt_pk_bf16(O[g][0][4 * j + 2] * wg[g], O[g][0][4 * j + 3] * wg[g]);
                w1.x = cvt_pk_bf16(O[g][1][4 * j] * wg[g], O[g][1][4 * j + 1] * wg[g]); w1.y = cvt_pk_bf16(O[g][1][4 * j + 2] * wg[g], O[g][1][4 * j + 3] * wg[g]);
                *(u32x2*)(op + 8 * j) = w0; *(u32x2*)(op + 32 + 8 * j) = w1; }
        }
    }
    __syncthreads();
}
DI void s5_tables(const Ctx& c, const float* lam_re, const float* lam_im, const float* log_dt, const float* b_re, const float* b_im, const float* c_re, const float* c_im,
                  bf16_t* Mt, bf16_t* Pt, float* APL, float* KKG) {
    LAS float* AP = (LAS float*)c.lds;
    LAS float* BB = AP + 2 * 33 * 64 * 2;
    LAS float* CC = BB + 2 * 64 * 16 * 2;
    for (int item = c.bid; item < 256; item += c.G) {
        const int g = item >> 2, qt = item & 3;
        if (c.tid < 128) {
            const int dir = c.tid >> 6, p = c.tid & 63;
            const float lr = lam_re[(dir * 64 + g) * 64 + p], li = lam_im[(dir * 64 + g) * 64 + p];
            const float dt = expf(log_dt[dir * 64 + g]);
            const float mag = expf(lr * dt);
            const float th = li * dt;
            float sn_, cs_; sincosf(th, &sn_, &cs_); const float ar = mag * cs_, ai = mag * sn_;
            const float den = lr * lr + li * li;
            const float zr = ((ar - 1.0f) * lr + ai * li) / den, zi = (ai * lr - (ar - 1.0f) * li) / den;
            double pr = 1.0, pi = 0.0;
            for (int t = 0; t <= 32; ++t) { AP[((dir * 33 + t) * 64 + p) * 2] = (float)pr; AP[((dir * 33 + t) * 64 + p) * 2 + 1] = (float)pi;
                const double nr = pr * (double)ar - pi * (double)ai, ni = pr * (double)ai + pi * (double)ar; pr = nr; pi = ni; }
            for (int j = 0; j < 16; ++j) { const float br = b_re[((dir * 64 + g) * 64 + p) * 16 + j], bi = b_im[((dir * 64 + g) * 64 + p) * 16 + j];
                BB[((dir * 64 + p) * 16 + j) * 2] = zr * br - zi * bi; BB[((dir * 64 + p) * 16 + j) * 2 + 1] = zr * bi + zi * br; }
        }
        for (int i = c.tid; i < 2 * 16 * 64; i += 512) { const int dir = i >> 10, r = i & 1023;
            CC[i * 2] = c_re[(dir * 64 + g) * 1024 + r]; CC[i * 2 + 1] = c_im[(dir * 64 + g) * 1024 + r]; }
        __syncthreads();
        if (qt == 0 && c.tid < 128) { const int dir = c.tid >> 6, p = c.tid & 63; APL[((g * 2 + dir) * 64 + p) * 2] = AP[((dir * 33 + 32) * 64 + p) * 2]; APL[((g * 2 + dir) * 64 + p) * 2 + 1] = AP[((dir * 33 + 32) * 64 + p) * 2 + 1]; }
        if (c.tid < 256) {
            const int dir = c.tid >> 7, tau = 8 * qt + ((c.tid >> 4) & 7), j = c.tid & 15;
            float acc[16];
#pragma unroll
            for (int jp = 0; jp < 16; ++jp) acc[jp] = 0.f;
            for (int p = 0; p < 64; ++p) {
                const f32x2 cc = *(const LAS f32x2*)(CC + ((dir * 16 + j) * 64 + p) * 2), ee = *(const LAS f32x2*)(AP + ((dir * 33 + tau) * 64 + p) * 2);
                const float wr = cc.x * ee.x - cc.y * ee.y, wi = cc.x * ee.y + cc.y * ee.x;
                const LAS f32x4* bb = (const LAS f32x4*)(BB + (dir * 64 + p) * 32);
#pragma unroll
                for (int q4 = 0; q4 < 8; ++q4) { const f32x4 b = bb[q4]; acc[2 * q4] += wr * b[0] - wi * b[1]; acc[2 * q4 + 1] += wr * b[2] - wi * b[3]; }
            }
            float* kk = KKG + ((size_t)g * 2 + dir) * 8192 + (tau * 16 + j) * 16;
#pragma unroll
            for (int q4 = 0; q4 < 4; ++q4) *(f32x4*)(kk + 4 * q4) = (f32x4){acc[4 * q4], acc[4 * q4 + 1], acc[4 * q4 + 2], acc[4 * q4 + 3]};
        }
        bf16_t* mt = Mt + (long)g * 512 * 768;
        for (int o = c.tid; o < 128 * 128; o += 512) {
            const int n = 128 * qt + (o >> 7), k = 512 + (o & 127) * 2, i = n >> 4, j = n & 15;
            float v[2];
#pragma unroll
            for (int e = 0; e < 2; ++e) { const int q = k + e - 512, dir = q >> 7, part = (q >> 6) & 1, p = q & 63, pw = dir == 0 ? i + 1 : 32 - i;
                const float cr = CC[((dir * 16 + j) * 64 + p) * 2], ci = CC[((dir * 16 + j) * 64 + p) * 2 + 1];
                const float er = AP[((dir * 33 + pw) * 64 + p) * 2], ei = AP[((dir * 33 + pw) * 64 + p) * 2 + 1];
                v[e] = part == 0 ? (cr * er - ci * ei) : -(cr * ei + ci * er); }
            *(unsigned*)(mt + (long)n * 768 + k) = cvt_pk_bf16(v[0], v[1]);
        }
        bf16_t* pt = Pt + (long)g * 256 * 512;
        for (int o = c.tid; o < 64 * 256; o += 512) {
            const int q = 64 * qt + (o >> 8), k = (o & 255) * 2, dir = q >> 7, part = (q >> 6) & 1, p = q & 63;
            float v[2];
#pragma unroll
            for (int e = 0; e < 2; ++e) { const int kk = k + e, s = kk >> 4, jp = kk & 15, pw = dir == 0 ? 31 - s : s;
                const float er = AP[((dir * 33 + pw) * 64 + p) * 2], ei = AP[((dir * 33 + pw) * 64 + p) * 2 + 1];
                const float br = BB[((dir * 64 + p) * 16 + jp) * 2], bi = BB[((dir * 64 + p) * 16 + jp) * 2 + 1];
                v[e] = part == 0 ? (er * br - ei * bi) : (er * bi + ei * br); }
            *(unsigned*)(pt + (long)q * 512 + k) = cvt_pk_bf16(v[0], v[1]);
        }
        __syncthreads();
    }
}
DI void s5_fill(const Ctx& c, const float* KKG, bf16_t* Mt) {
    LAS float* KK = (LAS float*)c.lds;
    for (int item = c.bid; item < 256; item += c.G) {
        const int g = item >> 2, qt = item & 3;
        for (int i = c.tid; i < 4096; i += 512) *(LAS f32x4*)(KK + 4 * i) = *(const f32x4*)(KKG + (size_t)g * 16384 + 4 * i);
        __syncthreads();
        bf16_t* mt = Mt + (long)g * 512 * 768;
        for (int o = c.tid; o < 128 * 256; o += 512) {
            const int n = 128 * qt + (o >> 8), k = (o & 255) * 2, i = n >> 4, j = n & 15;
            float v[2];
#pragma unroll
            for (int e = 0; e < 2; ++e) { const int kk = k + e, s = kk >> 4, jp = kk & 15; float x = 0.f;
                if (s <= i) x += KK[((i - s) * 16 + j) * 16 + jp];
                if (s >= i) x += KK[8192 + ((s - i) * 16 + j) * 16 + jp];
                v[e] = x; }
            *(unsigned*)(mt + (long)n * 768 + k) = cvt_pk_bf16(v[0], v[1]);
        }
        __syncthreads();
    }
}
DI void s5_scan(const Ctx& c, const float* PC, const float* APL, bf16_t* UH) {
    for (int wt = c.gw; wt < NSEQ * 64 * 2; wt += c.ngw) {
        const int dir = wt & 1, g = (wt >> 1) & 63, s = wt >> 7;
        const int c0 = seq_base(s) >> 5, nch = seq_len(s) >> 5;
        const float ar = APL[((g * 2 + dir) * 64 + c.lane) * 2], ai = APL[((g * 2 + dir) * 64 + c.lane) * 2 + 1];
        float sr = 0.f, si = 0.f;
        const float* pc = PC + ((long)g * 2048) * 256 + dir * 128 + c.lane;
        bf16_t* uh = UH + ((long)g * 2048) * 768 + 512 + dir * 128 + c.lane;
        for (int cb = 0; cb < nch; cb += 8) {
            float pr[8], pi[8];
#pragma unroll
            for (int u = 0; u < 8; ++u) { const int ch = dir == 0 ? c0 + cb + u : c0 + nch - 1 - (cb + u); pr[u] = pc[(long)ch * 256]; pi[u] = pc[(long)ch * 256 + 64]; }
#pragma unroll
            for (int u = 0; u < 8; ++u) { const int ch = dir == 0 ? c0 + cb + u : c0 + nch - 1 - (cb + u);
                uh[(long)ch * 768] = (bf16_t)(cvt_pk_bf16(sr, 0.f) & 0xffffu); uh[(long)ch * 768 + 64] = (bf16_t)(cvt_pk_bf16(si, 0.f) & 0xffffu);
                const float nr = ar * sr - ai * si + pr[u], ni = ar * si + ai * sr + pi[u]; sr = nr; si = ni; }
        }
    }
}
constexpr size_t MB = 1024 * 1024;
constexpr size_t WS_CTL = 0;
constexpr int    MAX_LAUNCH = 72;
constexpr size_t CTL_BYTES = 1 * MB;
constexpr size_t WS_XB   = WS_CTL + CTL_BYTES;
constexpr size_t WS_R2   = WS_XB + 128 * MB;
constexpr size_t WS_R1   = WS_R2 + 256 * MB;
constexpr size_t WS_WMIX = WS_R1 + 288 * MB;
constexpr size_t WS_WXQ  = WS_WMIX + 8 * MB;
constexpr size_t WS_WXKV = WS_WXQ + 2 * MB;
constexpr size_t WS_WXO  = WS_WXKV + 4 * MB;
constexpr size_t WS_WGU  = WS_WXO + 2 * MB;
constexpr size_t WS_WD   = WS_WGU + 64 * MB;
constexpr size_t WS_MEMB = WS_WD + 32 * MB;
constexpr size_t WS_MEMKV= WS_MEMB + 6 * MB;
constexpr size_t WS_GT   = WS_MEMKV + 12 * MB;
constexpr size_t WS_HT   = WS_GT + 24 * MB;
constexpr size_t WS_AFFT = WS_HT + 24 * MB;
constexpr size_t WS_IDX  = WS_AFFT + 4 * MB;
constexpr size_t WS_GATE = WS_IDX + 1 * MB;
constexpr size_t WS_INV  = WS_GATE + 1 * MB;
constexpr size_t WS_S5MT = WS_INV + 4 * MB;
constexpr size_t WS_S5PT = WS_S5MT + 48 * MB;
constexpr size_t WS_S5AP = WS_S5PT + 16 * MB;
constexpr size_t WS_S5KK = WS_S5AP + 1 * MB;
constexpr size_t WS_X8   = WS_S5KK + 4 * MB;
constexpr size_t WS_END  = WS_X8 + 64 * MB;

constexpr int LDS_BYTES = 152 * 1024;
constexpr int LDS_MISC = 148 * 1024;

#define XB ((bf16_t*)(wsl + WS_XB))
#define OB ((bf16_t*)(wsl + WS_R2))
#define YE ((bf16_t*)(wsl + WS_R2))
#define PC ((float*)(wsl + WS_R2 + 128 * MB))
#define QKV ((bf16_t*)(wsl + WS_R1))
#define HB ((bf16_t*)(wsl + WS_R1))
#define UH ((bf16_t*)(wsl + WS_R1))
#define WMIX ((bf16_t*)(wsl + WS_WMIX))
#define WXQ ((bf16_t*)(wsl + WS_WXQ))
#define WXKV ((bf16_t*)(wsl + WS_WXKV))
#define WXO ((bf16_t*)(wsl + WS_WXO))
#define WGU ((bf16_t*)(wsl + WS_WGU))
#define WD ((bf16_t*)(wsl + WS_WD))
#define MEMB ((bf16_t*)(wsl + WS_MEMB))
#define MEMKV ((bf16_t*)(wsl + WS_MEMKV))
#define GT ((bf16_t*)(wsl + WS_GT))
#define HT ((bf16_t*)(wsl + WS_HT))
#define AFFT ((float*)(wsl + WS_AFFT))
#define IDX ((int*)(wsl + WS_IDX))
#define GATE ((float*)(wsl + WS_GATE))
#define INV ((int*)(wsl + WS_INV))
#define S5MT ((bf16_t*)(wsl + WS_S5MT))
#define S5PT ((bf16_t*)(wsl + WS_S5PT))
#define S5AP ((float*)(wsl + WS_S5AP))
#define S5KK ((float*)(wsl + WS_S5KK))
#define WMIX2 (WMIX + 2304 * 1024)
#define AQ8 ((unsigned char*)(wsl + WS_R2 + 128 * MB))
#define AK8 ((unsigned char*)(wsl + WS_R2 + 192 * MB))
#define AV8T ((unsigned char*)(wsl + WS_R2 + 208 * MB))
#define X8 ((bf16_t*)(wsl + WS_X8))
#define HSUB ((bf16_t*)(wsl + WS_R1))
DI const float* inp_ld(int k) { unsigned a = (unsigned)(148 * 1024 + 64 + 8 * k); asm volatile("" : "+v"(a));
    const LAS unsigned* t = (const LAS unsigned*)a; const unsigned lo = __builtin_amdgcn_readfirstlane(t[0]), hi = __builtin_amdgcn_readfirstlane(t[1]);
    return (const float*)(const __attribute__((address_space(1))) float*)(((unsigned long long)hi << 32) | lo); }
#define INP(k) inp_ld(k)
struct Params { const float* in[33]; float* out; unsigned char* ws; int ph_lo, ph_hi, li, pad; };

#define IN(k) (lo <= (k) && (k) < hi)
#define SEAM(k) do { if ((k) + 1 < hi) xcd_barrier(bar); } while (0)
#define RELANE() do { int t_ = threadIdx.x; asm volatile("" : "+v"(t_)); c.tid = t_; c.lane = t_ & 63; \
        int g_ = c.G, b_ = c.bid, w_ = c.wave; asm volatile("" : "+s"(g_), "+s"(b_), "+s"(w_)); c.G = g_; c.bid = b_; c.wave = w_; c.gw = b_ * 8 + w_; c.ngw = g_ * 8; } while (0)
template <int li>
DI void layer_body(Ctx& c, LAS unsigned char* lds, unsigned char* ws, float* XF, const XcdBarrier& bar, const int lo0, const int hi0) {
        const int pb = 1 + li * 16;
        int lo = lo0, hi = hi0; asm volatile("" : "+s"(lo), "+s"(hi));
        unsigned char* wsl; { unsigned long long w_ = (unsigned long long)ws; asm volatile("" : "+s"(w_)); wsl = (unsigned char*)(__attribute__((address_space(1))) unsigned char*)w_; }
        const float* lng = INP(5) + (size_t)li * 3 * DM; const float* lnb = INP(6) + (size_t)li * 3 * DM;
        if (IN(pb + 0)) { RELANE();
            TJob j0, j1;
            if (li == 0) { j0 = tjob(INP(7), 1024, 1536, 1536, WMIX, 1024, 0, 3); j1 = tjob(INP(10), 1024, 1024, 1024, WMIX2, 1024, 0, 2); }
            else if (li == 1) { j0 = tjob(INP(11), 1024, 2304, 2304, WMIX, 1024, 0, 3); j1 = tjob(INP(12), 768, 1024, 1024, WMIX2, 768, 0); }
            else if (li == 2) { j0 = tjob(INP(21), 1024, 1024, 2048, WMIX, 1024, 1); j1 = tjob(INP(21) + 1024, 1024, 1024, 2048, WMIX, 1024, 2); }
            else { j0 = tjob(INP(22), 1024, 2304, 2304, WMIX, 1024, 0, 1); j1 = tjob(INP(25), 768, 1024, 1024, WMIX2, 768, 0); }
            const TJob j2 = tjob(INP(27) + (size_t)li * 1024 * 2048, 1024, 2048, 2048, WXKV, 1024, 0), j3 = tjob(INP(28) + (size_t)li * 1024 * 1024, 1024, 1024, 1024, WXO, 1024, 0);
            convert_layer_weights(c, j0, j1, j2, j3, INP(30) + (size_t)li * 16 * 1024 * 1024, INP(31) + (size_t)li * 16 * 1024 * 1024, INP(32) + (size_t)li * 16 * 1024 * 1024, WGU, WD);
            cvt_copy_bf16(c, INP(26) + (size_t)li * 1024 * 1024, WXQ, 1024 * 1024);
            __syncthreads();
            if (li == 2) s5_tables(c, INP(13), INP(14), INP(15), INP(16), INP(17), INP(18), INP(19), S5MT, S5PT, S5AP, S5KK);
            SEAM(pb + 0);
        }
        if (IN(pb + 1)) { RELANE();
            pg8::Sched S = pg8::make_sched_(c.G, c.bid, MEMB, 2048, WXKV, 2048, 12, 8);
            pg8::EpiBf16 E{MEMKV, 0, 0, 2048, nullptr, 0, 0, 0, 1.0f};
            pg8::gemm_phase<pg8::EpiBf16, false>(lds, S, E, 1024, c.tid);
            if (li == 2) s5_fill(c, S5KK, S5MT);
            SEAM(pb + 1);
        }
        if (IN(pb + 2)) { RELANE();
            {
                pg8::Sched S = pg8::make_sched_(c.G, c.bid, MEMKV, 4096, WXQ, 2048, 1, 4);
                S.nb2 = 4; S.total = 12 * 4 * 4; S.aS1 = 256l * 4096; S.aS2 = 512; S.bS1 = 0; S.bS2 = 512;
                pg8::EpiF16 E{GT, 1024l * 1024, 256l * 1024, 1024, nullptr, 0, 0, 1 << 30, 0.0625f * LOG2E};
                pg8::gemm_phase<pg8::EpiF16, false>(lds, S, E, 256, c.tid);
            }
            RELANE();
            {
                pg8::Sched S = pg8::make_sched_(c.G, c.bid, WXO, 2048, MEMKV + 1024, 4096, 4, 1);
                S.nb2 = 4; S.total = 12 * 4 * 4; S.aS1 = 0; S.aS2 = 512; S.bS1 = 256l * 4096; S.bS2 = 512;
                pg8::EpiF8 E{(unsigned char*)HT, 1024l * 1024, 256, 1024, 1.0f / 16.0f};
                pg8::gemm_phase<pg8::EpiF8, false>(lds, S, E, 256, c.tid);
            }
            SEAM(pb + 2);
        }
        if (li == 0) {
            if (IN(pb + 3)) { RELANE(); pg8::Sched S = pg8::make_sched_(c.G, c.bid, X8, 1024, WMIX, 1024, 256, 6); pg8::EpiBf16 E{QKV, 0, 0, 1536, nullptr, 0, 0, 0, 1.0f};
                pg8::gemm_phase<pg8::EpiBf16, false, 2>(lds, S, E, 512, c.tid); SEAM(pb + 3); }
            if (IN(pb + 4)) { RELANE(); prep_a(c, QKV, INP(8), INP(9), AQ8, AK8, AV8T); SEAM(pb + 4); }
            if (IN(pb + 5)) { RELANE(); attn_a_phase(c, AQ8, AK8, AV8T, OB); SEAM(pb + 5); }
            if (IN(pb + 6)) { RELANE(); pg8::Sched S = pg8::make_sched_(c.G, c.bid, OB, 1024, WMIX2, 1024, 256, 4); pg8::EpiF8 E{(unsigned char*)HSUB, 0, 0, 1024, 64.0f};
                pg8::gemm_phase<pg8::EpiF8, false, 2>(lds, S, E, 512, c.tid); SEAM(pb + 6); }
        } else if (li == 1) {
            if (IN(pb + 3)) { RELANE(); pg8::Sched S = pg8::make_sched_(c.G, c.bid, X8, 1024, WMIX, 1024, 256, 9); pg8::EpiBf16 E{QKV, 0, 0, 2304, nullptr, 0, 0, 0, 1.0f};
                pg8::gemm_phase<pg8::EpiBf16, false, 2>(lds, S, E, 512, c.tid); SEAM(pb + 3); }
            if (IN(pb + 5)) { RELANE(); attn_b_phase(c, QKV, OB, INP(4)); SEAM(pb + 5); }
            if (IN(pb + 6)) { RELANE(); pg8::Sched S = pg8::make_sched_(c.G, c.bid, OB, 1536, WMIX2, 1536, 256, 4); pg8::EpiF8 E{(unsigned char*)HSUB, 0, 0, 1024, 1.0f / 64.0f};
                pg8::gemm_phase<pg8::EpiF8, false>(lds, S, E, 768, c.tid); SEAM(pb + 6); }
        } else if (li == 2) {
            if (IN(pb + 3)) { RELANE();
                pg8::Sched S = pg8::make_sched_(c.G, c.bid, UH, 1536, S5PT, 1024, 8, 1); S.total = 64 * 8; S.aS1 = 2048l * 1536; S.bS1 = 256l * 1024;
                pg8::EpiF32 E{PC, 2048l * 256, 256};
                pg8::gemm_phase<pg8::EpiF32, false>(lds, S, E, 512, c.tid); SEAM(pb + 3); }
            if (IN(pb + 4)) { RELANE(); s5_scan(c, PC, S5AP, UH); SEAM(pb + 4); }
            if (IN(pb + 5)) { RELANE();
                pg8::Sched S = pg8::make_sched_(c.G, c.bid, UH, 1536, S5MT, 1536, 8, 2); S.total = 64 * 16; S.aS1 = 2048l * 1536; S.bS1 = 512l * 1536;
                pg8::EpiS5Out E{OB, XB, INP(20)};
                pg8::gemm_phase<pg8::EpiS5Out, false>(lds, S, E, 768, c.tid); SEAM(pb + 5); }
            if (IN(pb + 6)) { RELANE(); pg8::Sched S = pg8::make_sched_(c.G, c.bid, OB, 2048, WMIX, 2048, 256, 8); pg8::EpiGluBf16 E{HSUB};
                pg8::gemm_phase<pg8::EpiGluBf16, false>(lds, S, E, 1024, c.tid); SEAM(pb + 6); }
        } else {
            if (IN(pb + 3)) { RELANE(); pg8::Sched S = pg8::make_sched_(c.G, c.bid, XB, 2048, WMIX, 2048, 256, 9); pg8::EpiBf16 E{QKV, 0, 0, 2304, nullptr, 0, 0, 768, 0.17677669529663687f * LOG2E};
                pg8::gemm_phase<pg8::EpiBf16, false, true>(lds, S, E, 1024, c.tid); SEAM(pb + 3); }
            if (IN(pb + 5)) { RELANE(); attn_d_phase(c, QKV, OB, INP(4), INP(23), INP(24), 0.8f - 0.6f * 0.4065696597405991f); SEAM(pb + 5); }
            if (IN(pb + 6)) { RELANE(); pg8::Sched S = pg8::make_sched_(c.G, c.bid, OB, 1536, WMIX2, 1536, 256, 4); pg8::EpiBf16 E{HSUB, 0, 0, 1024, nullptr, 0, 0, 0, 1.0f};
                pg8::gemm_phase<pg8::EpiBf16, false>(lds, S, E, 768, c.tid); SEAM(pb + 6); }
        }
        if (IN(pb + 8)) { RELANE(); ln_phase<(li < 2 ? (8 | 64) : 8)>(c, nullptr, XB, lng, lnb, nullptr, nullptr, nullptr, nullptr, nullptr, nullptr, HSUB); SEAM(pb + 8); }
        if (IN(pb + 9)) { RELANE();
            pg8::Sched S = pg8::make_sched_(c.G, c.bid, XB, 2048, GT, 2048, 256, 4); S.cross = 1; S.bS1 = 1024l * 2048;
            pg8::EpiSoftmax256F8 E{OB};
            pg8::gemm_phase<pg8::EpiSoftmax256F8, false, true>(lds, S, E, 1024, c.tid); SEAM(pb + 9);
        }
        if (IN(pb + 10)) { RELANE();
            pg8::Sched S = pg8::make_sched_(c.G, c.bid, OB, 1024, HT, 1024, 256, 4); S.cross = 1; S.bS1 = 1024l * 1024;
            pg8::EpiF8 E{(unsigned char*)HSUB, 0, 0, 1024, 64.0f};
            pg8::gemm_phase<pg8::EpiF8, false, 2>(lds, S, E, 512, c.tid); SEAM(pb + 10);
        }
        if (IN(pb + 11)) { RELANE();
            ln_phase<10 | 64>(c, nullptr, XB, lng + DM, lnb + DM, nullptr, nullptr, INP(29) + (size_t)li * 1024 * 16, AFFT, INV, X8, HSUB);
            SEAM(pb + 11); }
        if (IN(pb + 12)) { RELANE(); topk_phase(c, AFFT, IDX, GATE, INV); SEAM(pb + 12); }
        if (IN(pb + 13)) { RELANE();
            pg8::Sched S = pg8::make_sched_(c.G, c.bid, X8, 1024, WGU, 1024, 16, 8);
            S.nb2 = 16; S.total = 2 * 16 * 16 * 8; S.aS1 = (long)NGRP_TOK * 1024; S.aS2 = 0; S.bS1 = 0; S.bS2 = 2048l * 1024; S.GI = IDX; S.giS1 = 16 * CAP; S.giS2 = CAP; S.gather = 1;
#if MOE_DOWN_FP8
            pg8::EpiSwiGLU8 E{HB};
            pg8::gemm_phase<pg8::EpiSwiGLU8, true, 2>(lds, S, E, 512, c.tid); SEAM(pb + 13);
#else
            pg8::EpiSwiGLU E{HB};
            pg8::gemm_phase<pg8::EpiSwiGLU, true, 2>(lds, S, E, 512, c.tid); SEAM(pb + 13);
#endif
        }
        if (IN(pb + 14)) { RELANE();
#if MOE_DOWN_FP8
            pg8::Sched S = pg8::make_sched_(c.G, c.bid, HB, 1024, WD, 1024, 16, 4);
            S.nb2 = 16; S.total = 2 * 16 * 16 * 4; S.aS1 = 16l * CAP * 1024; S.aS2 = (long)CAP * 1024; S.bS1 = 0; S.bS2 = 1024l * 1024;
            pg8::EpiF8 E{(unsigned char*)YE, 16l * CAP * 1024, (long)CAP * 1024, 1024, 8.0f};
            pg8::gemm_phase<pg8::EpiF8, false, 2>(lds, S, E, 512, c.tid); SEAM(pb + 14);
#else
            pg8::Sched S = pg8::make_sched_(c.G, c.bid, HB, 2048, WD, 2048, 16, 4);
            S.nb2 = 16; S.total = 2 * 16 * 16 * 4; S.aS1 = 16l * CAP * 2048; S.aS2 = (long)CAP * 2048; S.bS1 = 0; S.bS2 = 1024l * 2048;
            pg8::EpiBf16 E{YE, 16l * CAP * 1024, (long)CAP * 1024, 1024, GATE, 16 * CAP, CAP, 0, 1.0f};
            pg8::gemm_phase<pg8::EpiBf16, false>(lds, S, E, 1024, c.tid); SEAM(pb + 14);
#endif
        }
        if (IN(pb + 15)) { RELANE();
            const float* gsc = MOE_DOWN_FP8 ? GATE : nullptr;
            if (li == 1) ln_phase<5>(c, nullptr, XB, lng + 2 * DM, lnb + 2 * DM, YE, INV, nullptr, nullptr, nullptr, UH, nullptr, gsc);
            else if (li == 3) ln_phase<17>(c, XF, XB, lng + 2 * DM, lnb + 2 * DM, YE, INV, nullptr, nullptr, nullptr, nullptr, nullptr, gsc);
            else if (li == 0) ln_phase<33>(c, nullptr, XB, lng + 2 * DM, lnb + 2 * DM, YE, INV, nullptr, nullptr, nullptr, X8, nullptr, gsc);
            else ln_phase<1>(c, nullptr, XB, lng + 2 * DM, lnb + 2 * DM, YE, INV, nullptr, nullptr, nullptr, nullptr, nullptr, gsc);
            SEAM(pb + 15);
        }
}

__global__ void __launch_bounds__(512, 2) fwd_kernel(Params P) {
    extern __shared__ __attribute__((aligned(16))) unsigned char lds_raw[];
    LAS unsigned char* lds = (LAS unsigned char*)lds_raw;
    Ctx c; c.lds = lds; c.tid = threadIdx.x; c.lane = c.tid & 63; c.wave = __builtin_amdgcn_readfirstlane(c.tid >> 6); c.G = gridDim.x; c.bid = blockIdx.x;
    c.gw = c.bid * 8 + c.wave; c.ngw = c.G * 8;
    volatile LAS unsigned* misc = (volatile LAS unsigned*)(lds + LDS_MISC);
    if (c.tid < 4) misc[c.tid] = 0u;
    if (c.tid < 33) ((LAS unsigned long long*)(lds + LDS_MISC + 64))[c.tid] = (unsigned long long)P.in[c.tid];
    __syncthreads();
    unsigned char* ws = P.ws;
    const int lo0 = P.ph_lo, hi0 = P.ph_hi;
    XcdBarrier bar; bar.bar = (unsigned*)(ws + WS_CTL) + (size_t)P.li * XCD_BAR_WORDS; bar.x = 0; bar.st = misc;
    if (hi0 - lo0 > 1) bar = xcd_barrier_post(bar.bar, misc);
    float* XF = P.out;
    { const int lo = lo0, hi = hi0;
    if (IN(0)) {
        unsigned char* wsl = ws;
        init_x(c, INP(0), INP(1), XB, X8);
        cvt_copy_bf16(c, INP(2), MEMB, (long)2048 * DM);
        cvt_copy_bf16(c, INP(3), MEMB + (long)2048 * DM, (long)1024 * DM);
        SEAM(0);
    } }
    layer_body<0>(c, lds, ws, XF, bar, lo0, hi0); layer_body<1>(c, lds, ws, XF, bar, lo0, hi0); layer_body<2>(c, lds, ws, XF, bar, lo0, hi0); layer_body<3>(c, lds, ws, XF, bar, lo0, hi0);
}

constexpr int N_PHASES = 65;
static bool phase_exists(int k) {
    if (k == 0) return true;
    const int li = (k - 1) / 16, r = (k - 1) % 16;
    if (r == 7) return false;
    if (r == 4) return li == 0 || li == 2;
    return true;
}

#ifndef MK_PER_PHASE
#define MK_PER_PHASE 0
#endif

extern "C" void kernel_launch(void* const* d_in, const int* in_sizes, int n_in, void* d_out, int out_size, void* d_ws, size_t ws_size, hipStream_t stream) {
    static int grid = 0;
    if (grid == 0) {
        if (n_in != 33 || out_size != NTOK * DM || ws_size < WS_END) { fprintf(stderr, "kernel_launch: unexpected shapes (n_in %d out %d ws %zu need %zu)\n", n_in, out_size, ws_size, (size_t)WS_END); grid = -1; return; }
        int dev = 0, cus = 0, per_cu = 0;
        if (hipGetDevice(&dev) != hipSuccess || hipDeviceGetAttribute(&cus, hipDeviceAttributeMultiprocessorCount, dev) != hipSuccess) { grid = -1; return; }
        if (hipFuncSetAttribute((const void*)fwd_kernel, hipFuncAttributeMaxDynamicSharedMemorySize, LDS_BYTES) != hipSuccess) { fprintf(stderr, "kernel_launch: hipFuncSetAttribute failed\n"); grid = -1; return; }
        if (hipOccupancyMaxActiveBlocksPerMultiprocessor(&per_cu, (const void*)fwd_kernel, 512, LDS_BYTES) != hipSuccess || per_cu < 1) { fprintf(stderr, "kernel_launch: occupancy query says %d\n", per_cu); (void)hipGetLastError(); }
        grid = cus;
    }
    if (grid < 0) return;
    (void)hipMemsetAsync((char*)d_ws + WS_CTL, 0, CTL_BYTES, stream);
    Params p{};
    for (int i = 0; i < 33; ++i) p.in[i] = (const float*)d_in[i];
    p.out = (float*)d_out; p.ws = (unsigned char*)d_ws; p.pad = 0;
#if MK_PER_PHASE
    int li = 0;
    for (int k = 0; k < N_PHASES; ++k) { if (!phase_exists(k)) continue; p.ph_lo = k; p.ph_hi = k + 1; p.li = li++;
        hipLaunchKernelGGL(fwd_kernel, dim3(grid), dim3(512), LDS_BYTES, stream, p); }
#else
    p.ph_lo = 0; p.ph_hi = N_PHASES; p.li = 0;
    hipLaunchKernelGGL(fwd_kernel, dim3(grid), dim3(512), LDS_BYTES, stream, p);
#if defined(PROBE_LO)
    p.ph_lo = PROBE_LO; p.ph_hi = PROBE_HI; p.li = 1; p.out = (float*)((unsigned char*)d_ws + WS_R2);
    hipLaunchKernelGGL(fwd_kernel, dim3(grid), dim3(512), LDS_BYTES, stream, p);
#endif
#endif
}
```

```cpp
#include <hip/hip_runtime.h>
#include <stdint.h>
#include <stdio.h>

#define LAS __attribute__((address_space(3)))
#define DI __device__ __forceinline__
typedef unsigned short bf16_t;
typedef short bf16x8 __attribute__((ext_vector_type(8)));
typedef short s16x4 __attribute__((ext_vector_type(4)));
typedef float f32x4 __attribute__((ext_vector_type(4)));
typedef float f32x2 __attribute__((ext_vector_type(2)));
typedef float f32x16 __attribute__((ext_vector_type(16)));
typedef unsigned u32x4 __attribute__((ext_vector_type(4)));
typedef unsigned u32x2 __attribute__((ext_vector_type(2)));

constexpr int DM = 1024;
constexpr int NTOK = 65536;
constexpr int NGRP_TOK = 32768;
constexpr int NSEQ = 12;
constexpr int MEMLEN = 256;
constexpr int NEXP = 16, CAP = 4096;
constexpr float ALPHA = 1.681792830507429f;
constexpr float LN_EPS = 1e-5f;
constexpr float LOG2E = 1.4426950408889634f;

typedef __bf16 bf16x2_t __attribute__((ext_vector_type(2)));
DI unsigned cvt_pk_bf16(float lo, float hi) { const f32x2 f = {lo, hi}; const bf16x2_t v = __builtin_convertvector(f, bf16x2_t); return __builtin_bit_cast(unsigned, v); }
DI float bf2f(unsigned b) { return __uint_as_float(b << 16); }
typedef _Float16 f16x2_t __attribute__((ext_vector_type(2)));
typedef _Float16 f16x8 __attribute__((ext_vector_type(8)));
DI unsigned cvt_pk_f16(float lo, float hi) { const f32x2 f = {lo, hi}; const f16x2_t v = __builtin_convertvector(f, f16x2_t); return __builtin_bit_cast(unsigned, v); }
typedef int i32x8 __attribute__((ext_vector_type(8)));
DI unsigned cvt_pk4_fp8(float a, float b, float c2, float d) { int p_ = __builtin_amdgcn_cvt_pk_fp8_f32(a, b, 0, false); p_ = __builtin_amdgcn_cvt_pk_fp8_f32(c2, d, p_, true); return (unsigned)p_; }
typedef short s16x2_ __attribute__((ext_vector_type(2)));
DI unsigned cvt_pk4_fp8_sc(unsigned old, float a, float b, float c2, float d, float sc) { s16x2_ r = __builtin_bit_cast(s16x2_, old); r = __builtin_amdgcn_cvt_scalef32_pk_fp8_f32(r, a, b, sc, false); r = __builtin_amdgcn_cvt_scalef32_pk_fp8_f32(r, c2, d, sc, true); return __builtin_bit_cast(unsigned, r); }
DI unsigned cvt_pk2_fp8(float a, float b) { return (unsigned)__builtin_amdgcn_cvt_pk_fp8_f32(a, b, 0, false) & 0xffffu; }
#ifndef MOE_DOWN_FP8
#define MOE_DOWN_FP8 1
#endif
constexpr float W8_SCALE = 64.0f;
DI f32x2 unpk_f16(unsigned w) { const f16x2_t h = __builtin_bit_cast(f16x2_t, w); return (f32x2){(float)h[0], (float)h[1]}; }
DI float wave_sum(float v) {
#pragma unroll
    for (int o = 32; o >= 1; o >>= 1) v += __shfl_xor(v, o);
    return v; }
DI float wave_max(float v) {
#pragma unroll
    for (int o = 32; o >= 1; o >>= 1) v = fmaxf(v, __shfl_xor(v, o));
    return v; }
DI float fast_exp2(float x) { return __builtin_amdgcn_exp2f(x); }
DI float fast_rcp(float x) { return __builtin_amdgcn_rcpf(x); }
DI float sigmoidf_(float x) { return fast_rcp(1.0f + fast_exp2(-x * LOG2E)); }
DI float gelu_tanh(float y) { const float u = 0.7978845608028654f * (y + 0.044715f * y * y * y); return y * sigmoidf_(2.0f * u); }
DI int seq_of_row(int n) { return n < NGRP_TOK ? (n >> 12) : 8 + ((n - NGRP_TOK) >> 13); }
DI int seq_len(int s) { return s < 8 ? 4096 : 8192; }
DI int seq_base(int s) { return s < 8 ? s * 4096 : NGRP_TOK + (s - 8) * 8192; }

#define XB_TMO      128
#define XB_XCNT(j)  (256  + 64 * (j))
#define XB_XSUB(j)  (1280 + 64 * (j))
#define XB_XGEN(j)  (2304 + 64 * (j))
#define XB_TOP      3328
#define XB_TOPGEN   3392
#define XCD_BAR_WORDS 3456
#define XB_SPIN_CAP (1u << 20)

DI unsigned xb_ld(unsigned* p)              { return __hip_atomic_load(p, __ATOMIC_RELAXED, __HIP_MEMORY_SCOPE_AGENT); }
DI unsigned xb_add(unsigned* p, unsigned v) { return __hip_atomic_fetch_add(p, v, __ATOMIC_RELAXED, __HIP_MEMORY_SCOPE_AGENT); }
DI unsigned xb_xcc_id() { return (unsigned)__builtin_amdgcn_s_getreg((3 << 11) | 20) & 0xFu; }
#define XB_SPIN(cond, bar) do { unsigned _sp = 0; while (cond) { __builtin_amdgcn_s_sleep(1); \
    if ((++_sp & 255u) == 0u) { if (xb_ld(&(bar)[XB_TMO])) break; if (_sp > XB_SPIN_CAP) { atomicAdd(&(bar)[XB_TMO], 1u); break; } } } } while (0)

struct XcdBarrier { unsigned* bar; unsigned x; volatile LAS unsigned* st; };

DI XcdBarrier xcd_barrier_post(unsigned* bar, volatile LAS unsigned* st) {
    XcdBarrier b; b.bar = bar; b.x = xb_xcc_id(); b.st = st;
    if (threadIdx.x == 0) (void)xb_add(&bar[XB_XCNT(b.x)], 1u);
    return b;
}
DI void xcd_barrier_complete(unsigned* bar, unsigned x, unsigned& nloc, unsigned& nx) {
    const unsigned G = gridDim.x * gridDim.y * gridDim.z;
    unsigned sum, cnt, mine, sp = 0u;
    for (;;) {
        sum = 0u; cnt = 0u; mine = 0u;
#pragma unroll
        for (unsigned j = 0; j < 16; ++j) { const unsigned c = xb_ld(&bar[XB_XCNT(j)]); sum += c; cnt += (c > 0u) ? 1u : 0u; mine = (j == x) ? c : mine; }
        if (sum == G) break;
        __builtin_amdgcn_s_sleep(1);
        if ((++sp & 255u) == 0u) { if (xb_ld(&bar[XB_TMO])) break; if (sp > XB_SPIN_CAP) { atomicAdd(&bar[XB_TMO], 1u); break; } }
    }
    nloc = mine > 0u ? mine : 1u; nx = cnt > 0u ? cnt : 1u;
}
DI void xcd_barrier(const XcdBarrier& b) {
    asm volatile("s_waitcnt vmcnt(0)" ::: "memory");
    __syncthreads();
    if (threadIdx.x == 0) {
        unsigned* bar = b.bar;
        __builtin_amdgcn_s_waitcnt(0);
        unsigned nloc = b.st[0], nx = b.st[1];
        if (nloc == 0u) { xcd_barrier_complete(bar, b.x, nloc, nx); b.st[0] = nloc; b.st[1] = nx; }
        const unsigned old = xb_add(&bar[XB_XSUB(b.x)], 1u);
        const unsigned gen = old / nloc;
        if (old + 1u == (gen + 1u) * nloc) {
            __builtin_amdgcn_fence(__ATOMIC_RELEASE, "agent");
            asm volatile("s_waitcnt vmcnt(0)" ::: "memory");
            const unsigned og = xb_add(&bar[XB_TOP], 1u);
            const unsigned tg = og / nx;
            if (og + 1u == (tg + 1u) * nx) xb_add(&bar[XB_TOPGEN], 1u);
            else XB_SPIN(xb_ld(&bar[XB_TOPGEN]) == tg, bar);
            __builtin_amdgcn_fence(__ATOMIC_ACQUIRE, "agent");
            xb_add(&bar[XB_XGEN(b.x)], 1u);
            asm volatile("s_waitcnt vmcnt(0)" ::: "memory");
        } else {
            XB_SPIN(xb_ld(&bar[XB_XGEN(b.x)]) == gen, bar);
            __builtin_amdgcn_fence(__ATOMIC_ACQUIRE, "agent");
            asm volatile("s_waitcnt vmcnt(0)" ::: "memory");
        }
    }
    __syncthreads();
}
namespace pg8 {
constexpr int BM = 256, BK = 64, HALF = 128, HTB = HALF * BK * 2, STAGE_BYTES = 8 * HTB;

DI int lds_byte(int r, int c) { const int st = (r >> 4) * 2 + (c >> 5), rr = r & 15, cc = c & 31, ob = rr * 64 + cc * 2; return st * 1024 + (ob ^ (((ob >> 9) & 1) << 5)); }
DI void stage_rc(int b, int& R, int& C) { const int st = b / 1024, sb = b % 1024, swz = sb ^ (((sb >> 9) & 1) << 5); R = (st >> 1) * 16 + swz / 64; C = (st & 1) * 32 + (swz % 64) / 2; }
DI int perm32(int rho) { const int n = rho >> 4, i = rho & 15; return 8 * (i >> 2) + 4 * n + (i & 3); }

struct Unit { const char* a; const char* b; const int* gi; int pm, pn, b1, b2; };

DI int cross_batch(int pm) { return pm < 128 ? (pm >> 4) : 8 + ((pm - 128) >> 5); }

struct Sched {
    const char* A; const char* B; const int* GI;
    long aS1, aS2, bS1, bS2; int giS1, giS2;
    unsigned lda, ldb;
    int nb2, nM, nN, total, G, c, cross, gather;
    DI bool next(int i, Unit& u) const {
        const long L = (long)i * G + c; if (L >= total) return false;
        int w = (int)L; { const int q = total / 8, r = total % 8, xcd = w % 8, off = w / 8; w = (xcd < r ? xcd * (q + 1) : r * (q + 1) + (xcd - r) * q) + off; }
        const int per = nM * nN, bz = w / per, l = w % per;
        const int nig = 8 * nN, gid = l / nig, fm = gid * 8, gsz = (nM - fm) < 8 ? (nM - fm) : 8;
        u.pm = fm + ((l % nig) % gsz); u.pn = (l % nig) / gsz;
        u.b1 = bz / nb2; u.b2 = bz % nb2;
        const int bb = cross ? cross_batch(u.pm) : u.b1;
        u.a = A + (long)u.b1 * aS1 + (long)u.b2 * aS2 + (gather ? 0l : (long)u.pm * 256 * lda);
        u.gi = GI + (long)u.b1 * giS1 + (long)u.b2 * giS2 + u.pm * 256;
        u.b = B + (long)bb * bS1 + (long)u.b2 * bS2 + (long)u.pn * 256 * ldb;
        return true;
    }
};
DI Sched make_sched_(int G, int bid, const void* A, unsigned lda, const void* B, unsigned ldb, int nM, int nN) {
    Sched s; s.A = (const char*)A; s.B = (const char*)B; s.GI = nullptr; s.aS1 = s.aS2 = s.bS1 = s.bS2 = 0; s.giS1 = s.giS2 = 0; s.lda = lda; s.ldb = ldb;
    s.nb2 = 1; s.nM = nM; s.nN = nN; s.total = nM * nN; s.G = G; s.c = bid; s.cross = 0; s.gather = 0; return s; }

typedef f32x4 Acc[2][2][4][2];

template <class Epi, bool GATHER, int OPM = 0  >
DI void gemm_phase(LAS unsigned char* lds, const Sched& S, const Epi& E, const int K, const int tid_in) {
    const int tid = tid_in, wid = __builtin_amdgcn_readfirstlane(tid >> 6), lane = tid & 63, wr = wid >> 2, wc = wid & 3, fr = lane & 15, fq = lane >> 4;
    const int nt = K / BK;
    const unsigned lda = S.lda, ldb = S.ldb;
    unsigned voffA[2], voffB[2];
#pragma unroll
    for (int i = 0; i < 2; ++i) { int R, C; stage_rc(tid * 16 + i * 8192, R, C); const int Rb = Epi::PERM ? ((R & ~31) + perm32(R & 31)) : R;
        voffA[i] = (unsigned)R * lda + (unsigned)C * 2u; voffB[i] = (unsigned)Rb * ldb + (unsigned)C * 2u; }
    const unsigned hstepA = 128u * lda, hstepB = 128u * ldb;
    const size_t kstep = (size_t)(BK * 2);
    const unsigned ldsw = (unsigned)wid * 1024u;
    const int aoff = lds_byte(wr * 64 + fr, fq * 8), boff = lds_byte(wc * 32 + fr, fq * 8);
#define PG8_SA(b, h) (((b) * 2 + (h)) * HTB)
#define PG8_SB(b, h) ((4 + (b) * 2 + (h)) * HTB)
#define PG8_GLDS(bufoff, gp, _i) __builtin_amdgcn_global_load_lds((const unsigned*)(gp), (LAS unsigned*)(lds + (bufoff) + ldsw + (_i) * 8192), 16, 0, 0)
#define PG8_STAGE_A(b, h, base, OFF) do { _Pragma("unroll") for (int _i = 0; _i < 2; ++_i) \
        PG8_GLDS(PG8_SA(b, h), (base) + (GATHER ? OFF[h][_i] : (voffA[_i] + (unsigned)(h) * hstepA)), _i); } while (0)
#define PG8_STAGE_B(b, h, base) do { _Pragma("unroll") for (int _i = 0; _i < 2; ++_i) \
        PG8_GLDS(PG8_SB(b, h), (base) + (voffB[_i] + (unsigned)(h) * hstepB), _i); } while (0)
#define PG8_LDA(dst, b, h) do { _Pragma("unroll") for (int m = 0; m < 4; ++m) _Pragma("unroll") for (int k = 0; k < 2; ++k) dst[m][k] = *(const LAS bf16x8*)(lds + PG8_SA(b, h) + aoff + m * 2048 + k * 1024); } while (0)
#define PG8_LDB(dst, b, h) do { _Pragma("unroll") for (int n = 0; n < 2; ++n) _Pragma("unroll") for (int k = 0; k < 2; ++k) dst[n][k] = *(const LAS bf16x8*)(lds + PG8_SB(b, h) + boff + n * 2048 + k * 1024); } while (0)
#define PG8_MMA(ai, bj, At, Bt) do { __builtin_amdgcn_s_setprio(1); \
        if (OPM == 2) { _Pragma("unroll") for (int m = 0; m < 4; ++m) _Pragma("unroll") for (int n = 0; n < 2; ++n) { \
            typedef short s16x16_ __attribute__((ext_vector_type(16))); \
            const i32x8 a8_ = __builtin_bit_cast(i32x8, (s16x16_)__builtin_shufflevector(At[m][0], At[m][1], 0, 1, 2, 3, 4, 5, 6, 7, 8, 9, 10, 11, 12, 13, 14, 15)); \
            const i32x8 b8_ = __builtin_bit_cast(i32x8, (s16x16_)__builtin_shufflevector(Bt[n][0], Bt[n][1], 0, 1, 2, 3, 4, 5, 6, 7, 8, 9, 10, 11, 12, 13, 14, 15)); \
            acc[ai][bj][m][n] = __builtin_amdgcn_mfma_scale_f32_16x16x128_f8f6f4(b8_, a8_, acc[ai][bj][m][n], 0, 0, 0, 127, 0, 127); } } \
        else { _Pragma("unroll") for (int m = 0; m < 4; ++m) _Pragma("unroll") for (int n = 0; n < 2; ++n) _Pragma("unroll") for (int k = 0; k < 2; ++k) \
        acc[ai][bj][m][n] = OPM == 1 ? __builtin_amdgcn_mfma_f32_16x16x32_f16(__builtin_bit_cast(f16x8, Bt[n][k]), __builtin_bit_cast(f16x8, At[m][k]), acc[ai][bj][m][n], 0, 0, 0) \
                                : __builtin_amdgcn_mfma_f32_16x16x32_bf16(Bt[n][k], At[m][k], acc[ai][bj][m][n], 0, 0, 0); } __builtin_amdgcn_s_setprio(0); } while (0)
#define PG8_GOFF(dst, gi_) do { int _t = tid; asm volatile("" : "+v"(_t)); _Pragma("unroll") for (int _i = 0; _i < 2; ++_i) { int _R, _C; stage_rc(_t * 16 + _i * 8192, _R, _C); \
        _Pragma("unroll") for (int _h = 0; _h < 2; ++_h) dst[_h][_i] = (unsigned)(gi_)[_h * 128 + _R] * lda + (unsigned)_C * 2u; } } while (0)
#define PG8_WAIT_V(n) asm volatile("s_waitcnt vmcnt(" #n ")" ::: "memory")
#define PG8_WAIT_L(n) asm volatile("s_waitcnt lgkmcnt(" #n ")" ::: "memory")
#define PG8_BAR __builtin_amdgcn_s_barrier()
#define PG8_SCHED __builtin_amdgcn_sched_barrier(0)
    Unit cur, nxt; int ui = 0;
    if (!S.next(0, cur)) return;
    Acc acc;
#pragma unroll
    for (int a = 0; a < 2; ++a)
#pragma unroll
        for (int b = 0; b < 2; ++b)
#pragma unroll
            for (int m = 0; m < 4; ++m)
#pragma unroll
                for (int n = 0; n < 2; ++n) acc[a][b][m][n] = (f32x4){0.f, 0.f, 0.f, 0.f};
    bf16x8 At[4][2], B0[2][2], B1[2][2];
    unsigned cO[2][2], nO[2][2];
#pragma unroll
    for (int h = 0; h < 2; ++h)
#pragma unroll
        for (int i = 0; i < 2; ++i) { cO[h][i] = 0u; nO[h][i] = 0u; }
    if (GATHER) { PG8_GOFF(cO, cur.gi); }
    const char* cA = cur.a; const char* cB = cur.b;
    PG8_STAGE_B(0, 0, cB); PG8_STAGE_A(0, 0, cA, cO); PG8_STAGE_B(0, 1, cB); PG8_STAGE_A(0, 1, cA, cO);
    if (wr == 1) PG8_BAR;
    PG8_WAIT_V(4); PG8_BAR;
    PG8_STAGE_B(1, 0, cB + kstep); PG8_STAGE_A(1, 0, cA + kstep, cO); PG8_STAGE_B(1, 1, cB + kstep);
    PG8_WAIT_V(6); PG8_BAR;
    for (;;) {
        const bool has_next = S.next(ui + 1, nxt);
        const char* nA = has_next ? nxt.a : cA; const char* nB = has_next ? nxt.b : cB;
        if (GATHER) {
            if (has_next) { PG8_GOFF(nO, nxt.gi); }
        }
        for (int t = 0; t < nt; t += 2) {
            const bool last = (t == nt - 2);
            const char* a1 = cA + (size_t)(t + 1) * kstep;
            const char* a2 = last ? nA : cA + (size_t)(t + 2) * kstep; const char* b2 = last ? nB : cB + (size_t)(t + 2) * kstep;
            const char* a3 = a2 + kstep; const char* b3 = b2 + kstep;
            PG8_LDB(B0, 0, 0); PG8_SCHED; PG8_LDA(At, 0, 0); PG8_STAGE_A(1, 1, a1, cO);
            if (GATHER) { if (last) {
#pragma unroll
                for (int h = 0; h < 2; ++h)
#pragma unroll
                    for (int i = 0; i < 2; ++i) cO[h][i] = nO[h][i]; } }
            PG8_WAIT_L(8); PG8_BAR; PG8_WAIT_L(0); PG8_MMA(0, 0, At, B0); PG8_BAR; PG8_SCHED;
            PG8_LDB(B1, 0, 1); PG8_STAGE_B(0, 0, b2);
            PG8_BAR; PG8_WAIT_L(0); PG8_MMA(0, 1, At, B1); PG8_BAR;
            PG8_LDA(At, 0, 1); PG8_STAGE_A(0, 0, a2, cO);
            PG8_BAR; PG8_WAIT_L(0); PG8_MMA(1, 0, At, B0); PG8_BAR; PG8_SCHED;
            PG8_STAGE_B(0, 1, b2);
            PG8_WAIT_V(6); PG8_BAR; PG8_MMA(1, 1, At, B1); PG8_BAR;
            PG8_LDB(B0, 1, 0); PG8_SCHED; PG8_LDA(At, 1, 0); PG8_STAGE_A(0, 1, a2, cO);
            PG8_WAIT_L(8); PG8_BAR; PG8_WAIT_L(0); PG8_MMA(0, 0, At, B0); PG8_BAR; PG8_SCHED;
            PG8_LDB(B1, 1, 1); PG8_STAGE_B(1, 0, b3);
            PG8_BAR; PG8_WAIT_L(0); PG8_MMA(0, 1, At, B1); PG8_BAR;
            PG8_LDA(At, 1, 1); PG8_STAGE_A(1, 0, a3, cO);
            PG8_BAR; PG8_WAIT_L(0); PG8_MMA(1, 0, At, B0); PG8_BAR; PG8_SCHED;
            PG8_STAGE_B(1, 1, b3);
            PG8_WAIT_V(6); PG8_BAR; PG8_MMA(1, 1, At, B1); PG8_BAR;
        }
        E(acc, cur, wr, wc, fr, fq, lds, ui);
        if (!has_next) break;
#pragma unroll
        for (int a = 0; a < 2; ++a)
#pragma unroll
            for (int b = 0; b < 2; ++b)
#pragma unroll
                for (int m = 0; m < 4; ++m)
#pragma unroll
                    for (int n = 0; n < 2; ++n) acc[a][b][m][n] = (f32x4){0.f, 0.f, 0.f, 0.f};
        cur = nxt; cA = nA; cB = nB; ++ui;
    }
    PG8_WAIT_V(0);
    if (wr == 0) PG8_BAR;
    PG8_BAR;
#undef PG8_SA
#undef PG8_SB
#undef PG8_GLDS
#undef PG8_STAGE_A
#undef PG8_STAGE_B
#undef PG8_LDA
#undef PG8_LDB
#undef PG8_MMA
#undef PG8_GOFF
#undef PG8_WAIT_V
#undef PG8_WAIT_L
#undef PG8_SCHED
}
#define PG8_BAR_ASM asm volatile("s_waitcnt lgkmcnt(0)\n\ts_barrier" ::: "memory")

template <bool F16OUT> struct EpiPk16 {
    static constexpr bool PERM = true;
    bf16_t* O; long oS1, oS2; int ldo; const float* rs; int rsS1, rsS2; int slim; float sval;
    DI void operator()(const Acc& acc, const Unit& u, int wr, int wc, int fr, int fq, LAS unsigned char*, int) const {
        __builtin_amdgcn_sched_barrier(0);
        bf16_t* base = O + u.b1 * oS1 + u.b2 * oS2 + (long)(u.pm * 256 + wr * 64 + fr) * ldo + u.pn * 256 + wc * 32 + 8 * fq;
        const float* rsp = rs ? rs + u.b1 * rsS1 + u.b2 * rsS2 + u.pm * 256 + wr * 64 + fr : nullptr;
#pragma unroll
        for (int ai = 0; ai < 2; ++ai)
#pragma unroll
            for (int m = 0; m < 4; ++m) {
                bf16_t* rowp = base + (long)(ai * HALF + m * 16) * ldo;
                const float rsc = rsp ? rsp[ai * HALF + m * 16] : 1.0f;
#pragma unroll
                for (int bj = 0; bj < 2; ++bj) {
                    const float sc = rsc * ((u.pn * 256 + bj * HALF + wc * 32) < slim ? sval : 1.0f);
                    const f32x4 v0 = acc[ai][bj][m][0] * sc, v1 = acc[ai][bj][m][1] * sc;
                    u32x4 w;
                    if (F16OUT) { w.x = cvt_pk_f16(v0[0], v0[1]); w.y = cvt_pk_f16(v0[2], v0[3]); w.z = cvt_pk_f16(v1[0], v1[1]); w.w = cvt_pk_f16(v1[2], v1[3]); }
                    else { w.x = cvt_pk_bf16(v0[0], v0[1]); w.y = cvt_pk_bf16(v0[2], v0[3]); w.z = cvt_pk_bf16(v1[0], v1[1]); w.w = cvt_pk_bf16(v1[2], v1[3]); }
                    *(u32x4*)(rowp + bj * HALF) = w; } }
    }
};
typedef EpiPk16<false> EpiBf16;
struct EpiF8 {
    static constexpr bool PERM = true;
    unsigned char* O; long oS1, oS2; int ldo; float sc;
    DI void operator()(const Acc& acc, const Unit& u, int wr, int wc, int fr, int fq, LAS unsigned char*, int) const {
        __builtin_amdgcn_sched_barrier(0);
        unsigned char* base = O + u.b1 * oS1 + u.b2 * oS2 + (long)(u.pm * 256 + wr * 64 + fr) * ldo + u.pn * 256 + wc * 32 + 8 * fq;
#pragma unroll
        for (int ai = 0; ai < 2; ++ai)
#pragma unroll
            for (int m = 0; m < 4; ++m) {
                unsigned char* rowp = base + (long)(ai * HALF + m * 16) * ldo;
#pragma unroll
                for (int bj = 0; bj < 2; ++bj) {
                    const f32x4 v0 = acc[ai][bj][m][0], v1 = acc[ai][bj][m][1];
                    u32x2 w; w.x = cvt_pk4_fp8_sc(0u, v0[0], v0[1], v0[2], v0[3], sc); w.y = cvt_pk4_fp8_sc(0u, v1[0], v1[1], v1[2], v1[3], sc);
                    *(u32x2*)(rowp + bj * HALF) = w; } }
    }
};
typedef EpiPk16<true> EpiF16;
struct EpiResid {
    static constexpr bool PERM = false;
    float* X;
    DI void operator()(const Acc& acc, const Unit& u, int wr, int wc, int fr, int fq, LAS unsigned char*, int) const {
        float* base = X + (long)(u.pm * 256 + wr * 64 + fr) * DM + u.pn * 256 + wc * 32 + 4 * fq;
#pragma unroll
        for (int ai = 0; ai < 2; ++ai)
#pragma unroll
            for (int m = 0; m < 4; ++m) { float* rowp = base + (long)(ai * HALF + m * 16) * DM;
#pragma unroll
                for (int bj = 0; bj < 2; ++bj)
#pragma unroll
                    for (int n = 0; n < 2; ++n) { f32x4* p = (f32x4*)(rowp + bj * HALF + n * 16); *p = *p * ALPHA + acc[ai][bj][m][n]; } }
    }
};
struct EpiGluResid {
    static constexpr bool PERM = false;
    float* X;
    DI void operator()(const Acc& acc, const Unit& u, int wr, int wc, int fr, int fq, LAS unsigned char*, int) const {
        float* base = X + (long)(u.pm * 256 + wr * 64 + fr) * DM + u.pn * 128 + wc * 32 + 4 * fq;
#pragma unroll
        for (int ai = 0; ai < 2; ++ai)
#pragma unroll
            for (int m = 0; m < 4; ++m) { float* rowp = base + (long)(ai * HALF + m * 16) * DM;
#pragma unroll
                for (int n = 0; n < 2; ++n) { f32x4* p = (f32x4*)(rowp + n * 16); const f32x4 a = acc[ai][0][m][n], g = acc[ai][1][m][n]; f32x4 x = *p;
#pragma unroll
                    for (int j = 0; j < 4; ++j) x[j] = x[j] * ALPHA + a[j] * sigmoidf_(g[j]);
                    *p = x; } }
    }
};
struct EpiGluBf16 {
    static constexpr bool PERM = true;
    bf16_t* H;
    DI void operator()(const Acc& acc, const Unit& u, int wr, int wc, int fr, int fq, LAS unsigned char*, int) const {
        bf16_t* base = H + (long)(u.pm * 256 + wr * 64 + fr) * DM + u.pn * 128 + wc * 32 + 8 * fq;
#pragma unroll
        for (int ai = 0; ai < 2; ++ai)
#pragma unroll
            for (int m = 0; m < 4; ++m) { bf16_t* rowp = base + (long)(ai * HALF + m * 16) * DM;
                float h[8];
#pragma unroll
                for (int n = 0; n < 2; ++n)
#pragma unroll
                    for (int j = 0; j < 4; ++j) h[n * 4 + j] = acc[ai][0][m][n][j] * sigmoidf_(acc[ai][1][m][n][j]);
                u32x4 w; w.x = cvt_pk_bf16(h[0], h[1]); w.y = cvt_pk_bf16(h[2], h[3]); w.z = cvt_pk_bf16(h[4], h[5]); w.w = cvt_pk_bf16(h[6], h[7]);
                *(u32x4*)rowp = w; }
    }
};
template <bool F8OUT> struct EpiSwiGLU_ {
    static constexpr bool PERM = true;
    bf16_t* H;
    DI void operator()(const Acc& acc, const Unit& u, int wr, int wc, int fr, int fq, LAS unsigned char*, int) const {
        const long row0 = (long)(u.b1 * 16 + u.b2) * CAP + u.pm * 256 + wr * 64 + fr; const int col0 = u.pn * 128 + wc * 32 + 8 * fq;
#pragma unroll
        for (int ai = 0; ai < 2; ++ai)
#pragma unroll
            for (int m = 0; m < 4; ++m) {
                float h[8];
#pragma unroll
                for (int n = 0; n < 2; ++n)
#pragma unroll
                    for (int j = 0; j < 4; ++j) { const float g = acc[ai][0][m][n][j] * (1.0f / W8_SCALE); h[n * 4 + j] = g * sigmoidf_(g) * (acc[ai][1][m][n][j] * (1.0f / W8_SCALE)); }
                const long r = row0 + ai * HALF + m * 16;
                if (F8OUT) { u32x2 w; w.x = cvt_pk4_fp8(h[0], h[1], h[2], h[3]); w.y = cvt_pk4_fp8(h[4], h[5], h[6], h[7]); *(u32x2*)((unsigned char*)H + r * DM + col0) = w; }
                else { u32x4 w; w.x = cvt_pk_bf16(h[0], h[1]); w.y = cvt_pk_bf16(h[2], h[3]); w.z = cvt_pk_bf16(h[4], h[5]); w.w = cvt_pk_bf16(h[6], h[7]); *(u32x4*)(H + r * DM + col0) = w; }
                __builtin_amdgcn_sched_barrier(0); }
    }
};
typedef EpiSwiGLU_<false> EpiSwiGLU;
typedef EpiSwiGLU_<true> EpiSwiGLU8;
struct EpiF32 {
    static constexpr bool PERM = false;
    float* C; long oS1; int ldo;
    DI void operator()(const Acc& acc, const Unit& u, int wr, int wc, int fr, int fq, LAS unsigned char*, int) const {
        float* base = C + u.b1 * oS1 + (long)(u.pm * 256 + wr * 64 + fr) * ldo + u.pn * 256 + wc * 32 + 4 * fq;
#pragma unroll
        for (int ai = 0; ai < 2; ++ai)
#pragma unroll
            for (int m = 0; m < 4; ++m) { float* rowp = base + (long)(ai * HALF + m * 16) * ldo;
#pragma unroll
                for (int bj = 0; bj < 2; ++bj)
#pragma unroll
                    for (int n = 0; n < 2; ++n) *(f32x4*)(rowp + bj * HALF + n * 16) = acc[ai][bj][m][n]; }
    }
};
template <bool F8> struct EpiSoftmax256_ {
    static constexpr bool PERM = true;
    bf16_t* Pm;
    DI void operator()(const Acc& acc, const Unit& u, int wr, int wc, int fr, int fq, LAS unsigned char* lds, int ui) const {
        LAS f32x2* T = (LAS f32x2*)(lds + STAGE_BYTES + (ui & 1) * 8192);
        float mloc[2][4];
#pragma unroll
        for (int ai = 0; ai < 2; ++ai)
#pragma unroll
            for (int m = 0; m < 4; ++m) {
                float mx = -3.0e38f;
#pragma unroll
                for (int bj = 0; bj < 2; ++bj)
#pragma unroll
                    for (int n = 0; n < 2; ++n) { const f32x4 x = acc[ai][bj][m][n]; mx = fmaxf(fmaxf(mx, fmaxf(x[0], x[1])), fmaxf(x[2], x[3])); }
                mx = fmaxf(mx, __shfl_xor(mx, 16)); mx = fmaxf(mx, __shfl_xor(mx, 32));
                float s = 0.f;
#pragma unroll
                for (int bj = 0; bj < 2; ++bj)
#pragma unroll
                    for (int n = 0; n < 2; ++n) { const f32x4 x = acc[ai][bj][m][n]; s += (fast_exp2(x[0] - mx) + fast_exp2(x[1] - mx)) + (fast_exp2(x[2] - mx) + fast_exp2(x[3] - mx)); }
                s += __shfl_xor(s, 16); s += __shfl_xor(s, 32);
                mloc[ai][m] = mx;
                if (fq == 0) T[(ai * HALF + wr * 64 + m * 16 + fr) * 4 + wc] = (f32x2){mx, s};
            }
        PG8_BAR_ASM;
        bf16_t* base = Pm + (long)(u.pm * 256 + wr * 64 + fr) * DM + u.pn * 256 + wc * 32 + 8 * fq;
#pragma unroll
        for (int ai = 0; ai < 2; ++ai)
#pragma unroll
            for (int m = 0; m < 4; ++m) {
                const int row = ai * HALF + wr * 64 + m * 16 + fr;
                const f32x2 t0 = T[row * 4 + 0], t1 = T[row * 4 + 1], t2 = T[row * 4 + 2], t3 = T[row * 4 + 3];
                const float M = fmaxf(fmaxf(t0.x, t1.x), fmaxf(t2.x, t3.x));
                const float Lsum = t0.y * fast_exp2(t0.x - M) + t1.y * fast_exp2(t1.x - M) + t2.y * fast_exp2(t2.x - M) + t3.y * fast_exp2(t3.x - M);
                const float inv = fast_rcp(Lsum) * (F8 ? 256.0f : 1.0f);
                bf16_t* rowp = base + (long)(ai * HALF + m * 16) * DM;
                unsigned char* rowp8 = (unsigned char*)Pm + (long)(u.pm * 256 + row) * DM + u.pn * 256 + wc * 32 + 8 * fq;
#pragma unroll
                for (int bj = 0; bj < 2; ++bj) { const f32x4 x0 = acc[ai][bj][m][0], x1 = acc[ai][bj][m][1]; float p[8];
#pragma unroll
                    for (int j = 0; j < 4; ++j) { p[j] = fast_exp2(x0[j] - M) * inv; p[4 + j] = fast_exp2(x1[j] - M) * inv; }
                    if (F8) { u32x2 w8; w8.x = cvt_pk4_fp8(p[0], p[1], p[2], p[3]); w8.y = cvt_pk4_fp8(p[4], p[5], p[6], p[7]); *(u32x2*)(rowp8 + bj * HALF) = w8; }
                    else { u32x4 w; w.x = cvt_pk_bf16(p[0], p[1]); w.y = cvt_pk_bf16(p[2], p[3]); w.z = cvt_pk_bf16(p[4], p[5]); w.w = cvt_pk_bf16(p[6], p[7]);
                        *(u32x4*)(rowp + bj * HALF) = w; } } }
        (void)mloc;
    }
};
typedef EpiSoftmax256_<false> EpiSoftmax256;
typedef EpiSoftmax256_<true> EpiSoftmax256F8;
struct EpiS5Out {
    static constexpr bool PERM = true;
    bf16_t* Z; const bf16_t* X16; const float* dskip;
    DI void operator()(const Acc& acc, const Unit& u, int wr, int wc, int fr, int fq, LAS unsigned char*, int) const {
        const int g = u.b1;
#pragma unroll
        for (int ai = 0; ai < 2; ++ai)
#pragma unroll
            for (int m = 0; m < 4; ++m) {
                const int chunk = u.pm * 256 + ai * HALF + wr * 64 + m * 16 + fr;
#pragma unroll
                for (int bj = 0; bj < 2; ++bj) {
                    const int col = u.pn * 256 + bj * HALF + wc * 32 + 8 * fq, i = col >> 4, j = col & 15;
                    const long off = (long)(chunk * 32 + i) * DM + g * 16 + j;
                    const u32x4 xw = *(const u32x4*)(X16 + off); const f32x2 x01 = unpk_f16(xw.x), x23 = unpk_f16(xw.y), x45 = unpk_f16(xw.z), x67 = unpk_f16(xw.w);
                    const f32x4 xa = {x01.x, x01.y, x23.x, x23.y}, xb = {x45.x, x45.y, x67.x, x67.y};
                    const f32x4 da = *(const f32x4*)(dskip + g * 16 + j), db = *(const f32x4*)(dskip + g * 16 + j + 4);
                    float y[8];
#pragma unroll
                    for (int q = 0; q < 4; ++q) { y[q] = gelu_tanh(acc[ai][bj][m][0][q] + da[q] * xa[q]); y[4 + q] = gelu_tanh(acc[ai][bj][m][1][q] + db[q] * xb[q]); }
                    u32x4 w; w.x = cvt_pk_bf16(y[0], y[1]); w.y = cvt_pk_bf16(y[2], y[3]); w.z = cvt_pk_bf16(y[4], y[5]); w.w = cvt_pk_bf16(y[6], y[7]);
                    *(u32x4*)(Z + off) = w; } }
    }
};
}
struct Ctx { LAS unsigned char* lds; int tid, lane, wave, G, bid, gw, ngw; };

DI void cvt_copy_bf16(const Ctx& c, const float* src, bf16_t* dst, long n) {
    for (long i = ((long)c.bid * 512 + c.tid) * 4; i < n; i += (long)c.G * 512 * 4) {
        const f32x4 v = *(const f32x4*)(src + i); u32x2 w; w.x = cvt_pk_bf16(v[0], v[1]); w.y = cvt_pk_bf16(v[2], v[3]); *(u32x2*)(dst + i) = w; }
}
DI void init_x(const Ctx& c, const float* xp, const float* xs, bf16_t* X16, bf16_t* X8_) {
    const long half = (long)NGRP_TOK * DM;
    for (long i = ((long)c.bid * 512 + c.tid) * 4; i < 2 * half; i += (long)c.G * 512 * 4) {
        const f32x4 v = i < half ? *(const f32x4*)(xp + i) : *(const f32x4*)(xs + (i - half));
        u32x2 w; w.x = cvt_pk_f16(v[0], v[1]); w.y = cvt_pk_f16(v[2], v[3]); *(u32x2*)(X16 + i) = w;
        *(unsigned*)((unsigned char*)X8_ + i) = cvt_pk4_fp8(v[0], v[1], v[2], v[3]); }
}
DI long il_row(int n, int which) { return (long)(n >> 7) * 256 + which * 128 + (n & 127); }
struct TJob { const float* W; bf16_t* Wt; int tn  , ldw, ldt, mode, nit, f16; };
DI TJob tjob(const float* W, int K, int N, int ldw, bf16_t* Wt, int ldt, int mode, int f16 = 0) { TJob j; j.W = W; j.Wt = Wt; j.tn = N / 256; j.ldw = ldw; j.ldt = ldt; j.mode = mode; j.nit = (K / 64) * (N / 256); j.f16 = f16; return j; }
#define CONV_DECODE(it_, W_, Wt_, ldw_, ldt_, mode_, k0_, n0_, f16_) do { int tn_, r_; \
    if ((it_) < n3) { const bool b0 = (it_) < n0, b1 = (it_) < n1, b2 = (it_) < n2; \
        W_ = b0 ? j0.W : (b1 ? j1.W : (b2 ? j2.W : j3.W)); Wt_ = b0 ? j0.Wt : (b1 ? j1.Wt : (b2 ? j2.Wt : j3.Wt)); \
        tn_ = b0 ? j0.tn : (b1 ? j1.tn : (b2 ? j2.tn : j3.tn)); ldw_ = b0 ? j0.ldw : (b1 ? j1.ldw : (b2 ? j2.ldw : j3.ldw)); \
        ldt_ = b0 ? j0.ldt : (b1 ? j1.ldt : (b2 ? j2.ldt : j3.ldt)); mode_ = b0 ? j0.mode : (b1 ? j1.mode : (b2 ? j2.mode : j3.mode)); \
        r_ = (it_) - (b0 ? 0 : (b1 ? n0 : (b2 ? n1 : n2))); f16_ = b0 ? j0.f16 : (b1 ? j1.f16 : (b2 ? j2.f16 : j3.f16)); \
    } else { const int q_ = (it_) - n3, e_ = q_ / 192, m_ = (q_ % 192) >> 6; r_ = q_ & 63; \
        W_ = (m_ == 0 ? wg : (m_ == 1 ? wu : wd)) + (size_t)e_ * 1024 * 1024; \
        Wt_ = m_ == 2 ? (MOE_DOWN_FP8 ? (bf16_t*)((unsigned char*)WD + (size_t)e_ * 1024 * 1024) : WD + (size_t)e_ * 1024 * 1024) : (bf16_t*)((unsigned char*)WGU + (size_t)e_ * 2048 * 1024); \
        tn_ = 4; ldw_ = 1024; ldt_ = 1024; mode_ = m_ == 2 ? 0 : m_ + 1; f16_ = (m_ == 2 && !MOE_DOWN_FP8) ? 0 : 2; }        \
    k0_ = (r_ / tn_) * 64; n0_ = (r_ % tn_) * 256; } while (0)
DI void convert_layer_weights(const Ctx& c, const TJob& j0, const TJob& j1, const TJob& j2, const TJob& j3, const float* wg, const float* wu, const float* wd, bf16_t* WGU, bf16_t* WD) {
    const int n0 = j0.nit, n1 = n0 + j1.nit, n2 = n1 + j2.nit, n3 = n2 + j3.nit, total = n3 + 16 * 3 * 64;
    LAS float* scr = (LAS float*)c.lds;
    int it = c.bid;
    if (it >= total) return;
    const float* cW; bf16_t* cWt; int cldw, cldt, cmode, ck0, cn0, cf16;
    CONV_DECODE(it, cW, cWt, cldw, cldt, cmode, ck0, cn0, cf16);
    f32x4 a[8];
    { const float* src = cW + (long)(ck0 + c.wave * 8) * cldw + cn0 + c.lane * 4;
#pragma unroll
      for (int i = 0; i < 8; ++i) a[i] = *(const f32x4*)(src + (long)i * cldw); }
    for (;;) {
#pragma unroll
        for (int i = 0; i < 8; ++i) { const int k = c.wave * 8 + i;
#pragma unroll
            for (int q = 0; q < 4; ++q) scr[k * 257 + c.lane * 4 + q] = a[i][q]; }
        __syncthreads();
        const int itn = it + c.G; const bool more = itn < total;
        const float* nW = cW; bf16_t* nWt = cWt; int nldw = cldw, nldt = cldt, nmode = cmode, nk0 = ck0, nn0 = cn0, nf16 = cf16;
        if (more) { CONV_DECODE(itn, nW, nWt, nldw, nldt, nmode, nk0, nn0, nf16);
            const float* src = nW + (long)(nk0 + c.wave * 8) * nldw + nn0 + c.lane * 4;
#pragma unroll
            for (int i = 0; i < 8; ++i) a[i] = *(const f32x4*)(src + (long)i * nldw); }
        const int sub = c.lane >> 5, kk = (c.lane & 31) * 2;
#pragma unroll 4
        for (int j = 0; j < 16; ++j) { const int n = c.wave * 32 + 2 * j + sub;
            const float v0 = scr[kk * 257 + n], v1 = scr[(kk + 1) * 257 + n];
            const long orow = cmode == 0 ? (long)(cn0 + n) : il_row(cn0 + n, cmode - 1);
            if (cf16 >= 2) { const float ws_ = cf16 == 2 ? W8_SCALE : 1.0f; *(unsigned short*)((unsigned char*)cWt + orow * cldt + ck0 + kk) = (unsigned short)cvt_pk2_fp8(v0 * ws_, v1 * ws_); continue; }
            *(unsigned*)(cWt + orow * cldt + ck0 + kk) = cf16 ? cvt_pk_f16(v0, v1) : cvt_pk_bf16(v0, v1); }
        __syncthreads();
        if (!more) break;
        it = itn; cW = nW; cWt = nWt; cldw = nldw; cldt = nldt; cmode = nmode; ck0 = nk0; cn0 = nn0; cf16 = nf16;
    }
}
#undef CONV_DECODE

template <int MODE>
DI void ln_phase(const Ctx& c, float* OUTF, bf16_t* X16, const float* g, const float* b,
                 const bf16_t* YE, const int* INV_in, const float* wr_lds_src  , float* AFFT, int* INV_out, bf16_t* UH, const bf16_t* HB_in = nullptr, const float* GATE_in = nullptr) {
    LAS float* wT = (LAS float*)c.lds;
    if (MODE & 2) {
        for (int i = c.tid; i < 16 * 1024; i += 512) { const int cc = i >> 4, e = i & 15; wT[e * 1024 + cc] = wr_lds_src[i]; }
        __syncthreads();
    }
    f32x4 gv[4], bv[4];
#pragma unroll
    for (int j = 0; j < 4; ++j) { gv[j] = *(const f32x4*)(g + j * 256 + c.lane * 4); bv[j] = *(const f32x4*)(b + j * 256 + c.lane * 4); }
    f32x4 vprev[4]; int rowprev = 0, itn = 0;
#pragma unroll
    for (int j = 0; j < 4; ++j) vprev[j] = (f32x4){0.f, 0.f, 0.f, 0.f};
    for (int row = c.gw; row < NTOK; row += c.ngw, ++itn) {
        bf16_t* xr = X16 + (long)row * DM + c.lane * 4;
        f32x4 v[4];
#pragma unroll
        for (int j = 0; j < 4; ++j) { const u32x2 w = *(const u32x2*)(xr + j * 256); const f32x2 a = unpk_f16(w.x), bq = unpk_f16(w.y); v[j] = (f32x4){a.x, a.y, bq.x, bq.y}; }
        if ((MODE & 8) && (MODE & 64)) {
            const unsigned char* hr = (const unsigned char*)HB_in + (long)row * DM + c.lane * 4;
#pragma unroll
            for (int j = 0; j < 4; ++j) { const unsigned w = *(const unsigned*)(hr + j * 256);
                const f32x2 lo = __builtin_amdgcn_cvt_pk_f32_fp8((int)w, false), hi2 = __builtin_amdgcn_cvt_pk_f32_fp8((int)w, true);
                v[j][0] = v[j][0] * ALPHA + lo[0] * (1.0f / 64.0f); v[j][1] = v[j][1] * ALPHA + lo[1] * (1.0f / 64.0f); v[j][2] = v[j][2] * ALPHA + hi2[0] * (1.0f / 64.0f); v[j][3] = v[j][3] * ALPHA + hi2[1] * (1.0f / 64.0f); }
        } else if (MODE & 8) {
            const bf16_t* hr = HB_in + (long)row * DM + c.lane * 4;
#pragma unroll
            for (int j = 0; j < 4; ++j) { const u32x2 w = *(const u32x2*)(hr + j * 256);
                v[j][0] = v[j][0] * ALPHA + bf2f(w.x & 0xffffu); v[j][1] = v[j][1] * ALPHA + bf2f(w.x >> 16); v[j][2] = v[j][2] * ALPHA + bf2f(w.y & 0xffffu); v[j][3] = v[j][3] * ALPHA + bf2f(w.y >> 16); }
        }
        if (MODE & 1) {
#pragma unroll
            for (int j = 0; j < 4; ++j) v[j] = v[j] * ALPHA;
            const int grp = row >> 15;
            const int myp = c.lane < 16 ? INV_in[(long)row * 16 + c.lane] : -1;
            unsigned long long msk = __ballot(myp >= 0);
            while (msk) {
                int pos[4]; bool ok[4]; float gt[4];
#pragma unroll
                for (int q = 0; q < 4; ++q) { ok[q] = msk != 0ull; const int e = ok[q] ? __builtin_ctzll(msk) : 0; msk &= msk - 1ull; const int pz = __builtin_amdgcn_readlane(myp, e); pos[q] = ok[q] ? ((grp * 16 + e) * CAP + pz) : 0;
                    gt[q] = GATE_in ? GATE_in[pos[q]] * 0.125f : 1.0f; }
                unsigned w[4][4];
#pragma unroll
                for (int q = 0; q < 4; ++q) if (ok[q]) { const unsigned char* yr = (const unsigned char*)YE + (long)pos[q] * DM + c.lane * 4;
#pragma unroll
                    for (int j = 0; j < 4; ++j) w[q][j] = *(const unsigned*)(yr + j * 256); }
#pragma unroll
                for (int q = 0; q < 4; ++q) if (ok[q]) {
#pragma unroll
                    for (int j = 0; j < 4; ++j) { const f32x2 lo = __builtin_amdgcn_cvt_pk_f32_fp8((int)w[q][j], false), hi2 = __builtin_amdgcn_cvt_pk_f32_fp8((int)w[q][j], true);
                        v[j][0] += gt[q] * lo[0]; v[j][1] += gt[q] * lo[1]; v[j][2] += gt[q] * hi2[0]; v[j][3] += gt[q] * hi2[1]; } }
            }
        }
        float s = 0.f;
#pragma unroll
        for (int j = 0; j < 4; ++j) s += (v[j][0] + v[j][1]) + (v[j][2] + v[j][3]);
        const float mean = wave_sum(s) * (1.0f / DM);
        float q = 0.f;
#pragma unroll
        for (int j = 0; j < 4; ++j) { const f32x4 d = v[j] - mean; q += (d[0] * d[0] + d[1] * d[1]) + (d[2] * d[2] + d[3] * d[3]); }
        const float rstd = rsqrtf(wave_sum(q) * (1.0f / DM) + LN_EPS);
#pragma unroll
        for (int j = 0; j < 4; ++j) { v[j] = (v[j] - mean) * rstd * gv[j] + bv[j]; if (MODE & 16) *(f32x4*)(OUTF + (long)row * DM + c.lane * 4 + j * 256) = v[j]; }
#pragma unroll
        for (int j = 0; j < 4; ++j) { u32x2 w; w.x = cvt_pk_f16(v[j][0], v[j][1]); w.y = cvt_pk_f16(v[j][2], v[j][3]); if (!(MODE & 16)) *(u32x2*)(xr + j * 256) = w;
            if (MODE & (2 | 32)) *(unsigned*)((unsigned char*)UH + (long)row * DM + c.lane * 4 + j * 256) = cvt_pk4_fp8(v[j][0], v[j][1], v[j][2], v[j][3]);
            if (MODE & 4) { const int gi = j * 16 + (c.lane >> 2);
                u32x2 wb; wb.x = cvt_pk_bf16(v[j][0], v[j][1]); wb.y = cvt_pk_bf16(v[j][2], v[j][3]);
                *(u32x2*)(UH + ((long)gi * 2048 + (row >> 5)) * 768 + (row & 31) * 16 + (c.lane & 3) * 4) = wb; } }
        if ((MODE & 2) && !(itn & 1)) {
#pragma unroll
            for (int j = 0; j < 4; ++j) vprev[j] = v[j];
            rowprev = row;
        }
        if ((MODE & 2) && (itn & 1)) {
            float pe2[2][16];
            f32x2 xy[4][4];
#pragma unroll
            for (int j = 0; j < 4; ++j)
#pragma unroll
                for (int k = 0; k < 4; ++k) xy[j][k] = (f32x2){vprev[j][k], v[j][k]};
#pragma unroll
            for (int e = 0; e < 16; ++e) { f32x2 a = {0.f, 0.f};
#pragma unroll
                for (int j = 0; j < 4; ++j) { const f32x4 w = *(const LAS f32x4*)(wT + e * 1024 + j * 256 + c.lane * 4);
#pragma unroll
                    for (int k = 0; k < 4; ++k) a = xy[j][k] * (f32x2){w[k], w[k]} + a; }
                pe2[0][e] = a.x; pe2[1][e] = a.y; if (e & 1) __builtin_amdgcn_sched_barrier(0); }
#pragma unroll
            for (int hh = 0; hh < 2; ++hh) { const int rrow = hh == 0 ? rowprev : row;
            float pe[16];
#pragma unroll
            for (int e = 0; e < 16; ++e) pe[e] = pe2[hh][e];
            float q8[8], q4[4], q2[2], q1;
            { const bool up = (c.lane & 32) != 0;
#pragma unroll
              for (int k = 0; k < 8; ++k) { const float keep = up ? pe[k + 8] : pe[k], give = up ? pe[k] : pe[k + 8]; q8[k] = keep + __shfl_xor(give, 32); } }
            { const bool up = (c.lane & 16) != 0;
#pragma unroll
              for (int k = 0; k < 4; ++k) { const float keep = up ? q8[k + 4] : q8[k], give = up ? q8[k] : q8[k + 4]; q4[k] = keep + __shfl_xor(give, 16); } }
            { const bool up = (c.lane & 8) != 0;
#pragma unroll
              for (int k = 0; k < 2; ++k) { const float keep = up ? q4[k + 2] : q4[k], give = up ? q4[k] : q4[k + 2]; q2[k] = keep + __shfl_xor(give, 8); } }
            { const bool up = (c.lane & 4) != 0; const float keep = up ? q2[1] : q2[0], give = up ? q2[0] : q2[1]; q1 = keep + __shfl_xor(give, 4); }
            q1 += __shfl_xor(q1, 2); q1 += __shfl_xor(q1, 1);
            float mx = q1;
#pragma unroll
            for (int o = 32; o >= 4; o >>= 1) mx = fmaxf(mx, __shfl_xor(mx, o));
            const float ex = __expf(q1 - mx);
            float den = ex;
#pragma unroll
            for (int o = 32; o >= 4; o >>= 1) den += __shfl_xor(den, o);
            if ((c.lane & 3) == 0) { const int e = c.lane >> 2;
                AFFT[((long)(rrow >> 15) * 16 + e) * NGRP_TOK + (rrow & (NGRP_TOK - 1))] = ex / den; INV_out[(long)rrow * 16 + e] = -1; }
            }
        }
    }
    if (MODE & 2) __syncthreads();
}

DI void topk_phase(const Ctx& c, const float* AFFT, int* IDX, float* GATE, int* INV) {
    LAS unsigned* hist = (LAS unsigned*)c.lds;
    LAS unsigned* sel = hist + 8192;
    LAS unsigned* wsum = hist + 8196;
    for (int prob = c.bid; prob < 2 * NEXP; prob += c.G) {
        const unsigned* a = (const unsigned*)(AFFT + (long)prob * NGRP_TOK + c.tid * 64);
        unsigned prefix = 0u, mask = 0u; unsigned krem = CAP;
#pragma unroll 1
        for (int pass = 0; pass < 4; ++pass) {
            const int shift = 24 - 8 * pass;
            for (int i = c.tid; i < 8192; i += 512) hist[i] = 0u;
            __syncthreads();
#pragma unroll 2
            for (int i = 0; i < 16; ++i) { const u32x4 v = *(const u32x4*)(a + i * 4);
#pragma unroll
                for (int q = 0; q < 4; ++q) if ((v[q] & mask) == prefix) __hip_atomic_fetch_add(&hist[(((v[q] >> shift) & 255u) << 5) | (c.lane & 31)], 1u, __ATOMIC_RELAXED, __HIP_MEMORY_SCOPE_WORKGROUP); }
            __syncthreads();
            if (c.tid < 256) { unsigned t_ = 0u;
#pragma unroll 8
                for (int r = 0; r < 32; ++r) t_ += hist[(c.tid << 5) | ((r + c.tid) & 31)];
                sel[16 + c.tid] = t_; }
            __syncthreads();
            if (c.wave == 0) {
                const unsigned c0 = sel[16 + 4 * c.lane], c1 = sel[16 + 4 * c.lane + 1], c2 = sel[16 + 4 * c.lane + 2], c3 = sel[16 + 4 * c.lane + 3];
                const unsigned s = c0 + c1 + c2 + c3;
                unsigned suf = s;
#pragma unroll
                for (int o = 1; o < 64; o <<= 1) { const unsigned t = __shfl_down(suf, o); if (c.lane + o < 64) suf += t; }
                unsigned above = suf - s;
                if (above < krem && krem <= above + c3) { sel[0] = 4 * c.lane + 3; sel[1] = krem - above; } above += c3;
                if (above < krem && krem <= above + c2) { sel[0] = 4 * c.lane + 2; sel[1] = krem - above; } above += c2;
                if (above < krem && krem <= above + c1) { sel[0] = 4 * c.lane + 1; sel[1] = krem - above; } above += c1;
                if (above < krem && krem <= above + c0) { sel[0] = 4 * c.lane + 0; sel[1] = krem - above; }
            }
            __syncthreads();
            prefix |= sel[0] << shift; mask |= 255u << shift; krem = sel[1];
            __syncthreads();
        }
        unsigned cg = 0u, ce = 0u;
#pragma unroll 2
        for (int i = 0; i < 16; ++i) { const u32x4 v = *(const u32x4*)(a + i * 4);
#pragma unroll
            for (int q = 0; q < 4; ++q) { cg += v[q] > prefix ? 1u : 0u; ce += v[q] == prefix ? 1u : 0u; } }
        const unsigned pk = cg | (ce << 16); unsigned inc = pk;
#pragma unroll
        for (int o = 1; o < 64; o <<= 1) { const unsigned t = __shfl_up(inc, o); if (c.lane >= o) inc += t; }
        if (c.lane == 63) wsum[c.wave] = inc;
        __syncthreads();
        unsigned wbase = 0u;
        for (int w = 0; w < c.wave; ++w) wbase += wsum[w];
        const unsigned exc = wbase + inc - pk;
        unsigned pg = exc & 0xffffu, pe = exc >> 16;
        const unsigned ngt = CAP - krem;
        int* idx = IDX + (long)prob * CAP; float* gate = GATE + (long)prob * CAP;
        const int grp = prob >> 4, e = prob & 15;
#pragma unroll 1
        for (int i = 0; i < 16; ++i) { const u32x4 v = *(const u32x4*)(a + i * 4);
#pragma unroll
            for (int q = 0; q < 4; ++q) {
                int pos = -1;
                if (v[q] > prefix) pos = (int)(pg++);
                else if (v[q] == prefix) { if (pe < krem) pos = (int)(ngt + pe); ++pe; }
                if (pos >= 0) { const int n = c.tid * 64 + i * 4 + q; idx[pos] = n; gate[pos] = __uint_as_float(v[q]); INV[((long)grp * NGRP_TOK + n) * 16 + e] = pos; }
            } }
        __syncthreads();
    }
}

DI void prep_a(const Ctx& c, const bf16_t* QKV, const float* qgain, const float* kgain, unsigned char* Q8, unsigned char* K8, unsigned char* V8T) {
    LAS float* CS = (LAS float*)c.lds;
    for (int i = c.tid; i < 2048; i += 512) { const int pos = i >> 4, j = i & 15; float sn, cs; sincosf((float)pos * exp2f(-(float)j * (13.287712379549449f / 16.0f)), &sn, &cs); CS[i] = cs; CS[2048 + i] = sn; }
    __syncthreads();
    const int hl = c.lane >> 3, half = (c.lane >> 2) & 1, jq = c.lane & 3;
    const int d1 = half * 32 + jq * 4;
    const long nitem = (long)NTOK * 5 / 2;
    for (long it = c.gw; it < nitem; it += c.ngw) {
        const long hg = it * 8 + hl;
        const int row = (int)(hg / 20), hd = (int)(hg % 20);
        const int s = seq_of_row(row), t = row - seq_base(s);
        const int pos = half == 0 ? (t >> 6) : (t & 63);
        const bf16_t* p = QKV + (long)row * 1536 + hd * 64 + d1;
        const u32x2 a = *(const u32x2*)p, b = *(const u32x2*)(p + 16);
        float x1[4] = {bf2f(a.x & 0xffffu), bf2f(a.x >> 16), bf2f(a.y & 0xffffu), bf2f(a.y >> 16)}, x2[4] = {bf2f(b.x & 0xffffu), bf2f(b.x >> 16), bf2f(b.y & 0xffffu), bf2f(b.y >> 16)};
        float ss = 0.f;
#pragma unroll
        for (int q = 0; q < 4; ++q) ss += x1[q] * x1[q] + x2[q] * x2[q];
        ss += __shfl_xor(ss, 1); ss += __shfl_xor(ss, 2); ss += __shfl_xor(ss, 4);
        const float rinv = rsqrtf(ss * (1.0f / 64.0f) + 1e-6f) * (hd < 16 ? 0.125f * LOG2E : 1.0f);
        const float* gn = (hd < 16 ? qgain : kgain) + d1;
        const f32x4 g1 = *(const f32x4*)gn, g2 = *(const f32x4*)(gn + 16);
        const f32x4 cs = *(const LAS f32x4*)(CS + pos * 16 + jq * 4), sn = *(const LAS f32x4*)(CS + 2048 + pos * 16 + jq * 4);
        float o1[4], o2[4];
#pragma unroll
        for (int q = 0; q < 4; ++q) { const float y1 = x1[q] * rinv * g1[q], y2 = x2[q] * rinv * g2[q]; o1[q] = y1 * cs[q] - y2 * sn[q]; o2[q] = y1 * sn[q] + y2 * cs[q]; }
        unsigned char* o8 = hd < 16 ? Q8 + (long)row * 1024 + hd * 64 + d1 : K8 + (long)row * 256 + (hd - 16) * 64 + d1;
        *(unsigned*)o8 = cvt_pk4_fp8(o1[0], o1[1], o1[2], o1[3]); *(unsigned*)(o8 + 16) = cvt_pk4_fp8(o2[0], o2[1], o2[2], o2[3]);
    }
    for (int it = c.gw; it < (NTOK / 64) * 4; it += c.ngw) {
        const int tile = it >> 2, kh = it & 3, row = tile * 64 + c.lane;
        const int sq = seq_of_row(row); const long rb = seq_base(sq); const int S = seq_len(sq), tl = (int)(tile * 64 - rb);
        const int k = c.lane, w = k & 31, pos = ((w >> 2) & 1) * 32 + (k >> 5) * 16 + (w >> 3) * 4 + (w & 3);
        const bf16_t* vp = QKV + (long)row * 1536 + 1280 + kh * 64;
        unsigned char* dst = V8T + rb * 256 + (long)(kh * 64) * S + tl + pos;
#pragma unroll
        for (int q = 0; q < 8; ++q) { const u32x4 v = *(const u32x4*)(vp + q * 8);
            const unsigned p0 = cvt_pk4_fp8(bf2f(v.x & 0xffffu), bf2f(v.x >> 16), bf2f(v.y & 0xffffu), bf2f(v.y >> 16)), p1 = cvt_pk4_fp8(bf2f(v.z & 0xffffu), bf2f(v.z >> 16), bf2f(v.w & 0xffffu), bf2f(v.w >> 16));
#pragma unroll
            for (int e = 0; e < 4; ++e) { dst[(long)(q * 8 + e) * S] = (unsigned char)(p0 >> (8 * e)); dst[(long)(q * 8 + 4 + e) * S] = (unsigned char)(p1 >> (8 * e)); } }
    }
    __syncthreads();
}
#define MFMA32(a, b, c) __builtin_amdgcn_mfma_f32_32x32x16_bf16((a), (b), (c), 0, 0, 0)
typedef short v4i16_t __attribute__((ext_vector_type(4)));
constexpr int KST = 144;
DI s16x4 vtr(const LAS char* p) { return __builtin_bit_cast(s16x4, __builtin_amdgcn_ds_read_tr16_b64_v4i16((LAS v4i16_t*)p)); }
DI bf16x8 pack8(const f32x16& p, int s) {
    u32x4 w; w.x = cvt_pk_bf16(p[8 * s], p[8 * s + 1]); w.y = cvt_pk_bf16(p[8 * s + 2], p[8 * s + 3]); w.z = cvt_pk_bf16(p[8 * s + 4], p[8 * s + 5]); w.w = cvt_pk_bf16(p[8 * s + 6], p[8 * s + 7]);
    return __builtin_bit_cast(bf16x8, w); }
DI float max16(const f32x16& s) {
    float a = fmaxf(fmaxf(s[0], s[1]), fmaxf(s[2], s[3])), b = fmaxf(fmaxf(s[4], s[5]), fmaxf(s[6], s[7]));
    float cc = fmaxf(fmaxf(s[8], s[9]), fmaxf(s[10], s[11])), d = fmaxf(fmaxf(s[12], s[13]), fmaxf(s[14], s[15]));
    return fmaxf(fmaxf(a, b), fmaxf(cc, d)); }
DI float sum16(const f32x16& s) {
    return ((s[0] + s[1]) + (s[2] + s[3])) + ((s[4] + s[5]) + (s[6] + s[7])) + ((s[8] + s[9]) + (s[10] + s[11])) + ((s[12] + s[13]) + (s[14] + s[15])); }
DI f32x16 zero16() { f32x16 z;
#pragma unroll
    for (int i = 0; i < 16; ++i) z[i] = 0.f;
    return z; }
DI void pv_block(const LAS char* Vt, const f32x16& p, f32x16& O0, f32x16& O1, int lane) {
    const int hi = lane >> 5, blk = (lane >> 4) & 1, q4 = (lane & 15) >> 2, pp = lane & 3;
#pragma unroll
    for (int s = 0; s < 2; ++s) {
        const bf16x8 pf = pack8(p, s);
        const LAS char* r0 = Vt + (16 * s + 4 * hi + q4) * KST + 32 * blk + 8 * pp;
        const s16x4 a0 = vtr(r0), a1 = vtr(r0 + 8 * KST), b0 = vtr(r0 + 64), b1 = vtr(r0 + 8 * KST + 64);
        const bf16x8 v0 = __builtin_shufflevector(a0, a1, 0, 1, 2, 3, 4, 5, 6, 7), v1 = __builtin_shufflevector(b0, b1, 0, 1, 2, 3, 4, 5, 6, 7);
        O0 = MFMA32(v0, pf, O0); O1 = MFMA32(v1, pf, O1);
    }
}
constexpr float ATT_THR = 8.0f;
#define LDS_BARRIER() asm volatile("s_waitcnt lgkmcnt(0)\n\ts_barrier" ::: "memory")
#define MX3(a, b, c) __builtin_fmaxf(__builtin_fmaxf((a), (b)), (c))
DI float rowmax32x(const f32x16& p0, const f32x16& p1) {
    float a = MX3(p0[0], p0[1], p1[0]), b = MX3(p0[2], p0[3], p1[1]); a = MX3(a, p1[2], p1[3]);
#pragma unroll
    for (int r = 4; r < 16; r += 4) { a = MX3(a, p0[r], p0[r + 1]); b = MX3(b, p0[r + 2], p0[r + 3]); a = MX3(a, p1[r], p1[r + 1]); b = MX3(b, p1[r + 2], p1[r + 3]); }
    const float mm = __builtin_fmaxf(a, b);
    const auto rr = __builtin_amdgcn_permlane32_swap(__float_as_uint(mm), __float_as_uint(mm), false, false);
    return __builtin_fmaxf(__uint_as_float(rr[0]), __uint_as_float(rr[1])); }
DI float make_qx(float m, int hi, bf16x8& qx) {
    const unsigned h = cvt_pk_bf16(-m, 0.f) & 0xffffu; const float hf = bf2f(h);
    const unsigned lo = cvt_pk_bf16(-m - hf, 0.f) & 0xffffu; const float lf = bf2f(lo);
    u32x4 w; w.x = hi == 0 ? (h | (lo << 16)) : 0u; w.y = 0u; w.z = 0u; w.w = 0u; qx = __builtin_bit_cast(bf16x8, w);
    return -(hf + lf); }
DI void qk_tile_x(const LAS char* Klane, const bf16x8 (&qf)[4], const bf16x8& kx, const bf16x8& qx, f32x16& s0, f32x16& s1) {
    s0 = MFMA32(kx, qx, zero16()); s1 = MFMA32(kx, qx, zero16());
#pragma unroll
    for (int ks = 0; ks < 4; ++ks) {
        const bf16x8 k0 = *(const LAS bf16x8*)(Klane + ks * 32), k1 = *(const LAS bf16x8*)(Klane + 32 * KST + ks * 32);
        s0 = MFMA32(k0, qf[ks], s0); s1 = MFMA32(k1, qf[ks], s1); }
}
DI void exp_pack_x(f32x16& s0, f32x16& s1, bf16x8 (&pf)[4]) {
#pragma unroll
    for (int r = 0; r < 16; ++r) { s0[r] = fast_exp2(s0[r]); s1[r] = fast_exp2(s1[r]); }
    pf[0] = pack8(s0, 0); pf[1] = pack8(s0, 1); pf[2] = pack8(s1, 0); pf[3] = pack8(s1, 1);
}
DI void pv_tile_x(const LAS char* Vlane, const bf16x8 (&pf)[4], const bf16x8& ones, f32x16& O0, f32x16& O1, f32x16& Ls) {
#pragma unroll
    for (int ks = 0; ks < 4; ++ks) {
        const LAS char* r0 = Vlane + 16 * ks * KST;
        const s16x4 a0 = vtr(r0), a1 = vtr(r0 + 8 * KST), b0 = vtr(r0 + 64), b1 = vtr(r0 + 8 * KST + 64);
        const bf16x8 v0 = __builtin_shufflevector(a0, a1, 0, 1, 2, 3, 4, 5, 6, 7), v1 = __builtin_shufflevector(b0, b1, 0, 1, 2, 3, 4, 5, 6, 7);
        O0 = MFMA32(v0, pf[ks], O0); O1 = MFMA32(v1, pf[ks], O1); Ls = MFMA32(ones, pf[ks], Ls);
    }
}
DI void pv_tile(const LAS char* Vt, const bf16x8 (&pf)[4], f32x16& O0, f32x16& O1, int lane) {
    const int hi = lane >> 5, blk = (lane >> 4) & 1, q4 = (lane & 15) >> 2, pp = lane & 3;
#pragma unroll
    for (int ks = 0; ks < 4; ++ks) {
        const LAS char* r0 = Vt + (16 * ks + 4 * hi + q4) * KST + 32 * blk + 8 * pp;
        const s16x4 a0 = vtr(r0), a1 = vtr(r0 + 8 * KST), b0 = vtr(r0 + 64), b1 = vtr(r0 + 8 * KST + 64);
        const bf16x8 v0 = __builtin_shufflevector(a0, a1, 0, 1, 2, 3, 4, 5, 6, 7), v1 = __builtin_shufflevector(b0, b1, 0, 1, 2, 3, 4, 5, 6, 7);
        O0 = MFMA32(v0, pf[ks], O0); O1 = MFMA32(v1, pf[ks], O1);
    }
}
#define MFMA_ACC(acc, a, b) acc = MFMA32(a, b, acc)
constexpr int KST8 = 80;
constexpr float A8_TGT = 6.0f, A8_HI = 8.0f;
#define MFMA8(a, b, c) __builtin_amdgcn_mfma_scale_f32_32x32x64_f8f6f4((a), (b), (c), 0, 0, 0, 127, 0, 127)
DI i32x8 cat8(const u32x4& lo, const u32x4& hi) { return __builtin_bit_cast(i32x8, __builtin_shufflevector(lo, hi, 0, 1, 2, 3, 4, 5, 6, 7)); }
DI void attn_a_phase(const Ctx& c, const unsigned char* Q8, const unsigned char* K8, const unsigned char* V8T, bf16_t* OB) {
    constexpr int SLOT8 = 64 * KST8, NK = 3, NV = 4;
    const int r32 = c.lane & 31, hi = c.lane >> 5;
    LAS char* KB = (LAS char*)c.lds; LAS char* VB = KB + NK * SLOT8;
    const LAS char* Klane = KB + r32 * KST8 + hi * 32;
    const LAS char* Vlane = VB + r32 * KST8 + hi * 32;
    i32x8 ones8 = {0x38383838, 0x38383838, 0x38383838, 0x38383838, 0x38383838, 0x38383838, 0x38383838, 0x38383838};
    asm volatile("" : "+v"(ones8));
    const bool kld = c.wave < 4;
    const int pr = (c.tid & 255) >> 2, pc4 = (c.tid & 3) * 16, ldp = pr * KST8 + pc4;
    for (int L = c.bid; L < 4096; L += c.G) {
        int s, kh, qblk;
        if (L < 2048) { s = L >> 8; kh = (L >> 6) & 3; qblk = L & 63; } else { const int u = L - 2048; s = 8 + (u >> 9); kh = (u >> 7) & 3; qblk = u & 127; }
        const int S = seq_len(s); const long rb = seq_base(s);
        const int hq = kh * 4 + (c.wave >> 1), q0 = qblk * 64 + (c.wave & 1) * 32;
        i32x8 qf8;
        { const unsigned char* qp = Q8 + (rb + q0 + r32) * 1024 + hq * 64 + hi * 32; qf8 = cat8(*(const u32x4*)qp, *(const u32x4*)(qp + 16)); }
        const unsigned char* src = kld ? K8 + (rb + pr) * 256 + kh * 64 + pc4 : V8T + rb * 256 + (long)(kh * 64 + pr) * S + pc4;
        const long tstep = kld ? 64l * 256 : 64l;
        const int NT = S >> 6;
#define A_LOAD(tile) do { preg = *(const u32x4*)(src + (long)(tile) * tstep); } while (0)
#define A_STORE(tile) do { if (kld) *(LAS u32x4*)(KB + ((tile) % NK) * SLOT8 + ldp) = preg; else *(LAS u32x4*)(VB + ((tile) % NV) * SLOT8 + ldp) = preg; } while (0)
        u32x4 preg;
        A_LOAD(0); A_STORE(0); A_LOAD(1); A_STORE(1); A_LOAD(2);
        __syncthreads();
        f32x16 O0 = zero16(), O1 = zero16(), Ls = zero16(), sa0, sa1, sb0, sb1;
        i32x8 p8 = {0, 0, 0, 0, 0, 0, 0, 0};
        u32x4 vl0, vh0, vl1, vh1;
        float m, msc;
#define A_KFR(kbase) const u32x4 kl0_ = *(const LAS u32x4*)(kbase), kh0_ = *(const LAS u32x4*)((kbase) + 16), kl1_ = *(const LAS u32x4*)((kbase) + 32 * KST8), kh1_ = *(const LAS u32x4*)((kbase) + 32 * KST8 + 16)
#define A_QK(S0, S1) do { __builtin_amdgcn_s_setprio(1); S0 = MFMA8(cat8(kl0_, kh0_), qf8, zero16()); S1 = MFMA8(cat8(kl1_, kh1_), qf8, zero16()); __builtin_amdgcn_s_setprio(0); } while (0)
#define A_VFR(vbase) do { vl0 = *(const LAS u32x4*)(vbase); vh0 = *(const LAS u32x4*)((vbase) + 16); vl1 = *(const LAS u32x4*)((vbase) + 32 * KST8); vh1 = *(const LAS u32x4*)((vbase) + 32 * KST8 + 16); } while (0)
#define A_EXP(S0, S1) do { \
            _Pragma("unroll") for (int r = 0; r < 16; ++r) { S0[r] = fast_exp2(S0[r]); S1[r] = fast_exp2(S1[r]); } \
            _Pragma("unroll") for (int w = 0; w < 4; ++w) { p8[w] = (int)cvt_pk4_fp8_sc((unsigned)p8[w], S0[4 * w], S0[4 * w + 1], S0[4 * w + 2], S0[4 * w + 3], msc); \
                                                            p8[4 + w] = (int)cvt_pk4_fp8_sc((unsigned)p8[4 + w], S1[4 * w], S1[4 * w + 1], S1[4 * w + 2], S1[4 * w + 3], msc); } } while (0)
#define A_PV() do { __builtin_amdgcn_s_setprio(1); O0 = MFMA8(cat8(vl0, vh0), p8, O0); O1 = MFMA8(cat8(vl1, vh1), p8, O1); Ls = MFMA8(ones8, p8, Ls); __builtin_amdgcn_s_setprio(0); } while (0)
#define A_TAIL(t_) do { A_STORE((t_) + 2); asm volatile("" ::: "memory"); A_VFR(Vlane + ((t_) % NV) * SLOT8); asm volatile("s_waitcnt lgkmcnt(4)\n\ts_barrier" ::: "memory"); } while (0)
        { A_KFR(Klane); A_QK(sa0, sa1); }
        { const float mx = rowmax32x(sa0, sa1); m = __builtin_floorf(mx) - A8_TGT; msc = __int_as_float(((int)m + 127) << 23); }
        { A_KFR(Klane + SLOT8); A_EXP(sa0, sa1); A_QK(sb0, sb1); }
        A_TAIL(0);
#define A_BLOCK(t_, SI0, SI1, SO0, SO1) do { \
            { const int tl_ = (t_) + 2 < NT ? (t_) + 2 : NT - 1; A_LOAD(tl_); } \
            A_KFR(Klane + (((t_) + 1) % NK) * SLOT8); \
            A_PV(); \
            const float mx = rowmax32x(SI0, SI1); \
            if (__any(mx - m > A8_HI)) { \
                const float mn = __builtin_fmaxf(__builtin_floorf(mx) - A8_TGT, m), al = fast_exp2(m - mn); m = mn; msc = __int_as_float(((int)m + 127) << 23); \
                _Pragma("unroll") for (int r = 0; r < 16; ++r) { O0[r] *= al; O1[r] *= al; Ls[r] *= al; } } \
            A_EXP(SI0, SI1); \
            A_QK(SO0, SO1); \
            A_TAIL(t_); } while (0)
        for (int t = 1; t + 1 < NT; t += 2) { A_BLOCK(t, sb0, sb1, sa0, sa1); A_BLOCK(t + 1, sa0, sa1, sb0, sb1); }
        A_BLOCK(NT - 1, sb0, sb1, sa0, sa1);
        A_PV();
#undef A_KFR
#undef A_QK
#undef A_VFR
#undef A_EXP
#undef A_PV
#undef A_TAIL
#undef A_BLOCK
#undef A_LOAD
#undef A_STORE
        const float inv = fast_rcp(Ls[0]) * 64.0f;
        unsigned char* op = (unsigned char*)OB + (rb + q0 + r32) * DM + hq * 64 + 4 * hi;
#pragma unroll
        for (int j = 0; j < 4; ++j) {
            *(unsigned*)(op + 8 * j) = cvt_pk4_fp8(O0[4 * j] * inv, O0[4 * j + 1] * inv, O0[4 * j + 2] * inv, O0[4 * j + 3] * inv);
            *(unsigned*)(op + 32 + 8 * j) = cvt_pk4_fp8(O1[4 * j] * inv, O1[4 * j + 1] * inv, O1[4 * j + 2] * inv, O1[4 * j + 3] * inv); }
        __syncthreads();
    }
}

DI int t5_bucket(int rel) {
    const int n = rel < 0 ? -rel : rel;
    int large = 8 + (int)(logf((float)(n < 1 ? 1 : n) / 8.0f) / 2.772588722239781f * 8.0f);
    large = large < 15 ? large : 15;
    return (rel > 0 ? 16 : 0) + (n < 8 ? n : large);
}
DI void attn_d_phase(const Ctx& c, const bf16_t* QKV, bf16_t* OB, const float* rel_bias, const float* dlam, const float* ngain, float lambda_init) {
    constexpr int LQ = 2304, SLOT = 64 * KST;
    const int r32 = c.lane & 31, hi = c.lane >> 5;
    LAS char* KB = (LAS char*)c.lds; LAS char* VB = KB + 2 * SLOT;
    LAS float* LUT = (LAS float*)(c.lds + 4 * SLOT);
    for (int i = c.tid; i < 12 * 256; i += 512) { const int h = i >> 8, e = i & 255; const int rel = (e < 255 ? e : 254) - 127; LUT[i] = rel_bias[t5_bucket(rel) * 12 + h] * LOG2E; }
    float lam;
    { const int i = c.lane & 31; const float a = wave_sum(c.lane < 32 ? dlam[i] * dlam[32 + i] : 0.f), b = wave_sum(c.lane < 32 ? dlam[64 + i] * dlam[96 + i] : 0.f);
      lam = __expf(a) - __expf(b) + lambda_init; }
    const LAS char* Klane = KB + r32 * KST + hi * 16;
    const LAS char* Vlane = VB + (4 * hi + ((c.lane & 15) >> 2)) * KST + 32 * ((c.lane >> 4) & 1) + 8 * (c.lane & 3);
    bf16x8 kx;
    { u32x4 w; w.x = hi == 0 ? 0x3F803F80u : 0u; w.y = 0u; w.z = 0u; w.w = 0u; kx = __builtin_bit_cast(bf16x8, w); }
    __syncthreads();
    for (int L = c.bid; L < 3072; L += c.G) {
        int s, h, qblk;
        if (L < 1536) { s = L / 192; const int r = L % 192; h = r >> 4; qblk = r & 15; } else { const int u = L - 1536; s = 8 + u / 384; const int r = u % 384; h = r >> 5; qblk = r & 31; }
        const int S = seq_len(s); const long rb = seq_base(s);
        const int q0 = qblk * 256 + c.wave * 32;
        bf16x8 qf[2][2];
        { const bf16_t* qp = QKV + (rb + q0 + r32) * LQ + h * 64 + hi * 8;
#pragma unroll
          for (int mm = 0; mm < 2; ++mm)
#pragma unroll
              for (int ks = 0; ks < 2; ++ks) qf[mm][ks] = *(const bf16x8*)(qp + mm * 32 + ks * 16); }
        const bf16_t* kg = QKV + (rb + (c.tid >> 3)) * LQ + 768 + h * 64 + (c.tid & 7) * 8;
        const int ldst = (c.tid >> 3) * KST + (c.tid & 7) * 16;
        u32x4 kr = *(const u32x4*)kg, vr = *(const u32x4*)(kg + 768);
        *(LAS u32x4*)(KB + ldst) = kr; *(LAS u32x4*)(VB + ldst) = vr;
        asm volatile("" :: "v"(qf[0][0]), "v"(qf[0][1]), "v"(qf[1][0]), "v"(qf[1][1]));
        __syncthreads();
        f32x16 Oa0 = zero16(), Oa1 = zero16(), Ob0 = zero16(), Ob1 = zero16();
        const LAS float* lut = LUT + h * 256;
        const float bneg = lut[0], bpos = lut[254];
        bf16x8 qxa, qxb; float ra = make_qx(-100.f, hi, qxa), rbb = make_qx(-100.f, hi, qxb), la = 0.f, lb = 0.f, boff = 0.f;
        const int NT = S >> 6;
        for (int t = 0; t < NT; ++t) {
            const int buf = t & 1;
            if (t + 1 < NT) { const bf16_t* kn = kg + (long)(t + 1) * 64 * LQ; kr = *(const u32x4*)kn; vr = *(const u32x4*)(kn + 768); }
            const LAS char* Kt = Klane + buf * SLOT; const LAS char* Vt = Vlane + buf * SLOT;
            const int k0 = t * 64, dmin = k0 - (q0 + 31), dmax = k0 + 63 - q0;
            const bool near = (dmax > -127) && (dmin < 127);
            const float bnew = near ? 0.f : (dmax <= -127 ? bneg : bpos);
            if (bnew != boff) { ra = make_qx(ra + boff - bnew, hi, qxa); rbb = make_qx(rbb + boff - bnew, hi, qxb); boff = bnew; }
            bf16x8 pa[4], pb[4];
#define D_BRANCH(KOFF, QF, QX, RR, LL, O0_, O1_, PP) do { \
                f32x16 s0 = MFMA32(kx, QX, zero16()), s1 = MFMA32(kx, QX, zero16()); \
                _Pragma("unroll") for (int ks = 0; ks < 2; ++ks) { \
                    const bf16x8 k0_ = *(const LAS bf16x8*)(Kt + (KOFF) + ks * 32), k1_ = *(const LAS bf16x8*)(Kt + 32 * KST + (KOFF) + ks * 32); \
                    s0 = MFMA32(k0_, QF[ks], s0); s1 = MFMA32(k1_, QF[ks], s1); } \
                if (near) { int relb = k0 + 4 * hi - (q0 + r32); asm volatile("" : "+v"(relb)); \
                    _Pragma("unroll") for (int r = 0; r < 16; ++r) { int rel = relb + (r & 3) + 8 * (r >> 2); int r1 = rel + 32; \
                        rel = rel < -127 ? -127 : (rel > 127 ? 127 : rel); r1 = r1 < -127 ? -127 : (r1 > 127 ? 127 : r1); s0[r] += lut[rel + 127]; s1[r] += lut[r1 + 127]; \
                        if ((r & 3) == 3) __builtin_amdgcn_sched_barrier(0); } } \
                const float mx = rowmax32x(s0, s1); \
                if (__any(mx > ATT_THR)) { \
                    const float ro = RR; RR = make_qx(RR + __builtin_fmaxf(mx, 0.f), hi, QX); const float d = RR - ro, al = fast_exp2(-d); LL *= al; \
                    _Pragma("unroll") for (int r = 0; r < 16; ++r) { s0[r] -= d; s1[r] -= d; O0_[r] *= al; O1_[r] *= al; } } \
                exp_pack_x(s0, s1, PP); { const f32x16 t_ = s0 + s1; LL += sum16(t_); } } while (0)
            D_BRANCH(0, qf[0], qxa, ra, la, Oa0, Oa1, pa);
            D_BRANCH(64, qf[1], qxb, rbb, lb, Ob0, Ob1, pb);
#undef D_BRANCH
#pragma unroll
            for (int ks = 0; ks < 4; ++ks) {
                const LAS char* r0 = Vt + 16 * ks * KST;
                const s16x4 x0 = vtr(r0), x1 = vtr(r0 + 8 * KST), y0 = vtr(r0 + 64), y1 = vtr(r0 + 8 * KST + 64);
                const bf16x8 v0 = __builtin_shufflevector(x0, x1, 0, 1, 2, 3, 4, 5, 6, 7), v1 = __builtin_shufflevector(y0, y1, 0, 1, 2, 3, 4, 5, 6, 7);
                Oa0 = MFMA32(v0, pa[ks], Oa0); Oa1 = MFMA32(v1, pa[ks], Oa1); Ob0 = MFMA32(v0, pb[ks], Ob0); Ob1 = MFMA32(v1, pb[ks], Ob1);
            }
            if (t + 1 < NT) { *(LAS u32x4*)(KB + (buf ^ 1) * SLOT + ldst) = kr; *(LAS u32x4*)(VB + (buf ^ 1) * SLOT + ldst) = vr; }
            __syncthreads();
        }
        la += __shfl_xor(la, 32); lb += __shfl_xor(lb, 32);
        const float ia = fast_rcp(la), ib = lam * fast_rcp(lb);
        float ss = 0.f;
#pragma unroll
        for (int r = 0; r < 16; ++r) { Oa0[r] = Oa0[r] * ia - Ob0[r] * ib; Oa1[r] = Oa1[r] * ia - Ob1[r] * ib; ss += Oa0[r] * Oa0[r] + Oa1[r] * Oa1[r]; }
        ss += __shfl_xor(ss, 32);
        const float rn = rsqrtf(ss * (1.0f / 64.0f) + 1e-6f) * (1.0f - lambda_init);
        bf16_t* op = OB + (rb + q0 + r32) * 768 + h * 64 + 4 * hi;
#pragma unroll
        for (int j = 0; j < 4; ++j) {
            const f32x4 g0 = *(const f32x4*)(ngain + 8 * j + 4 * hi), g1 = *(const f32x4*)(ngain + 32 + 8 * j + 4 * hi);
            u32x2 w0, w1;
            w0.x = cvt_pk_bf16(Oa0[4 * j] * rn * g0[0], Oa0[4 * j + 1] * rn * g0[1]); w0.y = cvt_pk_bf16(Oa0[4 * j + 2] * rn * g0[2], Oa0[4 * j + 3] * rn * g0[3]);
            w1.x = cvt_pk_bf16(Oa1[4 * j] * rn * g1[0], Oa1[4 * j + 1] * rn * g1[1]); w1.y = cvt_pk_bf16(Oa1[4 * j + 2] * rn * g1[2], Oa1[4 * j + 3] * rn * g1[3]);
            *(u32x2*)(op + 8 * j) = w0; *(u32x2*)(op + 32 + 8 * j) = w1; }
    }
    __syncthreads();
}

DI void attn_b_phase(const Ctx& c, const bf16_t* QKV, bf16_t* OB, const float* rel_bias) {
    constexpr int LQ = 2304;
    const int r32 = c.lane & 31, hi = c.lane >> 5;
    LAS float* LUT = (LAS float*)c.lds;
    LAS char* Vw = (LAS char*)c.lds + 8192 + c.wave * (32 * KST);
    for (int i = c.tid; i < 12 * 132; i += 512) { const int gh = i / 132, jj = i % 132; const int g = gh >> 2, d = g == 0 ? 1 : (g == 1 ? 4 : 16);
        LUT[i] = jj <= 128 ? rel_bias[t5_bucket(d * (jj - 64)) * 12 + gh] * LOG2E : 0.f; }
    __syncthreads();
    for (int L = c.bid; L < 1024; L += c.G) {
        int s, rem;
        if (L < 512) { s = L >> 6; rem = L & 63; } else { s = 8 + ((L - 512) >> 7); rem = (L - 512) & 127; }
        const int S = seq_len(s); const long rb = seq_base(s);
        const int hh = rem & 3, rhalf = (rem >> 2) & 1, blk = rem >> 3;
        const int t0 = blk * 512 + rhalf * 8 + c.wave;
        const int qpos = t0 + 16 * r32;
        f32x16 O[3][2]; float mg[3], lg[3];
#pragma unroll
        for (int g = 0; g < 3; ++g) {
            const int d = g == 0 ? 1 : (g == 1 ? 4 : 16), dsh = g == 0 ? 0 : (g == 1 ? 2 : 4), ntile = g == 0 ? 20 : (g == 1 ? 8 : 5);
            const int head = g * 4 + hh;
            bf16x8 qf[4];
            { const bf16_t* qp = QKV + (rb + qpos) * LQ + head * 64 + hi * 8;
#pragma unroll
              for (int ks = 0; ks < 4; ++ks) qf[ks] = *(const bf16x8*)(qp + ks * 16); }
            const LAS float* lut = LUT + (g * 4 + hh) * 132;
            f32x16 O0 = zero16(), O1 = zero16(); float m = -INFINITY, l = 0.f;
            const int kbase = t0 - 64 * d;
#pragma unroll 1
            for (int j = 0; j < ntile; ++j) {
                int kp = kbase + d * (32 * j + r32); kp = kp < 0 ? 0 : (kp >= S ? S - 1 : kp);
                const bf16_t* kr = QKV + (rb + kp) * LQ + 768 + head * 64 + hi * 8;
                bf16x8 kf[4];
#pragma unroll
                for (int ks = 0; ks < 4; ++ks) kf[ks] = *(const bf16x8*)(kr + ks * 16);
                u32x4 vv[4];
#pragma unroll
                for (int i = 0; i < 4; ++i) { const int id = c.lane + 64 * i, e = id >> 3; int vp = kbase + d * (32 * j + e); vp = vp < 0 ? 0 : (vp >= S ? S - 1 : vp);
                    vv[i] = *(const u32x4*)(QKV + (rb + vp) * LQ + 1536 + head * 64 + (id & 7) * 8); }
                f32x16 sc = zero16();
#pragma unroll
                for (int ks = 0; ks < 4; ++ks) sc = MFMA32(kf[ks], qf[ks], sc);
                float mx = -INFINITY;
                if ((kbase + d * 32 * j >= 0) && (kbase + d * (32 * j + 31) < S)) {
                    const int JB = 32 * j + 4 * hi - (16 >> dsh) * r32;
#pragma unroll
                    for (int r = 0; r < 16; ++r) {
                        const int jj = JB + (r & 3) + 8 * (r >> 2);
                        const bool ok = (unsigned)jj <= 128u;
                        const float bv = lut[ok ? jj : 0];
                        sc[r] = ok ? sc[r] * (0.125f * LOG2E) + bv : -INFINITY;
                        mx = fmaxf(mx, sc[r]);
                    }
                } else {
#pragma unroll
                for (int r = 0; r < 16; ++r) {
                    const int e = (r & 3) + 8 * (r >> 2) + 4 * hi;
                    const int kpos = kbase + d * (32 * j + e), rel = kpos - qpos;
                    const int jj = (rel >> dsh) + 64;
                    const bool ok = (jj >= 0) && (jj <= 128) && (kpos >= 0) && (kpos < S);
                    const float bv = lut[ok ? jj : 0];
                    sc[r] = ok ? sc[r] * (0.125f * LOG2E) + bv : -INFINITY;
                    mx = fmaxf(mx, sc[r]);
                }
                }
                { const auto rr = __builtin_amdgcn_permlane32_swap(__float_as_uint(mx), __float_as_uint(mx), false, false); mx = fmaxf(__uint_as_float(rr[0]), __uint_as_float(rr[1])); }
                const float mn = fmaxf(m, mx), msafe = (mn == -INFINITY) ? 0.f : mn, alpha = fast_exp2(m - msafe);
                m = mn;
#pragma unroll
                for (int r = 0; r < 16; ++r) sc[r] = fast_exp2(sc[r] - msafe);
                l = l * alpha + sum16(sc);
                O0 = O0 * alpha; O1 = O1 * alpha;
#pragma unroll
                for (int i = 0; i < 4; ++i) { const int id = c.lane + 64 * i; *(LAS u32x4*)(Vw + (id >> 3) * KST + (id & 7) * 16) = vv[i]; }
                asm volatile("s_waitcnt lgkmcnt(0)" ::: "memory");
                pv_block(Vw, sc, O0, O1, c.lane);
                asm volatile("s_waitcnt lgkmcnt(0)" ::: "memory");
            }
            l += __shfl_xor(l, 32);
            O[g][0] = O0; O[g][1] = O1; mg[g] = m; lg[g] = l;
        }
        const float M = fmaxf(fmaxf(mg[0], mg[1]), mg[2]);
        const float e0 = fast_exp2(mg[0] - M), e1 = fast_exp2(mg[1] - M), e2 = fast_exp2(mg[2] - M);
        const float inv = fast_rcp(lg[0] * e0 + lg[1] * e1 + lg[2] * e2);
        const float wg[3] = {e0 * inv, e1 * inv, e2 * inv};
#pragma unroll
        for (int g = 0; g < 3; ++g) {
            bf16_t* op = OB + (rb + qpos) * 768 + (g * 4 + hh) * 64 + 4 * hi;
#pragma unroll
            for (int j = 0; j < 4; ++j) {
                u32x2 w0, w1;
                w0.x = cvt_pk_bf16(O[g][0][4 * j] * wg[g], O[g][0][4 * j + 1] * wg[g]); w0.y = cvt_pk_bf16(O[g][0][4 * j + 2] * wg[g], O[g][0][4 * j + 3] * wg[g]);
                w1.x = cvt_pk_bf16(O[g][1][4 * j] * wg[g], O[g][1][4 * j + 1] * wg[g]); w1.y = cvt_pk_bf16(O[g][1][4 * j + 2] * wg[g], O[g][1][4 * j + 3] * wg[g]);
                *(u32x2*)(op + 8 * j) = w0; *(u32x2*)(op + 32 + 8 * j) = w1; }
        }
    }
    __syncthreads();
}
DI void s5_tables(const Ctx& c, const float* lam_re, const float* lam_im, const float* log_dt, const float* b_re, const float* b_im, const float* c_re, const float* c_im,
                  bf16_t* Mt, bf16_t* Pt, float* APL, float* KKG) {
    LAS float* AP = (LAS float*)c.lds;
    LAS float* BB = AP + 2 * 33 * 64 * 2;
    LAS float* CC = BB + 2 * 64 * 16 * 2;
    for (int item = c.bid; item < 256; item += c.G) {
        const int g = item >> 2, qt = item & 3;
        if (c.tid < 128) {
            const int dir = c.tid >> 6, p = c.tid & 63;
            const float lr = lam_re[(dir * 64 + g) * 64 + p], li = lam_im[(dir * 64 + g) * 64 + p];
            const float dt = expf(log_dt[dir * 64 + g]);
            const float mag = expf(lr * dt);
            const float th = li * dt;
            float sn_, cs_; sincosf(th, &sn_, &cs_); const float ar = mag * cs_, ai = mag * sn_;
            const float den = lr * lr + li * li;
            const float zr = ((ar - 1.0f) * lr + ai * li) / den, zi = (ai * lr - (ar - 1.0f) * li) / den;
            double pr = 1.0, pi = 0.0;
            for (int t = 0; t <= 32; ++t) { AP[((dir * 33 + t) * 64 + p) * 2] = (float)pr; AP[((dir * 33 + t) * 64 + p) * 2 + 1] = (float)pi;
                const double nr = pr * (double)ar - pi * (double)ai, ni = pr * (double)ai + pi * (double)ar; pr = nr; pi = ni; }
            for (int j = 0; j < 16; ++j) { const float br = b_re[((dir * 64 + g) * 64 + p) * 16 + j], bi = b_im[((dir * 64 + g) * 64 + p) * 16 + j];
                BB[((dir * 64 + p) * 16 + j) * 2] = zr * br - zi * bi; BB[((dir * 64 + p) * 16 + j) * 2 + 1] = zr * bi + zi * br; }
        }
        for (int i = c.tid; i < 2 * 16 * 64; i += 512) { const int dir = i >> 10, r = i & 1023;
            CC[i * 2] = c_re[(dir * 64 + g) * 1024 + r]; CC[i * 2 + 1] = c_im[(dir * 64 + g) * 1024 + r]; }
        __syncthreads();
        if (qt == 0 && c.tid < 128) { const int dir = c.tid >> 6, p = c.tid & 63; APL[((g * 2 + dir) * 64 + p) * 2] = AP[((dir * 33 + 32) * 64 + p) * 2]; APL[((g * 2 + dir) * 64 + p) * 2 + 1] = AP[((dir * 33 + 32) * 64 + p) * 2 + 1]; }
        if (c.tid < 256) {
            const int dir = c.tid >> 7, tau = 8 * qt + ((c.tid >> 4) & 7), j = c.tid & 15;
            float acc[16];
#pragma unroll
            for (int jp = 0; jp < 16; ++jp) acc[jp] = 0.f;
            for (int p = 0; p < 64; ++p) {
                const f32x2 cc = *(const LAS f32x2*)(CC + ((dir * 16 + j) * 64 + p) * 2), ee = *(const LAS f32x2*)(AP + ((dir * 33 + tau) * 64 + p) * 2);
                const float wr = cc.x * ee.x - cc.y * ee.y, wi = cc.x * ee.y + cc.y * ee.x;
                const LAS f32x4* bb = (const LAS f32x4*)(BB + (dir * 64 + p) * 32);
#pragma unroll
                for (int q4 = 0; q4 < 8; ++q4) { const f32x4 b = bb[q4]; acc[2 * q4] += wr * b[0] - wi * b[1]; acc[2 * q4 + 1] += wr * b[2] - wi * b[3]; }
            }
            float* kk = KKG + ((size_t)g * 2 + dir) * 8192 + (tau * 16 + j) * 16;
#pragma unroll
            for (int q4 = 0; q4 < 4; ++q4) *(f32x4*)(kk + 4 * q4) = (f32x4){acc[4 * q4], acc[4 * q4 + 1], acc[4 * q4 + 2], acc[4 * q4 + 3]};
        }
        bf16_t* mt = Mt + (long)g * 512 * 768;
        for (int o = c.tid; o < 128 * 128; o += 512) {
            const int n = 128 * qt + (o >> 7), k = 512 + (o & 127) * 2, i = n >> 4, j = n & 15;
            float v[2];
#pragma unroll
            for (int e = 0; e < 2; ++e) { const int q = k + e - 512, dir = q >> 7, part = (q >> 6) & 1, p = q & 63, pw = dir == 0 ? i + 1 : 32 - i;
                const float cr = CC[((dir * 16 + j) * 64 + p) * 2], ci = CC[((dir * 16 + j) * 64 + p) * 2 + 1];
                const float er = AP[((dir * 33 + pw) * 64 + p) * 2], ei = AP[((dir * 33 + pw) * 64 + p) * 2 + 1];
                v[e] = part == 0 ? (cr * er - ci * ei) : -(cr * ei + ci * er); }
            *(unsigned*)(mt + (long)n * 768 + k) = cvt_pk_bf16(v[0], v[1]);
        }
        bf16_t* pt = Pt + (long)g * 256 * 512;
        for (int o = c.tid; o < 64 * 256; o += 512) {
            const int q = 64 * qt + (o >> 8), k = (o & 255) * 2, dir = q >> 7, part = (q >> 6) & 1, p = q & 63;
            float v[2];
#pragma unroll
            for (int e = 0; e < 2; ++e) { const int kk = k + e, s = kk >> 4, jp = kk & 15, pw = dir == 0 ? 31 - s : s;
                const float er = AP[((dir * 33 + pw) * 64 + p) * 2], ei = AP[((dir * 33 + pw) * 64 + p) * 2 + 1];
                const float br = BB[((dir * 64 + p) * 16 + jp) * 2], bi = BB[((dir * 64 + p) * 16 + jp) * 2 + 1];
                v[e] = part == 0 ? (er * br - ei * bi) : (er * bi + ei * br); }
            *(unsigned*)(pt + (long)q * 512 + k) = cvt_pk_bf16(v[0], v[1]);
        }
        __syncthreads();
    }
}
DI void s5_fill(const Ctx& c, const float* KKG, bf16_t* Mt) {
    LAS float* KK = (LAS float*)c.lds;
    for (int item = c.bid; item < 256; item += c.G) {
        const int g = item >> 2, qt = item & 3;
        for (int i = c.tid; i < 4096; i += 512) *(LAS f32x4*)(KK + 4 * i) = *(const f32x4*)(KKG + (size_t)g * 16384 + 4 * i);
        __syncthreads();
        bf16_t* mt = Mt + (long)g * 512 * 768;
        for (int o = c.tid; o < 128 * 256; o += 512) {
            const int n = 128 * qt + (o >> 8), k = (o & 255) * 2, i = n >> 4, j = n & 15;
            float v[2];
#pragma unroll
            for (int e = 0; e < 2; ++e) { const int kk = k + e, s = kk >> 4, jp = kk & 15; float x = 0.f;
                if (s <= i) x += KK[((i - s) * 16 + j) * 16 + jp];
                if (s >= i) x += KK[8192 + ((s - i) * 16 + j) * 16 + jp];
                v[e] = x; }
            *(unsigned*)(mt + (long)n * 768 + k) = cvt_pk_bf16(v[0], v[1]);
        }
        __syncthreads();
    }
}
DI void s5_scan(const Ctx& c, const float* PC, const float* APL, bf16_t* UH) {
    for (int wt = c.gw; wt < NSEQ * 64 * 2; wt += c.ngw) {
        const int dir = wt & 1, g = (wt >> 1) & 63, s = wt >> 7;
        const int c0 = seq_base(s) >> 5, nch = seq_len(s) >> 5;
        const float ar = APL[((g * 2 + dir) * 64 + c.lane) * 2], ai = APL[((g * 2 + dir) * 64 + c.lane) * 2 + 1];
        float sr = 0.f, si = 0.f;
        const float* pc = PC + ((long)g * 2048) * 256 + dir * 128 + c.lane;
        bf16_t* uh = UH + ((long)g * 2048) * 768 + 512 + dir * 128 + c.lane;
        for (int cb = 0; cb < nch; cb += 16) {
            float pr[16], pi[16];
#pragma unroll
            for (int u = 0; u < 16; ++u) { const int ch = dir == 0 ? c0 + cb + u : c0 + nch - 1 - (cb + u); pr[u] = pc[(long)ch * 256]; pi[u] = pc[(long)ch * 256 + 64]; }
#pragma unroll
            for (int u = 0; u < 16; ++u) { const int ch = dir == 0 ? c0 + cb + u : c0 + nch - 1 - (cb + u);
                uh[(long)ch * 768] = (bf16_t)(cvt_pk_bf16(sr, 0.f) & 0xffffu); uh[(long)ch * 768 + 64] = (bf16_t)(cvt_pk_bf16(si, 0.f) & 0xffffu);
                const float nr = ar * sr - ai * si + pr[u], ni = ar * si + ai * sr + pi[u]; sr = nr; si = ni; }
        }
    }
}
constexpr size_t MB = 1024 * 1024;
constexpr size_t WS_CTL = 0;
constexpr int    MAX_LAUNCH = 72;
constexpr size_t CTL_BYTES = 1 * MB;
constexpr size_t WS_XB   = WS_CTL + CTL_BYTES;
constexpr size_t WS_R2   = WS_XB + 128 * MB;
constexpr size_t WS_R1   = WS_R2 + 256 * MB;
constexpr size_t WS_WMIX = WS_R1 + 288 * MB;
constexpr size_t WS_WXQ  = WS_WMIX + 8 * MB;
constexpr size_t WS_WXKV = WS_WXQ + 2 * MB;
constexpr size_t WS_WXO  = WS_WXKV + 4 * MB;
constexpr size_t WS_WGU  = WS_WXO + 2 * MB;
constexpr size_t WS_WD   = WS_WGU + 64 * MB;
constexpr size_t WS_MEMB = WS_WD + 32 * MB;
constexpr size_t WS_MEMKV= WS_MEMB + 6 * MB;
constexpr size_t WS_GT   = WS_MEMKV + 12 * MB;
constexpr size_t WS_HT   = WS_GT + 24 * MB;
constexpr size_t WS_AFFT = WS_HT + 24 * MB;
constexpr size_t WS_IDX  = WS_AFFT + 4 * MB;
constexpr size_t WS_GATE = WS_IDX + 1 * MB;
constexpr size_t WS_INV  = WS_GATE + 1 * MB;
constexpr size_t WS_S5MT = WS_INV + 4 * MB;
constexpr size_t WS_S5PT = WS_S5MT + 48 * MB;
constexpr size_t WS_S5AP = WS_S5PT + 16 * MB;
constexpr size_t WS_S5KK = WS_S5AP + 1 * MB;
constexpr size_t WS_X8   = WS_S5KK + 4 * MB;
constexpr size_t WS_END  = WS_X8 + 64 * MB;

constexpr int LDS_BYTES = 152 * 1024;
constexpr int LDS_MISC = 148 * 1024;

#define XB ((bf16_t*)(wsl + WS_XB))
#define OB ((bf16_t*)(wsl + WS_R2))
#define YE ((bf16_t*)(wsl + WS_R2))
#define PC ((float*)(wsl + WS_R2 + 128 * MB))
#define QKV ((bf16_t*)(wsl + WS_R1))
#define HB ((bf16_t*)(wsl + WS_R1))
#define UH ((bf16_t*)(wsl + WS_R1))
#define WMIX ((bf16_t*)(wsl + WS_WMIX))
#define WXQ ((bf16_t*)(wsl + WS_WXQ))
#define WXKV ((bf16_t*)(wsl + WS_WXKV))
#define WXO ((bf16_t*)(wsl + WS_WXO))
#define WGU ((bf16_t*)(wsl + WS_WGU))
#define WD ((bf16_t*)(wsl + WS_WD))
#define MEMB ((bf16_t*)(wsl + WS_MEMB))
#define MEMKV ((bf16_t*)(wsl + WS_MEMKV))
#define GT ((bf16_t*)(wsl + WS_GT))
#define HT ((bf16_t*)(wsl + WS_HT))
#define AFFT ((float*)(wsl + WS_AFFT))
#define IDX ((int*)(wsl + WS_IDX))
#define GATE ((float*)(wsl + WS_GATE))
#define INV ((int*)(wsl + WS_INV))
#define S5MT ((bf16_t*)(wsl + WS_S5MT))
#define S5PT ((bf16_t*)(wsl + WS_S5PT))
#define S5AP ((float*)(wsl + WS_S5AP))
#define S5KK ((float*)(wsl + WS_S5KK))
#define WMIX2 (WMIX + 2304 * 1024)
#define AQ8 ((unsigned char*)(wsl + WS_R2 + 128 * MB))
#define AK8 ((unsigned char*)(wsl + WS_R2 + 192 * MB))
#define AV8T ((unsigned char*)(wsl + WS_R2 + 208 * MB))
#define X8 ((bf16_t*)(wsl + WS_X8))
#define HSUB ((bf16_t*)(wsl + WS_R1))
DI const float* inp_ld(int k) { unsigned a = (unsigned)(148 * 1024 + 64 + 8 * k); asm volatile("" : "+v"(a));
    const LAS unsigned* t = (const LAS unsigned*)a; const unsigned lo = __builtin_amdgcn_readfirstlane(t[0]), hi = __builtin_amdgcn_readfirstlane(t[1]);
    return (const float*)(const __attribute__((address_space(1))) float*)(((unsigned long long)hi << 32) | lo); }
#define INP(k) inp_ld(k)
struct Params { const float* in[33]; float* out; unsigned char* ws; int ph_lo, ph_hi, li, pad; };

#define IN(k) (lo <= (k) && (k) < hi)
#define SEAM(k) do { if ((k) + 1 < hi) xcd_barrier(bar); } while (0)
#define RELANE() do { int t_ = threadIdx.x; asm volatile("" : "+v"(t_)); c.tid = t_; c.lane = t_ & 63; \
        int g_ = c.G, b_ = c.bid, w_ = c.wave; asm volatile("" : "+s"(g_), "+s"(b_), "+s"(w_)); c.G = g_; c.bid = b_; c.wave = w_; c.gw = b_ * 8 + w_; c.ngw = g_ * 8; } while (0)
template <int li>
DI void layer_body(Ctx& c, LAS unsigned char* lds, unsigned char* ws, float* XF, const XcdBarrier& bar, const int lo0, const int hi0) {
        const int pb = 1 + li * 16;
        int lo = lo0, hi = hi0; asm volatile("" : "+s"(lo), "+s"(hi));
        unsigned char* wsl; { unsigned long long w_ = (unsigned long long)ws; asm volatile("" : "+s"(w_)); wsl = (unsigned char*)(__attribute__((address_space(1))) unsigned char*)w_; }
        const float* lng = INP(5) + (size_t)li * 3 * DM; const float* lnb = INP(6) + (size_t)li * 3 * DM;
        if (IN(pb + 0)) { RELANE();
            TJob j0, j1;
            if (li == 0) { j0 = tjob(INP(7), 1024, 1536, 1536, WMIX, 1024, 0, 3); j1 = tjob(INP(10), 1024, 1024, 1024, WMIX2, 1024, 0, 2); }
            else if (li == 1) { j0 = tjob(INP(11), 1024, 2304, 2304, WMIX, 1024, 0, 3); j1 = tjob(INP(12), 768, 1024, 1024, WMIX2, 768, 0); }
            else if (li == 2) { j0 = tjob(INP(21), 1024, 1024, 2048, WMIX, 1024, 1); j1 = tjob(INP(21) + 1024, 1024, 1024, 2048, WMIX, 1024, 2); }
            else { j0 = tjob(INP(22), 1024, 2304, 2304, WMIX, 1024, 0, 1); j1 = tjob(INP(25), 768, 1024, 1024, WMIX2, 768, 0); }
            const TJob j2 = tjob(INP(27) + (size_t)li * 1024 * 2048, 1024, 2048, 2048, WXKV, 1024, 0), j3 = tjob(INP(28) + (size_t)li * 1024 * 1024, 1024, 1024, 1024, WXO, 1024, 0);
            convert_layer_weights(c, j0, j1, j2, j3, INP(30) + (size_t)li * 16 * 1024 * 1024, INP(31) + (size_t)li * 16 * 1024 * 1024, INP(32) + (size_t)li * 16 * 1024 * 1024, WGU, WD);
            cvt_copy_bf16(c, INP(26) + (size_t)li * 1024 * 1024, WXQ, 1024 * 1024);
            __syncthreads();
            if (li == 2) s5_tables(c, INP(13), INP(14), INP(15), INP(16), INP(17), INP(18), INP(19), S5MT, S5PT, S5AP, S5KK);
            SEAM(pb + 0);
        }
        if (IN(pb + 1)) { RELANE();
            pg8::Sched S = pg8::make_sched_(c.G, c.bid, MEMB, 2048, WXKV, 2048, 12, 8);
            pg8::EpiBf16 E{MEMKV, 0, 0, 2048, nullptr, 0, 0, 0, 1.0f};
            pg8::gemm_phase<pg8::EpiBf16, false>(lds, S, E, 1024, c.tid);
            if (li == 2) s5_fill(c, S5KK, S5MT);
            SEAM(pb + 1);
        }
        if (IN(pb + 2)) { RELANE();
            {
                pg8::Sched S = pg8::make_sched_(c.G, c.bid, MEMKV, 4096, WXQ, 2048, 1, 4);
                S.nb2 = 4; S.total = 12 * 4 * 4; S.aS1 = 256l * 4096; S.aS2 = 512; S.bS1 = 0; S.bS2 = 512;
                pg8::EpiF16 E{GT, 1024l * 1024, 256l * 1024, 1024, nullptr, 0, 0, 1 << 30, 0.0625f * LOG2E};
                pg8::gemm_phase<pg8::EpiF16, false>(lds, S, E, 256, c.tid);
            }
            RELANE();
            {
                pg8::Sched S = pg8::make_sched_(c.G, c.bid, WXO, 2048, MEMKV + 1024, 4096, 4, 1);
                S.nb2 = 4; S.total = 12 * 4 * 4; S.aS1 = 0; S.aS2 = 512; S.bS1 = 256l * 4096; S.bS2 = 512;
                pg8::EpiF8 E{(unsigned char*)HT, 1024l * 1024, 256, 1024, 1.0f / 16.0f};
                pg8::gemm_phase<pg8::EpiF8, false>(lds, S, E, 256, c.tid);
            }
            SEAM(pb + 2);
        }
        if (li == 0) {
            if (IN(pb + 3)) { RELANE(); pg8::Sched S = pg8::make_sched_(c.G, c.bid, X8, 1024, WMIX, 1024, 256, 6); pg8::EpiBf16 E{QKV, 0, 0, 1536, nullptr, 0, 0, 0, 1.0f};
                pg8::gemm_phase<pg8::EpiBf16, false, 2>(lds, S, E, 512, c.tid); SEAM(pb + 3); }
            if (IN(pb + 4)) { RELANE(); prep_a(c, QKV, INP(8), INP(9), AQ8, AK8, AV8T); SEAM(pb + 4); }
            if (IN(pb + 5)) { RELANE(); attn_a_phase(c, AQ8, AK8, AV8T, OB); SEAM(pb + 5); }
            if (IN(pb + 6)) { RELANE(); pg8::Sched S = pg8::make_sched_(c.G, c.bid, OB, 1024, WMIX2, 1024, 256, 4); pg8::EpiF8 E{(unsigned char*)HSUB, 0, 0, 1024, 64.0f};
                pg8::gemm_phase<pg8::EpiF8, false, 2>(lds, S, E, 512, c.tid); SEAM(pb + 6); }
        } else if (li == 1) {
            if (IN(pb + 3)) { RELANE(); pg8::Sched S = pg8::make_sched_(c.G, c.bid, X8, 1024, WMIX, 1024, 256, 9); pg8::EpiBf16 E{QKV, 0, 0, 2304, nullptr, 0, 0, 0, 1.0f};
                pg8::gemm_phase<pg8::EpiBf16, false, 2>(lds, S, E, 512, c.tid); SEAM(pb + 3); }
            if (IN(pb + 5)) { RELANE(); attn_b_phase(c, QKV, OB, INP(4)); SEAM(pb + 5); }
            if (IN(pb + 6)) { RELANE(); pg8::Sched S = pg8::make_sched_(c.G, c.bid, OB, 1536, WMIX2, 1536, 256, 4); pg8::EpiF8 E{(unsigned char*)HSUB, 0, 0, 1024, 1.0f / 64.0f};
                pg8::gemm_phase<pg8::EpiF8, false>(lds, S, E, 768, c.tid); SEAM(pb + 6); }
        } else if (li == 2) {
            if (IN(pb + 3)) { RELANE();
                pg8::Sched S = pg8::make_sched_(c.G, c.bid, UH, 1536, S5PT, 1024, 8, 1); S.total = 64 * 8; S.aS1 = 2048l * 1536; S.bS1 = 256l * 1024;
                pg8::EpiF32 E{PC, 2048l * 256, 256};
                pg8::gemm_phase<pg8::EpiF32, false>(lds, S, E, 512, c.tid); SEAM(pb + 3); }
            if (IN(pb + 4)) { RELANE(); s5_scan(c, PC, S5AP, UH); SEAM(pb + 4); }
            if (IN(pb + 5)) { RELANE();
                pg8::Sched S = pg8::make_sched_(c.G, c.bid, UH, 1536, S5MT, 1536, 8, 2); S.total = 64 * 16; S.aS1 = 2048l * 1536; S.bS1 = 512l * 1536;
                pg8::EpiS5Out E{OB, XB, INP(20)};
                pg8::gemm_phase<pg8::EpiS5Out, false>(lds, S, E, 768, c.tid); SEAM(pb + 5); }
            if (IN(pb + 6)) { RELANE(); pg8::Sched S = pg8::make_sched_(c.G, c.bid, OB, 2048, WMIX, 2048, 256, 8); pg8::EpiGluBf16 E{HSUB};
                pg8::gemm_phase<pg8::EpiGluBf16, false>(lds, S, E, 1024, c.tid); SEAM(pb + 6); }
        } else {
            if (IN(pb + 3)) { RELANE(); pg8::Sched S = pg8::make_sched_(c.G, c.bid, XB, 2048, WMIX, 2048, 256, 9); pg8::EpiBf16 E{QKV, 0, 0, 2304, nullptr, 0, 0, 768, 0.17677669529663687f * LOG2E};
                pg8::gemm_phase<pg8::EpiBf16, false, true>(lds, S, E, 1024, c.tid); SEAM(pb + 3); }
            if (IN(pb + 5)) { RELANE(); attn_d_phase(c, QKV, OB, INP(4), INP(23), INP(24), 0.8f - 0.6f * 0.4065696597405991f); SEAM(pb + 5); }
            if (IN(pb + 6)) { RELANE(); pg8::Sched S = pg8::make_sched_(c.G, c.bid, OB, 1536, WMIX2, 1536, 256, 4); pg8::EpiBf16 E{HSUB, 0, 0, 1024, nullptr, 0, 0, 0, 1.0f};
                pg8::gemm_phase<pg8::EpiBf16, false>(lds, S, E, 768, c.tid); SEAM(pb + 6); }
        }
        if (IN(pb + 8)) { RELANE(); ln_phase<(li < 2 ? (8 | 64) : 8)>(c, nullptr, XB, lng, lnb, nullptr, nullptr, nullptr, nullptr, nullptr, nullptr, HSUB); SEAM(pb + 8); }
        if (IN(pb + 9)) { RELANE();
            pg8::Sched S = pg8::make_sched_(c.G, c.bid, XB, 2048, GT, 2048, 256, 4); S.cross = 1; S.bS1 = 1024l * 2048;
            pg8::EpiSoftmax256F8 E{OB};
            pg8::gemm_phase<pg8::EpiSoftmax256F8, false, true>(lds, S, E, 1024, c.tid); SEAM(pb + 9);
        }
        if (IN(pb + 10)) { RELANE();
            pg8::Sched S = pg8::make_sched_(c.G, c.bid, OB, 1024, HT, 1024, 256, 4); S.cross = 1; S.bS1 = 1024l * 1024;
            pg8::EpiF8 E{(unsigned char*)HSUB, 0, 0, 1024, 64.0f};
            pg8::gemm_phase<pg8::EpiF8, false, 2>(lds, S, E, 512, c.tid); SEAM(pb + 10);
        }
        if (IN(pb + 11)) { RELANE();
            ln_phase<10 | 64>(c, nullptr, XB, lng + DM, lnb + DM, nullptr, nullptr, INP(29) + (size_t)li * 1024 * 16, AFFT, INV, X8, HSUB);
            SEAM(pb + 11); }
        if (IN(pb + 12)) { RELANE(); topk_phase(c, AFFT, IDX, GATE, INV); SEAM(pb + 12); }
        if (IN(pb + 13)) { RELANE();
            pg8::Sched S = pg8::make_sched_(c.G, c.bid, X8, 1024, WGU, 1024, 16, 8);
            S.nb2 = 16; S.total = 2 * 16 * 16 * 8; S.aS1 = (long)NGRP_TOK * 1024; S.aS2 = 0; S.bS1 = 0; S.bS2 = 2048l * 1024; S.GI = IDX; S.giS1 = 16 * CAP; S.giS2 = CAP; S.gather = 1;
#if MOE_DOWN_FP8
            pg8::EpiSwiGLU8 E{HB};
            pg8::gemm_phase<pg8::EpiSwiGLU8, true, 2>(lds, S, E, 512, c.tid); SEAM(pb + 13);
#else
            pg8::EpiSwiGLU E{HB};
            pg8::gemm_phase<pg8::EpiSwiGLU, true, 2>(lds, S, E, 512, c.tid); SEAM(pb + 13);
#endif
        }
        if (IN(pb + 14)) { RELANE();
#if MOE_DOWN_FP8
            pg8::Sched S = pg8::make_sched_(c.G, c.bid, HB, 1024, WD, 1024, 16, 4);
            S.nb2 = 16; S.total = 2 * 16 * 16 * 4; S.aS1 = 16l * CAP * 1024; S.aS2 = (long)CAP * 1024; S.bS1 = 0; S.bS2 = 1024l * 1024;
            pg8::EpiF8 E{(unsigned char*)YE, 16l * CAP * 1024, (long)CAP * 1024, 1024, 8.0f};
            pg8::gemm_phase<pg8::EpiF8, false, 2>(lds, S, E, 512, c.tid); SEAM(pb + 14);
#else
            pg8::Sched S = pg8::make_sched_(c.G, c.bid, HB, 2048, WD, 2048, 16, 4);
            S.nb2 = 16; S.total = 2 * 16 * 16 * 4; S.aS1 = 16l * CAP * 2048; S.aS2 = (long)CAP * 2048; S.bS1 = 0; S.bS2 = 1024l * 2048;
            pg8::EpiBf16 E{YE, 16l * CAP * 1024, (long)CAP * 1024, 1024, GATE, 16 * CAP, CAP, 0, 1.0f};
            pg8::gemm_phase<pg8::EpiBf16, false>(lds, S, E, 1024, c.tid); SEAM(pb + 14);
#endif
        }
        if (IN(pb + 15)) { RELANE();
            const float* gsc = MOE_DOWN_FP8 ? GATE : nullptr;
            if (li == 1) ln_phase<5>(c, nullptr, XB, lng + 2 * DM, lnb + 2 * DM, YE, INV, nullptr, nullptr, nullptr, UH, nullptr, gsc);
            else if (li == 3) ln_phase<17>(c, XF, XB, lng + 2 * DM, lnb + 2 * DM, YE, INV, nullptr, nullptr, nullptr, nullptr, nullptr, gsc);
            else if (li == 0) ln_phase<33>(c, nullptr, XB, lng + 2 * DM, lnb + 2 * DM, YE, INV, nullptr, nullptr, nullptr, X8, nullptr, gsc);
            else ln_phase<1>(c, nullptr, XB, lng + 2 * DM, lnb + 2 * DM, YE, INV, nullptr, nullptr, nullptr, nullptr, nullptr, gsc);
            SEAM(pb + 15);
        }
}

__global__ void __launch_bounds__(512, 2) fwd_kernel(Params P) {
    extern __shared__ __attribute__((aligned(16))) unsigned char lds_raw[];
    LAS unsigned char* lds = (LAS unsigned char*)lds_raw;
    Ctx c; c.lds = lds; c.tid = threadIdx.x; c.lane = c.tid & 63; c.wave = __builtin_amdgcn_readfirstlane(c.tid >> 6); c.G = gridDim.x; c.bid = blockIdx.x;
    c.gw = c.bid * 8 + c.wave; c.ngw = c.G * 8;
    volatile LAS unsigned* misc = (volatile LAS unsigned*)(lds + LDS_MISC);
    if (c.tid < 4) misc[c.tid] = 0u;
    if (c.tid < 33) ((LAS unsigned long long*)(lds + LDS_MISC + 64))[c.tid] = (unsigned long long)P.in[c.tid];
    __syncthreads();
    unsigned char* ws = P.ws;
    const int lo0 = P.ph_lo, hi0 = P.ph_hi;
    XcdBarrier bar; bar.bar = (unsigned*)(ws + WS_CTL) + (size_t)P.li * XCD_BAR_WORDS; bar.x = 0; bar.st = misc;
    if (hi0 - lo0 > 1) bar = xcd_barrier_post(bar.bar, misc);
    float* XF = P.out;
    { const int lo = lo0, hi = hi0;
    if (IN(0)) {
        unsigned char* wsl = ws;
        init_x(c, INP(0), INP(1), XB, X8);
        cvt_copy_bf16(c, INP(2), MEMB, (long)2048 * DM);
        cvt_copy_bf16(c, INP(3), MEMB + (long)2048 * DM, (long)1024 * DM);
        SEAM(0);
    } }
    layer_body<0>(c, lds, ws, XF, bar, lo0, hi0); layer_body<1>(c, lds, ws, XF, bar, lo0, hi0); layer_body<2>(c, lds, ws, XF, bar, lo0, hi0); layer_body<3>(c, lds, ws, XF, bar, lo0, hi0);
}

constexpr int N_PHASES = 65;
static bool phase_exists(int k) {
    if (k == 0) return true;
    const int li = (k - 1) / 16, r = (k - 1) % 16;
    if (r == 7) return false;
    if (r == 4) return li == 0 || li == 2;
    return true;
}

#ifndef MK_PER_PHASE
#define MK_PER_PHASE 0
#endif

extern "C" void kernel_launch(void* const* d_in, const int* in_sizes, int n_in, void* d_out, int out_size, void* d_ws, size_t ws_size, hipStream_t stream) {
    static int grid = 0;
    if (grid == 0) {
        if (n_in != 33 || out_size != NTOK * DM || ws_size < WS_END) { fprintf(stderr, "kernel_launch: unexpected shapes (n_in %d out %d ws %zu need %zu)\n", n_in, out_size, ws_size, (size_t)WS_END); grid = -1; return; }
        int dev = 0, cus = 0, per_cu = 0;
        if (hipGetDevice(&dev) != hipSuccess || hipDeviceGetAttribute(&cus, hipDeviceAttributeMultiprocessorCount, dev) != hipSuccess) { grid = -1; return; }
        if (hipFuncSetAttribute((const void*)fwd_kernel, hipFuncAttributeMaxDynamicSharedMemorySize, LDS_BYTES) != hipSuccess) { fprintf(stderr, "kernel_launch: hipFuncSetAttribute failed\n"); grid = -1; return; }
        if (hipOccupancyMaxActiveBlocksPerMultiprocessor(&per_cu, (const void*)fwd_kernel, 512, LDS_BYTES) != hipSuccess || per_cu < 1) { fprintf(stderr, "kernel_launch: occupancy query says %d\n", per_cu); (void)hipGetLastError(); }
        grid = cus;
    }
    if (grid < 0) return;
    (void)hipMemsetAsync((char*)d_ws + WS_CTL, 0, CTL_BYTES, stream);
    Params p{};
    for (int i = 0; i < 33; ++i) p.in[i] = (const float*)d_in[i];
    p.out = (float*)d_out; p.ws = (unsigned char*)d_ws; p.pad = 0;
#if MK_PER_PHASE
    int li = 0;
    for (int k = 0; k < N_PHASES; ++k) { if (!phase_exists(k)) continue; p.ph_lo = k; p.ph_hi = k + 1; p.li = li++;
        hipLaunchKernelGGL(fwd_kernel, dim3(grid), dim3(512), LDS_BYTES, stream, p); }
#else
    p.ph_lo = 0; p.ph_hi = N_PHASES; p.li = 0;
    hipLaunchKernelGGL(fwd_kernel, dim3(grid), dim3(512), LDS_BYTES, stream, p);
#if defined(PROBE_LO)
    p.ph_lo = PROBE_LO; p.ph_hi = PROBE_HI; p.li = 1; p.out = (float*)((unsigned char*)d_ws + WS_R2);
    hipLaunchKernelGGL(fwd_kernel, dim3(grid), dim3(512), LDS_BYTES, stream, p);
#endif
#endif
}
```

```cpp
#include <hip/hip_runtime.h>
#include <stdint.h>
#include <stdio.h>

#define LAS __attribute__((address_space(3)))
#define DI __device__ __forceinline__
typedef unsigned short bf16_t;
typedef short bf16x8 __attribute__((ext_vector_type(8)));
typedef short s16x4 __attribute__((ext_vector_type(4)));
typedef float f32x4 __attribute__((ext_vector_type(4)));
typedef float f32x2 __attribute__((ext_vector_type(2)));
typedef float f32x16 __attribute__((ext_vector_type(16)));
typedef unsigned u32x4 __attribute__((ext_vector_type(4)));
typedef unsigned u32x2 __attribute__((ext_vector_type(2)));

constexpr int DM = 1024;
constexpr int NTOK = 65536;
constexpr int NGRP_TOK = 32768;
constexpr int NSEQ = 12;
constexpr int MEMLEN = 256;
constexpr int NEXP = 16, CAP = 4096;
constexpr float ALPHA = 1.681792830507429f;
constexpr float LN_EPS = 1e-5f;
constexpr float LOG2E = 1.4426950408889634f;

typedef __bf16 bf16x2_t __attribute__((ext_vector_type(2)));
DI unsigned cvt_pk_bf16(float lo, float hi) { const f32x2 f = {lo, hi}; const bf16x2_t v = __builtin_convertvector(f, bf16x2_t); return __builtin_bit_cast(unsigned, v); }
DI float bf2f(unsigned b) { return __uint_as_float(b << 16); }
typedef _Float16 f16x2_t __attribute__((ext_vector_type(2)));
typedef _Float16 f16x8 __attribute__((ext_vector_type(8)));
DI unsigned cvt_pk_f16(float lo, float hi) { const f32x2 f = {lo, hi}; const f16x2_t v = __builtin_convertvector(f, f16x2_t); return __builtin_bit_cast(unsigned, v); }
typedef int i32x8 __attribute__((ext_vector_type(8)));
DI unsigned cvt_pk4_fp8(float a, float b, float c2, float d) { int p_ = __builtin_amdgcn_cvt_pk_fp8_f32(a, b, 0, false); p_ = __builtin_amdgcn_cvt_pk_fp8_f32(c2, d, p_, true); return (unsigned)p_; }
typedef short s16x2_ __attribute__((ext_vector_type(2)));
DI unsigned cvt_pk4_fp8_sc(unsigned old, float a, float b, float c2, float d, float sc) { s16x2_ r = __builtin_bit_cast(s16x2_, old); r = __builtin_amdgcn_cvt_scalef32_pk_fp8_f32(r, a, b, sc, false); r = __builtin_amdgcn_cvt_scalef32_pk_fp8_f32(r, c2, d, sc, true); return __builtin_bit_cast(unsigned, r); }
DI unsigned cvt_pk2_fp8(float a, float b) { return (unsigned)__builtin_amdgcn_cvt_pk_fp8_f32(a, b, 0, false) & 0xffffu; }
#ifndef MOE_DOWN_FP8
#define MOE_DOWN_FP8 1
#endif
constexpr float W8_SCALE = 64.0f;
DI f32x2 unpk_f16(unsigned w) { const f16x2_t h = __builtin_bit_cast(f16x2_t, w); return (f32x2){(float)h[0], (float)h[1]}; }
DI float wave_sum(float v) {
#pragma unroll
    for (int o = 32; o >= 1; o >>= 1) v += __shfl_xor(v, o);
    return v; }
DI float wave_max(float v) {
#pragma unroll
    for (int o = 32; o >= 1; o >>= 1) v = fmaxf(v, __shfl_xor(v, o));
    return v; }
DI float fast_exp2(float x) { return __builtin_amdgcn_exp2f(x); }
DI float fast_rcp(float x) { return __builtin_amdgcn_rcpf(x); }
DI float sigmoidf_(float x) { return fast_rcp(1.0f + fast_exp2(-x * LOG2E)); }
DI float gelu_tanh(float y) { const float u = 0.7978845608028654f * (y + 0.044715f * y * y * y); return y * sigmoidf_(2.0f * u); }
DI int seq_of_row(int n) { return n < NGRP_TOK ? (n >> 12) : 8 + ((n - NGRP_TOK) >> 13); }
DI int seq_len(int s) { return s < 8 ? 4096 : 8192; }
DI int seq_base(int s) { return s < 8 ? s * 4096 : NGRP_TOK + (s - 8) * 8192; }

#define XB_TMO      128
#define XB_XCNT(j)  (256  + 64 * (j))
#define XB_XSUB(j)  (1280 + 64 * (j))
#define XB_XGEN(j)  (2304 + 64 * (j))
#define XB_TOP      3328
#define XB_TOPGEN   3392
#define XCD_BAR_WORDS 3456
#define XB_SPIN_CAP (1u << 20)

DI unsigned xb_ld(unsigned* p)              { return __hip_atomic_load(p, __ATOMIC_RELAXED, __HIP_MEMORY_SCOPE_AGENT); }
DI unsigned xb_add(unsigned* p, unsigned v) { return __hip_atomic_fetch_add(p, v, __ATOMIC_RELAXED, __HIP_MEMORY_SCOPE_AGENT); }
DI unsigned xb_xcc_id() { return (unsigned)__builtin_amdgcn_s_getreg((3 << 11) | 20) & 0xFu; }
#define XB_SPIN(cond, bar) do { unsigned _sp = 0; while (cond) { __builtin_amdgcn_s_sleep(1); \
    if ((++_sp & 255u) == 0u) { if (xb_ld(&(bar)[XB_TMO])) break; if (_sp > XB_SPIN_CAP) { atomicAdd(&(bar)[XB_TMO], 1u); break; } } } } while (0)

struct XcdBarrier { unsigned* bar; unsigned x; volatile LAS unsigned* st; };

DI XcdBarrier xcd_barrier_post(unsigned* bar, volatile LAS unsigned* st) {
    XcdBarrier b; b.bar = bar; b.x = xb_xcc_id(); b.st = st;
    if (threadIdx.x == 0) (void)xb_add(&bar[XB_XCNT(b.x)], 1u);
    return b;
}
DI void xcd_barrier_complete(unsigned* bar, unsigned x, unsigned& nloc, unsigned& nx) {
    const unsigned G = gridDim.x * gridDim.y * gridDim.z;
    unsigned sum, cnt, mine, sp = 0u;
    for (;;) {
        sum = 0u; cnt = 0u; mine = 0u;
#pragma unroll
        for (unsigned j = 0; j < 16; ++j) { const unsigned c = xb_ld(&bar[XB_XCNT(j)]); sum += c; cnt += (c > 0u) ? 1u : 0u; mine = (j == x) ? c : mine; }
        if (sum == G) break;
        __builtin_amdgcn_s_sleep(1);
        if ((++sp & 255u) == 0u) { if (xb_ld(&bar[XB_TMO])) break; if (sp > XB_SPIN_CAP) { atomicAdd(&bar[XB_TMO], 1u); break; } }
    }
    nloc = mine > 0u ? mine : 1u; nx = cnt > 0u ? cnt : 1u;
}
DI void xcd_barrier(const XcdBarrier& b) {
    asm volatile("s_waitcnt vmcnt(0)" ::: "memory");
    __syncthreads();
    if (threadIdx.x == 0) {
        unsigned* bar = b.bar;
        __builtin_amdgcn_s_waitcnt(0);
        unsigned nloc = b.st[0], nx = b.st[1];
        if (nloc == 0u) { xcd_barrier_complete(bar, b.x, nloc, nx); b.st[0] = nloc; b.st[1] = nx; }
        const unsigned old = xb_add(&bar[XB_XSUB(b.x)], 1u);
        const unsigned gen = old / nloc;
        if (old + 1u == (gen + 1u) * nloc) {
            __builtin_amdgcn_fence(__ATOMIC_RELEASE, "agent");
            asm volatile("s_waitcnt vmcnt(0)" ::: "memory");
            const unsigned og = xb_add(&bar[XB_TOP], 1u);
            const unsigned tg = og / nx;
            if (og + 1u == (tg + 1u) * nx) xb_add(&bar[XB_TOPGEN], 1u);
            else XB_SPIN(xb_ld(&bar[XB_TOPGEN]) == tg, bar);
            __builtin_amdgcn_fence(__ATOMIC_ACQUIRE, "agent");
            xb_add(&bar[XB_XGEN(b.x)], 1u);
            asm volatile("s_waitcnt vmcnt(0)" ::: "memory");
        } else {
            XB_SPIN(xb_ld(&bar[XB_XGEN(b.x)]) == gen, bar);
            __builtin_amdgcn_fence(__ATOMIC_ACQUIRE, "agent");
            asm volatile("s_waitcnt vmcnt(0)" ::: "memory");
        }
    }
    __syncthreads();
}
namespace pg8 {
constexpr int BM = 256, BK = 64, HALF = 128, HTB = HALF * BK * 2, STAGE_BYTES = 8 * HTB;

DI int lds_byte(int r, int c) { const int st = (r >> 4) * 2 + (c >> 5), rr = r & 15, cc = c & 31, ob = rr * 64 + cc * 2; return st * 1024 + (ob ^ (((ob >> 9) & 1) << 5)); }
DI void stage_rc(int b, int& R, int& C) { const int st = b / 1024, sb = b % 1024, swz = sb ^ (((sb >> 9) & 1) << 5); R = (st >> 1) * 16 + swz / 64; C = (st & 1) * 32 + (swz % 64) / 2; }
DI int perm32(int rho) { const int n = rho >> 4, i = rho & 15; return 8 * (i >> 2) + 4 * n + (i & 3); }

struct Unit { const char* a; const char* b; const int* gi; int pm, pn, b1, b2; };

DI int cross_batch(int pm) { return pm < 128 ? (pm >> 4) : 8 + ((pm - 128) >> 5); }

struct Sched {
    const char* A; const char* B; const int* GI;
    long aS1, aS2, bS1, bS2; int giS1, giS2;
    unsigned lda, ldb;
    int nb2, nM, nN, total, G, c, cross, gather;
    DI bool next(int i, Unit& u) const {
        const long L = (long)i * G + c; if (L >= total) return false;
        int w = (int)L; { const int q = total / 8, r = total % 8, xcd = w % 8, off = w / 8; w = (xcd < r ? xcd * (q + 1) : r * (q + 1) + (xcd - r) * q) + off; }
        const int per = nM * nN, bz = w / per, l = w % per;
        const int nig = 8 * nN, gid = l / nig, fm = gid * 8, gsz = (nM - fm) < 8 ? (nM - fm) : 8;
        u.pm = fm + ((l % nig) % gsz); u.pn = (l % nig) / gsz;
        u.b1 = bz / nb2; u.b2 = bz % nb2;
        const int bb = cross ? cross_batch(u.pm) : u.b1;
        u.a = A + (long)u.b1 * aS1 + (long)u.b2 * aS2 + (gather ? 0l : (long)u.pm * 256 * lda);
        u.gi = GI + (long)u.b1 * giS1 + (long)u.b2 * giS2 + u.pm * 256;
        u.b = B + (long)bb * bS1 + (long)u.b2 * bS2 + (long)u.pn * 256 * ldb;
        return true;
    }
};
DI Sched make_sched_(int G, int bid, const void* A, unsigned lda, const void* B, unsigned ldb, int nM, int nN) {
    Sched s; s.A = (const char*)A; s.B = (const char*)B; s.GI = nullptr; s.aS1 = s.aS2 = s.bS1 = s.bS2 = 0; s.giS1 = s.giS2 = 0; s.lda = lda; s.ldb = ldb;
    s.nb2 = 1; s.nM = nM; s.nN = nN; s.total = nM * nN; s.G = G; s.c = bid; s.cross = 0; s.gather = 0; return s; }

typedef f32x4 Acc[2][2][4][2];

template <class Epi, bool GATHER, int OPM = 0  >
DI void gemm_phase(LAS unsigned char* lds, const Sched& S, const Epi& E, const int K, const int tid_in) {
    const int tid = tid_in, wid = __builtin_amdgcn_readfirstlane(tid >> 6), lane = tid & 63, wr = wid >> 2, wc = wid & 3, fr = lane & 15, fq = lane >> 4;
    const int nt = K / BK;
    const unsigned lda = S.lda, ldb = S.ldb;
    unsigned voffA[2], voffB[2];
#pragma unroll
    for (int i = 0; i < 2; ++i) { int R, C; stage_rc(tid * 16 + i * 8192, R, C); const int Rb = Epi::PERM ? ((R & ~31) + perm32(R & 31)) : R;
        voffA[i] = (unsigned)R * lda + (unsigned)C * 2u; voffB[i] = (unsigned)Rb * ldb + (unsigned)C * 2u; }
    const unsigned hstepA = 128u * lda, hstepB = 128u * ldb;
    const size_t kstep = (size_t)(BK * 2);
    const unsigned ldsw = (unsigned)wid * 1024u;
    const int aoff = lds_byte(wr * 64 + fr, fq * 8), boff = lds_byte(wc * 32 + fr, fq * 8);
#define PG8_SA(b, h) (((b) * 2 + (h)) * HTB)
#define PG8_SB(b, h) ((4 + (b) * 2 + (h)) * HTB)
#define PG8_GLDS(bufoff, gp, _i) __builtin_amdgcn_global_load_lds((const unsigned*)(gp), (LAS unsigned*)(lds + (bufoff) + ldsw + (_i) * 8192), 16, 0, 0)
#define PG8_STAGE_A(b, h, base, OFF) do { _Pragma("unroll") for (int _i = 0; _i < 2; ++_i) \
        PG8_GLDS(PG8_SA(b, h), (base) + (GATHER ? OFF[h][_i] : (voffA[_i] + (unsigned)(h) * hstepA)), _i); } while (0)
#define PG8_STAGE_B(b, h, base) do { _Pragma("unroll") for (int _i = 0; _i < 2; ++_i) \
        PG8_GLDS(PG8_SB(b, h), (base) + (voffB[_i] + (unsigned)(h) * hstepB), _i); } while (0)
#define PG8_LDA(dst, b, h) do { _Pragma("unroll") for (int m = 0; m < 4; ++m) _Pragma("unroll") for (int k = 0; k < 2; ++k) dst[m][k] = *(const LAS bf16x8*)(lds + PG8_SA(b, h) + aoff + m * 2048 + k * 1024); } while (0)
#define PG8_LDB(dst, b, h) do { _Pragma("unroll") for (int n = 0; n < 2; ++n) _Pragma("unroll") for (int k = 0; k < 2; ++k) dst[n][k] = *(const LAS bf16x8*)(lds + PG8_SB(b, h) + boff + n * 2048 + k * 1024); } while (0)
#define PG8_MMA(ai, bj, At, Bt) do { __builtin_amdgcn_s_setprio(1); \
        if (OPM == 2) { _Pragma("unroll") for (int m = 0; m < 4; ++m) _Pragma("unroll") for (int n = 0; n < 2; ++n) { \
            typedef short s16x16_ __attribute__((ext_vector_type(16))); \
            const i32x8 a8_ = __builtin_bit_cast(i32x8, (s16x16_)__builtin_shufflevector(At[m][0], At[m][1], 0, 1, 2, 3, 4, 5, 6, 7, 8, 9, 10, 11, 12, 13, 14, 15)); \
            const i32x8 b8_ = __builtin_bit_cast(i32x8, (s16x16_)__builtin_shufflevector(Bt[n][0], Bt[n][1], 0, 1, 2, 3, 4, 5, 6, 7, 8, 9, 10, 11, 12, 13, 14, 15)); \
            acc[ai][bj][m][n] = __builtin_amdgcn_mfma_scale_f32_16x16x128_f8f6f4(b8_, a8_, acc[ai][bj][m][n], 0, 0, 0, 127, 0, 127); } } \
        else { _Pragma("unroll") for (int m = 0; m < 4; ++m) _Pragma("unroll") for (int n = 0; n < 2; ++n) _Pragma("unroll") for (int k = 0; k < 2; ++k) \
        acc[ai][bj][m][n] = OPM == 1 ? __builtin_amdgcn_mfma_f32_16x16x32_f16(__builtin_bit_cast(f16x8, Bt[n][k]), __builtin_bit_cast(f16x8, At[m][k]), acc[ai][bj][m][n], 0, 0, 0) \
                                : __builtin_amdgcn_mfma_f32_16x16x32_bf16(Bt[n][k], At[m][k], acc[ai][bj][m][n], 0, 0, 0); } __builtin_amdgcn_s_setprio(0); } while (0)
#define PG8_GOFF(dst, gi_) do { int _t = tid; asm volatile("" : "+v"(_t)); _Pragma("unroll") for (int _i = 0; _i < 2; ++_i) { int _R, _C; stage_rc(_t * 16 + _i * 8192, _R, _C); \
        _Pragma("unroll") for (int _h = 0; _h < 2; ++_h) dst[_h][_i] = (unsigned)(gi_)[_h * 128 + _R] * lda + (unsigned)_C * 2u; } } while (0)
#define PG8_WAIT_V(n) asm volatile("s_waitcnt vmcnt(" #n ")" ::: "memory")
#define PG8_WAIT_L(n) asm volatile("s_waitcnt lgkmcnt(" #n ")" ::: "memory")
#define PG8_BAR __builtin_amdgcn_s_barrier()
#define PG8_SCHED __builtin_amdgcn_sched_barrier(0)
    Unit cur, nxt; int ui = 0;
    if (!S.next(0, cur)) return;
    Acc acc;
#pragma unroll
    for (int a = 0; a < 2; ++a)
#pragma unroll
        for (int b = 0; b < 2; ++b)
#pragma unroll
            for (int m = 0; m < 4; ++m)
#pragma unroll
                for (int n = 0; n < 2; ++n) acc[a][b][m][n] = (f32x4){0.f, 0.f, 0.f, 0.f};
    bf16x8 At[4][2], B0[2][2], B1[2][2];
    unsigned cO[2][2], nO[2][2];
#pragma unroll
    for (int h = 0; h < 2; ++h)
#pragma unroll
        for (int i = 0; i < 2; ++i) { cO[h][i] = 0u; nO[h][i] = 0u; }
    if (GATHER) { PG8_GOFF(cO, cur.gi); }
    const char* cA = cur.a; const char* cB = cur.b;
    PG8_STAGE_B(0, 0, cB); PG8_STAGE_A(0, 0, cA, cO); PG8_STAGE_B(0, 1, cB); PG8_STAGE_A(0, 1, cA, cO);
    if (wr == 1) PG8_BAR;
    PG8_WAIT_V(4); PG8_BAR;
    PG8_STAGE_B(1, 0, cB + kstep); PG8_STAGE_A(1, 0, cA + kstep, cO); PG8_STAGE_B(1, 1, cB + kstep);
    PG8_WAIT_V(6); PG8_BAR;
    for (;;) {
        const bool has_next = S.next(ui + 1, nxt);
        const char* nA = has_next ? nxt.a : cA; const char* nB = has_next ? nxt.b : cB;
        if (GATHER) {
            if (has_next) { PG8_GOFF(nO, nxt.gi); }
        }
        for (int t = 0; t < nt; t += 2) {
            const bool last = (t == nt - 2);
            const char* a1 = cA + (size_t)(t + 1) * kstep;
            const char* a2 = last ? nA : cA + (size_t)(t + 2) * kstep; const char* b2 = last ? nB : cB + (size_t)(t + 2) * kstep;
            const char* a3 = a2 + kstep; const char* b3 = b2 + kstep;
            PG8_LDB(B0, 0, 0); PG8_SCHED; PG8_LDA(At, 0, 0); PG8_STAGE_A(1, 1, a1, cO);
            if (GATHER) { if (last) {
#pragma unroll
                for (int h = 0; h < 2; ++h)
#pragma unroll
                    for (int i = 0; i < 2; ++i) cO[h][i] = nO[h][i]; } }
            PG8_WAIT_L(8); PG8_BAR; PG8_WAIT_L(0); PG8_MMA(0, 0, At, B0); PG8_BAR; PG8_SCHED;
            PG8_LDB(B1, 0, 1); PG8_STAGE_B(0, 0, b2);
            PG8_BAR; PG8_WAIT_L(0); PG8_MMA(0, 1, At, B1); PG8_BAR;
            PG8_LDA(At, 0, 1); PG8_STAGE_A(0, 0, a2, cO);
            PG8_BAR; PG8_WAIT_L(0); PG8_MMA(1, 0, At, B0); PG8_BAR; PG8_SCHED;
            PG8_STAGE_B(0, 1, b2);
            PG8_WAIT_V(6); PG8_BAR; PG8_MMA(1, 1, At, B1); PG8_BAR;
            PG8_LDB(B0, 1, 0); PG8_SCHED; PG8_LDA(At, 1, 0); PG8_STAGE_A(0, 1, a2, cO);
            PG8_WAIT_L(8); PG8_BAR; PG8_WAIT_L(0); PG8_MMA(0, 0, At, B0); PG8_BAR; PG8_SCHED;
            PG8_LDB(B1, 1, 1); PG8_STAGE_B(1, 0, b3);
            PG8_BAR; PG8_WAIT_L(0); PG8_MMA(0, 1, At, B1); PG8_BAR;
            PG8_LDA(At, 1, 1); PG8_STAGE_A(1, 0, a3, cO);
            PG8_BAR; PG8_WAIT_L(0); PG8_MMA(1, 0, At, B0); PG8_BAR; PG8_SCHED;
            PG8_STAGE_B(1, 1, b3);
            PG8_WAIT_V(6); PG8_BAR; PG8_MMA(1, 1, At, B1); PG8_BAR;
        }
        E(acc, cur, wr, wc, fr, fq, lds, ui);
        if (!has_next) break;
#pragma unroll
        for (int a = 0; a < 2; ++a)
#pragma unroll
            for (int b = 0; b < 2; ++b)
#pragma unroll
                for (int m = 0; m < 4; ++m)
#pragma unroll
                    for (int n = 0; n < 2; ++n) acc[a][b][m][n] = (f32x4){0.f, 0.f, 0.f, 0.f};
        cur = nxt; cA = nA; cB = nB; ++ui;
    }
    PG8_WAIT_V(0);
    if (wr == 0) PG8_BAR;
    PG8_BAR;
#undef PG8_SA
#undef PG8_SB
#undef PG8_GLDS
#undef PG8_STAGE_A
#undef PG8_STAGE_B
#undef PG8_LDA
#undef PG8_LDB
#undef PG8_MMA
#undef PG8_GOFF
#undef PG8_WAIT_V
#undef PG8_WAIT_L
#undef PG8_SCHED
}
#define PG8_BAR_ASM asm volatile("s_waitcnt lgkmcnt(0)\n\ts_barrier" ::: "memory")

template <bool F16OUT> struct EpiPk16 {
    static constexpr bool PERM = true;
    bf16_t* O; long oS1, oS2; int ldo; const float* rs; int rsS1, rsS2; int slim; float sval;
    DI void operator()(const Acc& acc, const Unit& u, int wr, int wc, int fr, int fq, LAS unsigned char*, int) const {
        __builtin_amdgcn_sched_barrier(0);
        bf16_t* base = O + u.b1 * oS1 + u.b2 * oS2 + (long)(u.pm * 256 + wr * 64 + fr) * ldo + u.pn * 256 + wc * 32 + 8 * fq;
        const float* rsp = rs ? rs + u.b1 * rsS1 + u.b2 * rsS2 + u.pm * 256 + wr * 64 + fr : nullptr;
#pragma unroll
        for (int ai = 0; ai < 2; ++ai)
#pragma unroll
            for (int m = 0; m < 4; ++m) {
                bf16_t* rowp = base + (long)(ai * HALF + m * 16) * ldo;
                const float rsc = rsp ? rsp[ai * HALF + m * 16] : 1.0f;
#pragma unroll
                for (int bj = 0; bj < 2; ++bj) {
                    const float sc = rsc * ((u.pn * 256 + bj * HALF + wc * 32) < slim ? sval : 1.0f);
                    const f32x4 v0 = acc[ai][bj][m][0] * sc, v1 = acc[ai][bj][m][1] * sc;
                    u32x4 w;
                    if (F16OUT) { w.x = cvt_pk_f16(v0[0], v0[1]); w.y = cvt_pk_f16(v0[2], v0[3]); w.z = cvt_pk_f16(v1[0], v1[1]); w.w = cvt_pk_f16(v1[2], v1[3]); }
                    else { w.x = cvt_pk_bf16(v0[0], v0[1]); w.y = cvt_pk_bf16(v0[2], v0[3]); w.z = cvt_pk_bf16(v1[0], v1[1]); w.w = cvt_pk_bf16(v1[2], v1[3]); }
                    *(u32x4*)(rowp + bj * HALF) = w; } }
    }
};
typedef EpiPk16<false> EpiBf16;
struct EpiF8 {
    static constexpr bool PERM = true;
    unsigned char* O; long oS1, oS2; int ldo; float sc;
    DI void operator()(const Acc& acc, const Unit& u, int wr, int wc, int fr, int fq, LAS unsigned char*, int) const {
        __builtin_amdgcn_sched_barrier(0);
        unsigned char* base = O + u.b1 * oS1 + u.b2 * oS2 + (long)(u.pm * 256 + wr * 64 + fr) * ldo + u.pn * 256 + wc * 32 + 8 * fq;
#pragma unroll
        for (int ai = 0; ai < 2; ++ai)
#pragma unroll
            for (int m = 0; m < 4; ++m) {
                unsigned char* rowp = base + (long)(ai * HALF + m * 16) * ldo;
#pragma unroll
                for (int bj = 0; bj < 2; ++bj) {
                    const f32x4 v0 = acc[ai][bj][m][0], v1 = acc[ai][bj][m][1];
                    u32x2 w; w.x = cvt_pk4_fp8_sc(0u, v0[0], v0[1], v0[2], v0[3], sc); w.y = cvt_pk4_fp8_sc(0u, v1[0], v1[1], v1[2], v1[3], sc);
                    *(u32x2*)(rowp + bj * HALF) = w; } }
    }
};
typedef EpiPk16<true> EpiF16;
struct EpiResid {
    static constexpr bool PERM = false;
    float* X;
    DI void operator()(const Acc& acc, const Unit& u, int wr, int wc, int fr, int fq, LAS unsigned char*, int) const {
        float* base = X + (long)(u.pm * 256 + wr * 64 + fr) * DM + u.pn * 256 + wc * 32 + 4 * fq;
#pragma unroll
        for (int ai = 0; ai < 2; ++ai)
#pragma unroll
            for (int m = 0; m < 4; ++m) { float* rowp = base + (long)(ai * HALF + m * 16) * DM;
#pragma unroll
                for (int bj = 0; bj < 2; ++bj)
#pragma unroll
                    for (int n = 0; n < 2; ++n) { f32x4* p = (f32x4*)(rowp + bj * HALF + n * 16); *p = *p * ALPHA + acc[ai][bj][m][n]; } }
    }
};
struct EpiGluResid {
    static constexpr bool PERM = false;
    float* X;
    DI void operator()(const Acc& acc, const Unit& u, int wr, int wc, int fr, int fq, LAS unsigned char*, int) const {
        float* base = X + (long)(u.pm * 256 + wr * 64 + fr) * DM + u.pn * 128 + wc * 32 + 4 * fq;
#pragma unroll
        for (int ai = 0; ai < 2; ++ai)
#pragma unroll
            for (int m = 0; m < 4; ++m) { float* rowp = base + (long)(ai * HALF + m * 16) * DM;
#pragma unroll
                for (int n = 0; n < 2; ++n) { f32x4* p = (f32x4*)(rowp + n * 16); const f32x4 a = acc[ai][0][m][n], g = acc[ai][1][m][n]; f32x4 x = *p;
#pragma unroll
                    for (int j = 0; j < 4; ++j) x[j] = x[j] * ALPHA + a[j] * sigmoidf_(g[j]);
                    *p = x; } }
    }
};
struct EpiGluBf16 {
    static constexpr bool PERM = true;
    bf16_t* H;
    DI void operator()(const Acc& acc, const Unit& u, int wr, int wc, int fr, int fq, LAS unsigned char*, int) const {
        bf16_t* base = H + (long)(u.pm * 256 + wr * 64 + fr) * DM + u.pn * 128 + wc * 32 + 8 * fq;
#pragma unroll
        for (int ai = 0; ai < 2; ++ai)
#pragma unroll
            for (int m = 0; m < 4; ++m) { bf16_t* rowp = base + (long)(ai * HALF + m * 16) * DM;
                float h[8];
#pragma unroll
                for (int n = 0; n < 2; ++n)
#pragma unroll
                    for (int j = 0; j < 4; ++j) h[n * 4 + j] = acc[ai][0][m][n][j] * sigmoidf_(acc[ai][1][m][n][j]);
                u32x4 w; w.x = cvt_pk_bf16(h[0], h[1]); w.y = cvt_pk_bf16(h[2], h[3]); w.z = cvt_pk_bf16(h[4], h[5]); w.w = cvt_pk_bf16(h[6], h[7]);
                *(u32x4*)rowp = w; }
    }
};
template <bool F8OUT> struct EpiSwiGLU_ {
    static constexpr bool PERM = true;
    bf16_t* H;
    DI void operator()(const Acc& acc, const Unit& u, int wr, int wc, int fr, int fq, LAS unsigned char*, int) const {
        const long row0 = (long)(u.b1 * 16 + u.b2) * CAP + u.pm * 256 + wr * 64 + fr; const int col0 = u.pn * 128 + wc * 32 + 8 * fq;
#pragma unroll
        for (int ai = 0; ai < 2; ++ai)
#pragma unroll
            for (int m = 0; m < 4; ++m) {
                float h[8];
#pragma unroll
                for (int n = 0; n < 2; ++n)
#pragma unroll
                    for (int j = 0; j < 4; ++j) { const float g = acc[ai][0][m][n][j] * (1.0f / W8_SCALE); h[n * 4 + j] = g * sigmoidf_(g) * (acc[ai][1][m][n][j] * (1.0f / W8_SCALE)); }
                const long r = row0 + ai * HALF + m * 16;
                if (F8OUT) { u32x2 w; w.x = cvt_pk4_fp8(h[0], h[1], h[2], h[3]); w.y = cvt_pk4_fp8(h[4], h[5], h[6], h[7]); *(u32x2*)((unsigned char*)H + r * DM + col0) = w; }
                else { u32x4 w; w.x = cvt_pk_bf16(h[0], h[1]); w.y = cvt_pk_bf16(h[2], h[3]); w.z = cvt_pk_bf16(h[4], h[5]); w.w = cvt_pk_bf16(h[6], h[7]); *(u32x4*)(H + r * DM + col0) = w; }
                __builtin_amdgcn_sched_barrier(0); }
    }
};
typedef EpiSwiGLU_<false> EpiSwiGLU;
typedef EpiSwiGLU_<true> EpiSwiGLU8;
struct EpiF32 {
    static constexpr bool PERM = false;
    float* C; long oS1; int ldo;
    DI void operator()(const Acc& acc, const Unit& u, int wr, int wc, int fr, int fq, LAS unsigned char*, int) const {
        float* base = C + u.b1 * oS1 + (long)(u.pm * 256 + wr * 64 + fr) * ldo + u.pn * 256 + wc * 32 + 4 * fq;
#pragma unroll
        for (int ai = 0; ai < 2; ++ai)
#pragma unroll
            for (int m = 0; m < 4; ++m) { float* rowp = base + (long)(ai * HALF + m * 16) * ldo;
#pragma unroll
                for (int bj = 0; bj < 2; ++bj)
#pragma unroll
                    for (int n = 0; n < 2; ++n) *(f32x4*)(rowp + bj * HALF + n * 16) = acc[ai][bj][m][n]; }
    }
};
template <bool F8> struct EpiSoftmax256_ {
    static constexpr bool PERM = true;
    bf16_t* Pm;
    DI void operator()(const Acc& acc, const Unit& u, int wr, int wc, int fr, int fq, LAS unsigned char* lds, int ui) const {
        LAS f32x2* T = (LAS f32x2*)(lds + STAGE_BYTES + (ui & 1) * 8192);
        float mloc[2][4];
#pragma unroll
        for (int ai = 0; ai < 2; ++ai)
#pragma unroll
            for (int m = 0; m < 4; ++m) {
                float mx = -3.0e38f;
#pragma unroll
                for (int bj = 0; bj < 2; ++bj)
#pragma unroll
                    for (int n = 0; n < 2; ++n) { const f32x4 x = acc[ai][bj][m][n]; mx = fmaxf(fmaxf(mx, fmaxf(x[0], x[1])), fmaxf(x[2], x[3])); }
                mx = fmaxf(mx, __shfl_xor(mx, 16)); mx = fmaxf(mx, __shfl_xor(mx, 32));
                float s = 0.f;
#pragma unroll
                for (int bj = 0; bj < 2; ++bj)
#pragma unroll
                    for (int n = 0; n < 2; ++n) { const f32x4 x = acc[ai][bj][m][n]; s += (fast_exp2(x[0] - mx) + fast_exp2(x[1] - mx)) + (fast_exp2(x[2] - mx) + fast_exp2(x[3] - mx)); }
                s += __shfl_xor(s, 16); s += __shfl_xor(s, 32);
                mloc[ai][m] = mx;
                if (fq == 0) T[(ai * HALF + wr * 64 + m * 16 + fr) * 4 + wc] = (f32x2){mx, s};
            }
        PG8_BAR_ASM;
        bf16_t* base = Pm + (long)(u.pm * 256 + wr * 64 + fr) * DM + u.pn * 256 + wc * 32 + 8 * fq;
#pragma unroll
        for (int ai = 0; ai < 2; ++ai)
#pragma unroll
            for (int m = 0; m < 4; ++m) {
                const int row = ai * HALF + wr * 64 + m * 16 + fr;
                const f32x2 t0 = T[row * 4 + 0], t1 = T[row * 4 + 1], t2 = T[row * 4 + 2], t3 = T[row * 4 + 3];
                const float M = fmaxf(fmaxf(t0.x, t1.x), fmaxf(t2.x, t3.x));
                const float Lsum = t0.y * fast_exp2(t0.x - M) + t1.y * fast_exp2(t1.x - M) + t2.y * fast_exp2(t2.x - M) + t3.y * fast_exp2(t3.x - M);
                const float inv = fast_rcp(Lsum) * (F8 ? 256.0f : 1.0f);
                bf16_t* rowp = base + (long)(ai * HALF + m * 16) * DM;
                unsigned char* rowp8 = (unsigned char*)Pm + (long)(u.pm * 256 + row) * DM + u.pn * 256 + wc * 32 + 8 * fq;
#pragma unroll
                for (int bj = 0; bj < 2; ++bj) { const f32x4 x0 = acc[ai][bj][m][0], x1 = acc[ai][bj][m][1]; float p[8];
#pragma unroll
                    for (int j = 0; j < 4; ++j) { p[j] = fast_exp2(x0[j] - M) * inv; p[4 + j] = fast_exp2(x1[j] - M) * inv; }
                    if (F8) { u32x2 w8; w8.x = cvt_pk4_fp8(p[0], p[1], p[2], p[3]); w8.y = cvt_pk4_fp8(p[4], p[5], p[6], p[7]); *(u32x2*)(rowp8 + bj * HALF) = w8; }
                    else { u32x4 w; w.x = cvt_pk_bf16(p[0], p[1]); w.y = cvt_pk_bf16(p[2], p[3]); w.z = cvt_pk_bf16(p[4], p[5]); w.w = cvt_pk_bf16(p[6], p[7]);
                        *(u32x4*)(rowp + bj * HALF) = w; } } }
        (void)mloc;
    }
};
typedef EpiSoftmax256_<false> EpiSoftmax256;
typedef EpiSoftmax256_<true> EpiSoftmax256F8;
struct EpiS5Out {
    static constexpr bool PERM = true;
    bf16_t* Z; const bf16_t* X16; const float* dskip;
    DI void operator()(const Acc& acc, const Unit& u, int wr, int wc, int fr, int fq, LAS unsigned char*, int) const {
        const int g = u.b1;
#pragma unroll
        for (int ai = 0; ai < 2; ++ai)
#pragma unroll
            for (int m = 0; m < 4; ++m) {
                const int chunk = u.pm * 256 + ai * HALF + wr * 64 + m * 16 + fr;
#pragma unroll
                for (int bj = 0; bj < 2; ++bj) {
                    const int col = u.pn * 256 + bj * HALF + wc * 32 + 8 * fq, i = col >> 4, j = col & 15;
                    const long off = (long)(chunk * 32 + i) * DM + g * 16 + j;
                    const u32x4 xw = *(const u32x4*)(X16 + off); const f32x2 x01 = unpk_f16(xw.x), x23 = unpk_f16(xw.y), x45 = unpk_f16(xw.z), x67 = unpk_f16(xw.w);
                    const f32x4 xa = {x01.x, x01.y, x23.x, x23.y}, xb = {x45.x, x45.y, x67.x, x67.y};
                    const f32x4 da = *(const f32x4*)(dskip + g * 16 + j), db = *(const f32x4*)(dskip + g * 16 + j + 4);
                    float y[8];
#pragma unroll
                    for (int q = 0; q < 4; ++q) { y[q] = gelu_tanh(acc[ai][bj][m][0][q] + da[q] * xa[q]); y[4 + q] = gelu_tanh(acc[ai][bj][m][1][q] + db[q] * xb[q]); }
                    u32x4 w; w.x = cvt_pk_bf16(y[0], y[1]); w.y = cvt_pk_bf16(y[2], y[3]); w.z = cvt_pk_bf16(y[4], y[5]); w.w = cvt_pk_bf16(y[6], y[7]);
                    *(u32x4*)(Z + off) = w; } }
    }
};
}
struct Ctx { LAS unsigned char* lds; int tid, lane, wave, G, bid, gw, ngw; };

DI void cvt_copy_bf16(const Ctx& c, const float* src, bf16_t* dst, long n) {
    for (long i = ((long)c.bid * 512 + c.tid) * 4; i < n; i += (long)c.G * 512 * 4) {
        const f32x4 v = *(const f32x4*)(src + i); u32x2 w; w.x = cvt_pk_bf16(v[0], v[1]); w.y = cvt_pk_bf16(v[2], v[3]); *(u32x2*)(dst + i) = w; }
}
DI void init_x(const Ctx& c, const float* xp, const float* xs, bf16_t* X16, bf16_t* X8_) {
    const long half = (long)NGRP_TOK * DM;
    for (long i = ((long)c.bid * 512 + c.tid) * 4; i < 2 * half; i += (long)c.G * 512 * 4) {
        const f32x4 v = i < half ? *(const f32x4*)(xp + i) : *(const f32x4*)(xs + (i - half));
        u32x2 w; w.x = cvt_pk_f16(v[0], v[1]); w.y = cvt_pk_f16(v[2], v[3]); *(u32x2*)(X16 + i) = w;
        *(unsigned*)((unsigned char*)X8_ + i) = cvt_pk4_fp8(v[0], v[1], v[2], v[3]); }
}
DI long il_row(int n, int which) { return (long)(n >> 7) * 256 + which * 128 + (n & 127); }
struct TJob { const float* W; bf16_t* Wt; int tn  , ldw, ldt, mode, nit, f16; };
DI TJob tjob(const float* W, int K, int N, int ldw, bf16_t* Wt, int ldt, int mode, int f16 = 0) { TJob j; j.W = W; j.Wt = Wt; j.tn = N / 256; j.ldw = ldw; j.ldt = ldt; j.mode = mode; j.nit = (K / 64) * (N / 256); j.f16 = f16; return j; }
#define CONV_DECODE(it_, W_, Wt_, ldw_, ldt_, mode_, k0_, n0_, f16_) do { int tn_, r_; \
    if ((it_) < n3) { const bool b0 = (it_) < n0, b1 = (it_) < n1, b2 = (it_) < n2; \
        W_ = b0 ? j0.W : (b1 ? j1.W : (b2 ? j2.W : j3.W)); Wt_ = b0 ? j0.Wt : (b1 ? j1.Wt : (b2 ? j2.Wt : j3.Wt)); \
        tn_ = b0 ? j0.tn : (b1 ? j1.tn : (b2 ? j2.tn : j3.tn)); ldw_ = b0 ? j0.ldw : (b1 ? j1.ldw : (b2 ? j2.ldw : j3.ldw)); \
        ldt_ = b0 ? j0.ldt : (b1 ? j1.ldt : (b2 ? j2.ldt : j3.ldt)); mode_ = b0 ? j0.mode : (b1 ? j1.mode : (b2 ? j2.mode : j3.mode)); \
        r_ = (it_) - (b0 ? 0 : (b1 ? n0 : (b2 ? n1 : n2))); f16_ = b0 ? j0.f16 : (b1 ? j1.f16 : (b2 ? j2.f16 : j3.f16)); \
    } else { const int q_ = (it_) - n3, e_ = q_ / 192, m_ = (q_ % 192) >> 6; r_ = q_ & 63; \
        W_ = (m_ == 0 ? wg : (m_ == 1 ? wu : wd)) + (size_t)e_ * 1024 * 1024; \
        Wt_ = m_ == 2 ? (MOE_DOWN_FP8 ? (bf16_t*)((unsigned char*)WD + (size_t)e_ * 1024 * 1024) : WD + (size_t)e_ * 1024 * 1024) : (bf16_t*)((unsigned char*)WGU + (size_t)e_ * 2048 * 1024); \
        tn_ = 4; ldw_ = 1024; ldt_ = 1024; mode_ = m_ == 2 ? 0 : m_ + 1; f16_ = (m_ == 2 && !MOE_DOWN_FP8) ? 0 : 2; }        \
    k0_ = (r_ / tn_) * 64; n0_ = (r_ % tn_) * 256; } while (0)
DI void convert_layer_weights(const Ctx& c, const TJob& j0, const TJob& j1, const TJob& j2, const TJob& j3, const float* wg, const float* wu, const float* wd, bf16_t* WGU, bf16_t* WD) {
    const int n0 = j0.nit, n1 = n0 + j1.nit, n2 = n1 + j2.nit, n3 = n2 + j3.nit, total = n3 + 16 * 3 * 64;
    LAS float* scr = (LAS float*)c.lds;
    int it = c.bid;
    if (it >= total) return;
    const float* cW; bf16_t* cWt; int cldw, cldt, cmode, ck0, cn0, cf16;
    CONV_DECODE(it, cW, cWt, cldw, cldt, cmode, ck0, cn0, cf16);
    f32x4 a[8];
    { const float* src = cW + (long)(ck0 + c.wave * 8) * cldw + cn0 + c.lane * 4;
#pragma unroll
      for (int i = 0; i < 8; ++i) a[i] = *(const f32x4*)(src + (long)i * cldw); }
    for (;;) {
#pragma unroll
        for (int i = 0; i < 8; ++i) { const int k = c.wave * 8 + i;
#pragma unroll
            for (int q = 0; q < 4; ++q) scr[k * 257 + c.lane * 4 + q] = a[i][q]; }
        __syncthreads();
        const int itn = it + c.G; const bool more = itn < total;
        const float* nW = cW; bf16_t* nWt = cWt; int nldw = cldw, nldt = cldt, nmode = cmode, nk0 = ck0, nn0 = cn0, nf16 = cf16;
        if (more) { CONV_DECODE(itn, nW, nWt, nldw, nldt, nmode, nk0, nn0, nf16);
            const float* src = nW + (long)(nk0 + c.wave * 8) * nldw + nn0 + c.lane * 4;
#pragma unroll
            for (int i = 0; i < 8; ++i) a[i] = *(const f32x4*)(src + (long)i * nldw); }
        const int sub = c.lane >> 5, kk = (c.lane & 31) * 2;
#pragma unroll 4
        for (int j = 0; j < 16; ++j) { const int n = c.wave * 32 + 2 * j + sub;
            const float v0 = scr[kk * 257 + n], v1 = scr[(kk + 1) * 257 + n];
            const long orow = cmode == 0 ? (long)(cn0 + n) : il_row(cn0 + n, cmode - 1);
            if (cf16 >= 2) { const float ws_ = cf16 == 2 ? W8_SCALE : 1.0f; *(unsigned short*)((unsigned char*)cWt + orow * cldt + ck0 + kk) = (unsigned short)cvt_pk2_fp8(v0 * ws_, v1 * ws_); continue; }
            *(unsigned*)(cWt + orow * cldt + ck0 + kk) = cf16 ? cvt_pk_f16(v0, v1) : cvt_pk_bf16(v0, v1); }
        __syncthreads();
        if (!more) break;
        it = itn; cW = nW; cWt = nWt; cldw = nldw; cldt = nldt; cmode = nmode; ck0 = nk0; cn0 = nn0; cf16 = nf16;
    }
}
#undef CONV_DECODE

template <int MODE>
DI void ln_phase(const Ctx& c, float* OUTF, bf16_t* X16, const float* g, const float* b,
                 const bf16_t* YE, const int* INV_in, const float* wr_lds_src  , float* AFFT, int* INV_out, bf16_t* UH, const bf16_t* HB_in = nullptr, const float* GATE_in = nullptr) {
    LAS float* wT = (LAS float*)c.lds;
    if (MODE & 2) {
        for (int i = c.tid; i < 16 * 1024; i += 512) { const int cc = i >> 4, e = i & 15; wT[e * 1024 + cc] = wr_lds_src[i]; }
        __syncthreads();
    }
    f32x4 gv[4], bv[4];
#pragma unroll
    for (int j = 0; j < 4; ++j) { gv[j] = *(const f32x4*)(g + j * 256 + c.lane * 4); bv[j] = *(const f32x4*)(b + j * 256 + c.lane * 4); }
    f32x4 vprev[4]; int rowprev = 0, itn = 0;
#pragma unroll
    for (int j = 0; j < 4; ++j) vprev[j] = (f32x4){0.f, 0.f, 0.f, 0.f};
    for (int row = c.gw; row < NTOK; row += c.ngw, ++itn) {
        bf16_t* xr = X16 + (long)row * DM + c.lane * 4;
        f32x4 v[4];
#pragma unroll
        for (int j = 0; j < 4; ++j) { const u32x2 w = *(const u32x2*)(xr + j * 256); const f32x2 a = unpk_f16(w.x), bq = unpk_f16(w.y); v[j] = (f32x4){a.x, a.y, bq.x, bq.y}; }
        if ((MODE & 8) && (MODE & 64)) {
            const unsigned char* hr = (const unsigned char*)HB_in + (long)row * DM + c.lane * 4;
#pragma unroll
            for (int j = 0; j < 4; ++j) { const unsigned w = *(const unsigned*)(hr + j * 256);
                const f32x2 lo = __builtin_amdgcn_cvt_pk_f32_fp8((int)w, false), hi2 = __builtin_amdgcn_cvt_pk_f32_fp8((int)w, true);
                v[j][0] = v[j][0] * ALPHA + lo[0] * (1.0f / 64.0f); v[j][1] = v[j][1] * ALPHA + lo[1] * (1.0f / 64.0f); v[j][2] = v[j][2] * ALPHA + hi2[0] * (1.0f / 64.0f); v[j][3] = v[j][3] * ALPHA + hi2[1] * (1.0f / 64.0f); }
        } else if (MODE & 8) {
            const bf16_t* hr = HB_in + (long)row * DM + c.lane * 4;
#pragma unroll
            for (int j = 0; j < 4; ++j) { const u32x2 w = *(const u32x2*)(hr + j * 256);
                v[j][0] = v[j][0] * ALPHA + bf2f(w.x & 0xffffu); v[j][1] = v[j][1] * ALPHA + bf2f(w.x >> 16); v[j][2] = v[j][2] * ALPHA + bf2f(w.y & 0xffffu); v[j][3] = v[j][3] * ALPHA + bf2f(w.y >> 16); }
        }
        if (MODE & 1) {
#pragma unroll
            for (int j = 0; j < 4; ++j) v[j] = v[j] * ALPHA;
            const int grp = row >> 15;
            const int myp = c.lane < 16 ? INV_in[(long)row * 16 + c.lane] : -1;
            unsigned long long msk = __ballot(myp >= 0);
            while (msk) {
                int pos[4]; bool ok[4]; float gt[4];
#pragma unroll
                for (int q = 0; q < 4; ++q) { ok[q] = msk != 0ull; const int e = ok[q] ? __builtin_ctzll(msk) : 0; msk &= msk - 1ull; const int pz = __builtin_amdgcn_readlane(myp, e); pos[q] = ok[q] ? ((grp * 16 + e) * CAP + pz) : 0;
                    gt[q] = GATE_in ? GATE_in[pos[q]] * 0.125f : 1.0f; }
                unsigned w[4][4];
#pragma unroll
                for (int q = 0; q < 4; ++q) if (ok[q]) { const unsigned char* yr = (const unsigned char*)YE + (long)pos[q] * DM + c.lane * 4;
#pragma unroll
                    for (int j = 0; j < 4; ++j) w[q][j] = *(const unsigned*)(yr + j * 256); }
#pragma unroll
                for (int q = 0; q < 4; ++q) if (ok[q]) {
#pragma unroll
                    for (int j = 0; j < 4; ++j) { const f32x2 lo = __builtin_amdgcn_cvt_pk_f32_fp8((int)w[q][j], false), hi2 = __builtin_amdgcn_cvt_pk_f32_fp8((int)w[q][j], true);
                        v[j][0] += gt[q] * lo[0]; v[j][1] += gt[q] * lo[1]; v[j][2] += gt[q] * hi2[0]; v[j][3] += gt[q] * hi2[1]; } }
            }
        }
        float s = 0.f;
#pragma unroll
        for (int j = 0; j < 4; ++j) s += (v[j][0] + v[j][1]) + (v[j][2] + v[j][3]);
        const float mean = wave_sum(s) * (1.0f / DM);
        float q = 0.f;
#pragma unroll
        for (int j = 0; j < 4; ++j) { const f32x4 d = v[j] - mean; q += (d[0] * d[0] + d[1] * d[1]) + (d[2] * d[2] + d[3] * d[3]); }
        const float rstd = rsqrtf(wave_sum(q) * (1.0f / DM) + LN_EPS);
#pragma unroll
        for (int j = 0; j < 4; ++j) { v[j] = (v[j] - mean) * rstd * gv[j] + bv[j]; if (MODE & 16) *(f32x4*)(OUTF + (long)row * DM + c.lane * 4 + j * 256) = v[j]; }
#pragma unroll
        for (int j = 0; j < 4; ++j) { u32x2 w; w.x = cvt_pk_f16(v[j][0], v[j][1]); w.y = cvt_pk_f16(v[j][2], v[j][3]); if (!(MODE & 16)) *(u32x2*)(xr + j * 256) = w;
            if (MODE & (2 | 32)) *(unsigned*)((unsigned char*)UH + (long)row * DM + c.lane * 4 + j * 256) = cvt_pk4_fp8(v[j][0], v[j][1], v[j][2], v[j][3]);
            if (MODE & 4) { const int gi = j * 16 + (c.lane >> 2);
                u32x2 wb; wb.x = cvt_pk_bf16(v[j][0], v[j][1]); wb.y = cvt_pk_bf16(v[j][2], v[j][3]);
                *(u32x2*)(UH + ((long)gi * 2048 + (row >> 5)) * 768 + (row & 31) * 16 + (c.lane & 3) * 4) = wb; } }
        if ((MODE & 2) && !(itn & 1)) {
#pragma unroll
            for (int j = 0; j < 4; ++j) vprev[j] = v[j];
            rowprev = row;
        }
        if ((MODE & 2) && (itn & 1)) {
            float pe2[2][16];
            f32x2 xy[4][4];
#pragma unroll
            for (int j = 0; j < 4; ++j)
#pragma unroll
                for (int k = 0; k < 4; ++k) xy[j][k] = (f32x2){vprev[j][k], v[j][k]};
#pragma unroll
            for (int e = 0; e < 16; ++e) { f32x2 a = {0.f, 0.f};
#pragma unroll
                for (int j = 0; j < 4; ++j) { const f32x4 w = *(const LAS f32x4*)(wT + e * 1024 + j * 256 + c.lane * 4);
#pragma unroll
                    for (int k = 0; k < 4; ++k) a = xy[j][k] * (f32x2){w[k], w[k]} + a; }
                pe2[0][e] = a.x; pe2[1][e] = a.y; if (e & 1) __builtin_amdgcn_sched_barrier(0); }
#pragma unroll
            for (int hh = 0; hh < 2; ++hh) { const int rrow = hh == 0 ? rowprev : row;
            float pe[16];
#pragma unroll
            for (int e = 0; e < 16; ++e) pe[e] = pe2[hh][e];
            float q8[8], q4[4], q2[2], q1;
            { const bool up = (c.lane & 32) != 0;
#pragma unroll
              for (int k = 0; k < 8; ++k) { const float keep = up ? pe[k + 8] : pe[k], give = up ? pe[k] : pe[k + 8]; q8[k] = keep + __shfl_xor(give, 32); } }
            { const bool up = (c.lane & 16) != 0;
#pragma unroll
              for (int k = 0; k < 4; ++k) { const float keep = up ? q8[k + 4] : q8[k], give = up ? q8[k] : q8[k + 4]; q4[k] = keep + __shfl_xor(give, 16); } }
            { const bool up = (c.lane & 8) != 0;
#pragma unroll
              for (int k = 0; k < 2; ++k) { const float keep = up ? q4[k + 2] : q4[k], give = up ? q4[k] : q4[k + 2]; q2[k] = keep + __shfl_xor(give, 8); } }
            { const bool up = (c.lane & 4) != 0; const float keep = up ? q2[1] : q2[0], give = up ? q2[0] : q2[1]; q1 = keep + __shfl_xor(give, 4); }
            q1 += __shfl_xor(q1, 2); q1 += __shfl_xor(q1, 1);
            float mx = q1;
#pragma unroll
            for (int o = 32; o >= 4; o >>= 1) mx = fmaxf(mx, __shfl_xor(mx, o));
            const float ex = __expf(q1 - mx);
            float den = ex;
#pragma unroll
            for (int o = 32; o >= 4; o >>= 1) den += __shfl_xor(den, o);
            if ((c.lane & 3) == 0) { const int e = c.lane >> 2;
                AFFT[((long)(rrow >> 15) * 16 + e) * NGRP_TOK + (rrow & (NGRP_TOK - 1))] = ex / den; INV_out[(long)rrow * 16 + e] = -1; }
            }
        }
    }
    if (MODE & 2) __syncthreads();
}

DI void topk_phase(const Ctx& c, const float* AFFT, int* IDX, float* GATE, int* INV) {
    LAS unsigned* hist = (LAS unsigned*)c.lds;
    LAS unsigned* sel = hist + 8192;
    LAS unsigned* wsum = hist + 8196;
    for (int prob = c.bid; prob < 2 * NEXP; prob += c.G) {
        const unsigned* a = (const unsigned*)(AFFT + (long)prob * NGRP_TOK + c.tid * 64);
        unsigned prefix = 0u, mask = 0u; unsigned krem = CAP;
#pragma unroll 1
        for (int pass = 0; pass < 4; ++pass) {
            const int shift = 24 - 8 * pass;
            for (int i = c.tid; i < 8192; i += 512) hist[i] = 0u;
            __syncthreads();
#pragma unroll 2
            for (int i = 0; i < 16; ++i) { const u32x4 v = *(const u32x4*)(a + i * 4);
#pragma unroll
                for (int q = 0; q < 4; ++q) if ((v[q] & mask) == prefix) __hip_atomic_fetch_add(&hist[(((v[q] >> shift) & 255u) << 5) | (c.lane & 31)], 1u, __ATOMIC_RELAXED, __HIP_MEMORY_SCOPE_WORKGROUP); }
            __syncthreads();
            if (c.tid < 256) { unsigned t_ = 0u;
#pragma unroll 8
                for (int r = 0; r < 32; ++r) t_ += hist[(c.tid << 5) | ((r + c.tid) & 31)];
                sel[16 + c.tid] = t_; }
            __syncthreads();
            if (c.wave == 0) {
                const unsigned c0 = sel[16 + 4 * c.lane], c1 = sel[16 + 4 * c.lane + 1], c2 = sel[16 + 4 * c.lane + 2], c3 = sel[16 + 4 * c.lane + 3];
                const unsigned s = c0 + c1 + c2 + c3;
                unsigned suf = s;
#pragma unroll
                for (int o = 1; o < 64; o <<= 1) { const unsigned t = __shfl_down(suf, o); if (c.lane + o < 64) suf += t; }
                unsigned above = suf - s;
                if (above < krem && krem <= above + c3) { sel[0] = 4 * c.lane + 3; sel[1] = krem - above; } above += c3;
                if (above < krem && krem <= above + c2) { sel[0] = 4 * c.lane + 2; sel[1] = krem - above; } above += c2;
                if (above < krem && krem <= above + c1) { sel[0] = 4 * c.lane + 1; sel[1] = krem - above; } above += c1;
                if (above < krem && krem <= above + c0) { sel[0] = 4 * c.lane + 0; sel[1] = krem - above; }
            }
            __syncthreads();
            prefix |= sel[0] << shift; mask |= 255u << shift; krem = sel[1];
            __syncthreads();
        }
        unsigned cg = 0u, ce = 0u;
#pragma unroll 2
        for (int i = 0; i < 16; ++i) { const u32x4 v = *(const u32x4*)(a + i * 4);
#pragma unroll
            for (int q = 0; q < 4; ++q) { cg += v[q] > prefix ? 1u : 0u; ce += v[q] == prefix ? 1u : 0u; } }
        const unsigned pk = cg | (ce << 16); unsigned inc = pk;
#pragma unroll
        for (int o = 1; o < 64; o <<= 1) { const unsigned t = __shfl_up(inc, o); if (c.lane >= o) inc += t; }
        if (c.lane == 63) wsum[c.wave] = inc;
        __syncthreads();
        unsigned wbase = 0u;
        for (int w = 0; w < c.wave; ++w) wbase += wsum[w];
        const unsigned exc = wbase + inc - pk;
        unsigned pg = exc & 0xffffu, pe = exc >> 16;
        const unsigned ngt = CAP - krem;
        int* idx = IDX + (long)prob * CAP; float* gate = GATE + (long)prob * CAP;
        const int grp = prob >> 4, e = prob & 15;
#pragma unroll 1
        for (int i = 0; i < 16; ++i) { const u32x4 v = *(const u32x4*)(a + i * 4);
#pragma unroll
            for (int q = 0; q < 4; ++q) {
                int pos = -1;
                if (v[q] > prefix) pos = (int)(pg++);
                else if (v[q] == prefix) { if (pe < krem) pos = (int)(ngt + pe); ++pe; }
                if (pos >= 0) { const int n = c.tid * 64 + i * 4 + q; idx[pos] = n; gate[pos] = __uint_as_float(v[q]); INV[((long)grp * NGRP_TOK + n) * 16 + e] = pos; }
            } }
        __syncthreads();
    }
}

DI void prep_a(const Ctx& c, const bf16_t* QKV, const float* qgain, const float* kgain, unsigned char* Q8, unsigned char* K8, unsigned char* V8T) {
    LAS float* CS = (LAS float*)c.lds;
    for (int i = c.tid; i < 2048; i += 512) { const int pos = i >> 4, j = i & 15; float sn, cs; sincosf((float)pos * exp2f(-(float)j * (13.287712379549449f / 16.0f)), &sn, &cs); CS[i] = cs; CS[2048 + i] = sn; }
    __syncthreads();
    const int hl = c.lane >> 3, half = (c.lane >> 2) & 1, jq = c.lane & 3;
    const int d1 = half * 32 + jq * 4;
    const long nitem = (long)NTOK * 5 / 2;
    for (long it = c.gw; it < nitem; it += c.ngw) {
        const long hg = it * 8 + hl;
        const int row = (int)(hg / 20), hd = (int)(hg % 20);
        const int s = seq_of_row(row), t = row - seq_base(s);
        const int pos = half == 0 ? (t >> 6) : (t & 63);
        const bf16_t* p = QKV + (long)row * 1536 + hd * 64 + d1;
        const u32x2 a = *(const u32x2*)p, b = *(const u32x2*)(p + 16);
        float x1[4] = {bf2f(a.x & 0xffffu), bf2f(a.x >> 16), bf2f(a.y & 0xffffu), bf2f(a.y >> 16)}, x2[4] = {bf2f(b.x & 0xffffu), bf2f(b.x >> 16), bf2f(b.y & 0xffffu), bf2f(b.y >> 16)};
        float ss = 0.f;
#pragma unroll
        for (int q = 0; q < 4; ++q) ss += x1[q] * x1[q] + x2[q] * x2[q];
        ss += __shfl_xor(ss, 1); ss += __shfl_xor(ss, 2); ss += __shfl_xor(ss, 4);
        const float rinv = rsqrtf(ss * (1.0f / 64.0f) + 1e-6f) * (hd < 16 ? 0.125f * LOG2E : 1.0f);
        const float* gn = (hd < 16 ? qgain : kgain) + d1;
        const f32x4 g1 = *(const f32x4*)gn, g2 = *(const f32x4*)(gn + 16);
        const f32x4 cs = *(const LAS f32x4*)(CS + pos * 16 + jq * 4), sn = *(const LAS f32x4*)(CS + 2048 + pos * 16 + jq * 4);
        float o1[4], o2[4];
#pragma unroll
        for (int q = 0; q < 4; ++q) { const float y1 = x1[q] * rinv * g1[q], y2 = x2[q] * rinv * g2[q]; o1[q] = y1 * cs[q] - y2 * sn[q]; o2[q] = y1 * sn[q] + y2 * cs[q]; }
        unsigned char* o8 = hd < 16 ? Q8 + (long)row * 1024 + hd * 64 + d1 : K8 + (long)row * 256 + (hd - 16) * 64 + d1;
        *(unsigned*)o8 = cvt_pk4_fp8(o1[0], o1[1], o1[2], o1[3]); *(unsigned*)(o8 + 16) = cvt_pk4_fp8(o2[0], o2[1], o2[2], o2[3]);
    }
    for (int it = c.gw; it < (NTOK / 64) * 4; it += c.ngw) {
        const int tile = it >> 2, kh = it & 3, row = tile * 64 + c.lane;
        const int sq = seq_of_row(row); const long rb = seq_base(sq); const int S = seq_len(sq), tl = (int)(tile * 64 - rb);
        const int k = c.lane, w = k & 31, pos = ((w >> 2) & 1) * 32 + (k >> 5) * 16 + (w >> 3) * 4 + (w & 3);
        const bf16_t* vp = QKV + (long)row * 1536 + 1280 + kh * 64;
        unsigned char* dst = V8T + rb * 256 + (long)(kh * 64) * S + tl + pos;
#pragma unroll
        for (int q = 0; q < 8; ++q) { const u32x4 v = *(const u32x4*)(vp + q * 8);
            const unsigned p0 = cvt_pk4_fp8(bf2f(v.x & 0xffffu), bf2f(v.x >> 16), bf2f(v.y & 0xffffu), bf2f(v.y >> 16)), p1 = cvt_pk4_fp8(bf2f(v.z & 0xffffu), bf2f(v.z >> 16), bf2f(v.w & 0xffffu), bf2f(v.w >> 16));
#pragma unroll
            for (int e = 0; e < 4; ++e) { dst[(long)(q * 8 + e) * S] = (unsigned char)(p0 >> (8 * e)); dst[(long)(q * 8 + 4 + e) * S] = (unsigned char)(p1 >> (8 * e)); } }
    }
    __syncthreads();
}
#define MFMA32(a, b, c) __builtin_amdgcn_mfma_f32_32x32x16_bf16((a), (b), (c), 0, 0, 0)
typedef short v4i16_t __attribute__((ext_vector_type(4)));
constexpr int KST = 144;
DI s16x4 vtr(const LAS char* p) { return __builtin_bit_cast(s16x4, __builtin_amdgcn_ds_read_tr16_b64_v4i16((LAS v4i16_t*)p)); }
DI bf16x8 pack8(const f32x16& p, int s) {
    u32x4 w; w.x = cvt_pk_bf16(p[8 * s], p[8 * s + 1]); w.y = cvt_pk_bf16(p[8 * s + 2], p[8 * s + 3]); w.z = cvt_pk_bf16(p[8 * s + 4], p[8 * s + 5]); w.w = cvt_pk_bf16(p[8 * s + 6], p[8 * s + 7]);
    return __builtin_bit_cast(bf16x8, w); }
DI float max16(const f32x16& s) {
    float a = fmaxf(fmaxf(s[0], s[1]), fmaxf(s[2], s[3])), b = fmaxf(fmaxf(s[4], s[5]), fmaxf(s[6], s[7]));
    float cc = fmaxf(fmaxf(s[8], s[9]), fmaxf(s[10], s[11])), d = fmaxf(fmaxf(s[12], s[13]), fmaxf(s[14], s[15]));
    return fmaxf(fmaxf(a, b), fmaxf(cc, d)); }
DI float sum16(const f32x16& s) {
    return ((s[0] + s[1]) + (s[2] + s[3])) + ((s[4] + s[5]) + (s[6] + s[7])) + ((s[8] + s[9]) + (s[10] + s[11])) + ((s[12] + s[13]) + (s[14] + s[15])); }
DI f32x16 zero16() { f32x16 z;
#pragma unroll
    for (int i = 0; i < 16; ++i) z[i] = 0.f;
    return z; }
DI void pv_block(const LAS char* Vt, const f32x16& p, f32x16& O0, f32x16& O1, int lane) {
    const int hi = lane >> 5, blk = (lane >> 4) & 1, q4 = (lane & 15) >> 2, pp = lane & 3;
#pragma unroll
    for (int s = 0; s < 2; ++s) {
        const bf16x8 pf = pack8(p, s);
        const LAS char* r0 = Vt + (16 * s + 4 * hi + q4) * KST + 32 * blk + 8 * pp;
        const s16x4 a0 = vtr(r0), a1 = vtr(r0 + 8 * KST), b0 = vtr(r0 + 64), b1 = vtr(r0 + 8 * KST + 64);
        const bf16x8 v0 = __builtin_shufflevector(a0, a1, 0, 1, 2, 3, 4, 5, 6, 7), v1 = __builtin_shufflevector(b0, b1, 0, 1, 2, 3, 4, 5, 6, 7);
        O0 = MFMA32(v0, pf, O0); O1 = MFMA32(v1, pf, O1);
    }
}
constexpr float ATT_THR = 8.0f;
#define LDS_BARRIER() asm volatile("s_waitcnt lgkmcnt(0)\n\ts_barrier" ::: "memory")
#define MX3(a, b, c) __builtin_fmaxf(__builtin_fmaxf((a), (b)), (c))
DI float rowmax32x(const f32x16& p0, const f32x16& p1) {
    float a = MX3(p0[0], p0[1], p1[0]), b = MX3(p0[2], p0[3], p1[1]); a = MX3(a, p1[2], p1[3]);
#pragma unroll
    for (int r = 4; r < 16; r += 4) { a = MX3(a, p0[r], p0[r + 1]); b = MX3(b, p0[r + 2], p0[r + 3]); a = MX3(a, p1[r], p1[r + 1]); b = MX3(b, p1[r + 2], p1[r + 3]); }
    const float mm = __builtin_fmaxf(a, b);
    const auto rr = __builtin_amdgcn_permlane32_swap(__float_as_uint(mm), __float_as_uint(mm), false, false);
    return __builtin_fmaxf(__uint_as_float(rr[0]), __uint_as_float(rr[1])); }
DI float make_qx(float m, int hi, bf16x8& qx) {
    const unsigned h = cvt_pk_bf16(-m, 0.f) & 0xffffu; const float hf = bf2f(h);
    const unsigned lo = cvt_pk_bf16(-m - hf, 0.f) & 0xffffu; const float lf = bf2f(lo);
    u32x4 w; w.x = hi == 0 ? (h | (lo << 16)) : 0u; w.y = 0u; w.z = 0u; w.w = 0u; qx = __builtin_bit_cast(bf16x8, w);
    return -(hf + lf); }
DI void qk_tile_x(const LAS char* Klane, const bf16x8 (&qf)[4], const bf16x8& kx, const bf16x8& qx, f32x16& s0, f32x16& s1) {
    s0 = MFMA32(kx, qx, zero16()); s1 = MFMA32(kx, qx, zero16());
#pragma unroll
    for (int ks = 0; ks < 4; ++ks) {
        const bf16x8 k0 = *(const LAS bf16x8*)(Klane + ks * 32), k1 = *(const LAS bf16x8*)(Klane + 32 * KST + ks * 32);
        s0 = MFMA32(k0, qf[ks], s0); s1 = MFMA32(k1, qf[ks], s1); }
}
DI void exp_pack_x(f32x16& s0, f32x16& s1, bf16x8 (&pf)[4]) {
#pragma unroll
    for (int r = 0; r < 16; ++r) { s0[r] = fast_exp2(s0[r]); s1[r] = fast_exp2(s1[r]); }
    pf[0] = pack8(s0, 0); pf[1] = pack8(s0, 1); pf[2] = pack8(s1, 0); pf[3] = pack8(s1, 1);
}
DI void pv_tile_x(const LAS char* Vlane, const bf16x8 (&pf)[4], const bf16x8& ones, f32x16& O0, f32x16& O1, f32x16& Ls) {
#pragma unroll
    for (int ks = 0; ks < 4; ++ks) {
        const LAS char* r0 = Vlane + 16 * ks * KST;
        const s16x4 a0 = vtr(r0), a1 = vtr(r0 + 8 * KST), b0 = vtr(r0 + 64), b1 = vtr(r0 + 8 * KST + 64);
        const bf16x8 v0 = __builtin_shufflevector(a0, a1, 0, 1, 2, 3, 4, 5, 6, 7), v1 = __builtin_shufflevector(b0, b1, 0, 1, 2, 3, 4, 5, 6, 7);
        O0 = MFMA32(v0, pf[ks], O0); O1 = MFMA32(v1, pf[ks], O1); Ls = MFMA32(ones, pf[ks], Ls);
    }
}
DI void pv_tile(const LAS char* Vt, const bf16x8 (&pf)[4], f32x16& O0, f32x16& O1, int lane) {
    const int hi = lane >> 5, blk = (lane >> 4) & 1, q4 = (lane & 15) >> 2, pp = lane & 3;
#pragma unroll
    for (int ks = 0; ks < 4; ++ks) {
        const LAS char* r0 = Vt + (16 * ks + 4 * hi + q4) * KST + 32 * blk + 8 * pp;
        const s16x4 a0 = vtr(r0), a1 = vtr(r0 + 8 * KST), b0 = vtr(r0 + 64), b1 = vtr(r0 + 8 * KST + 64);
        const bf16x8 v0 = __builtin_shufflevector(a0, a1, 0, 1, 2, 3, 4, 5, 6, 7), v1 = __builtin_shufflevector(b0, b1, 0, 1, 2, 3, 4, 5, 6, 7);
        O0 = MFMA32(v0, pf[ks], O0); O1 = MFMA32(v1, pf[ks], O1);
    }
}
#define MFMA_ACC(acc, a, b) acc = MFMA32(a, b, acc)
constexpr int KST8 = 80;
constexpr float A8_TGT = 6.0f, A8_HI = 8.0f;
#define MFMA8(a, b, c) __builtin_amdgcn_mfma_scale_f32_32x32x64_f8f6f4((a), (b), (c), 0, 0, 0, 127, 0, 127)
DI i32x8 cat8(const u32x4& lo, const u32x4& hi) { return __builtin_bit_cast(i32x8, __builtin_shufflevector(lo, hi, 0, 1, 2, 3, 4, 5, 6, 7)); }
DI void attn_a_phase(const Ctx& c, const unsigned char* Q8, const unsigned char* K8, const unsigned char* V8T, bf16_t* OB) {
    constexpr int SLOT8 = 64 * KST8, NK = 3, NV = 4;
    const int r32 = c.lane & 31, hi = c.lane >> 5;
    LAS char* KB = (LAS char*)c.lds; LAS char* VB = KB + NK * SLOT8;
    const LAS char* Klane = KB + r32 * KST8 + hi * 32;
    const LAS char* Vlane = VB + r32 * KST8 + hi * 32;
    i32x8 ones8 = {0x38383838, 0x38383838, 0x38383838, 0x38383838, 0x38383838, 0x38383838, 0x38383838, 0x38383838};
    asm volatile("" : "+v"(ones8));
    const bool kld = c.wave < 4;
    const int pr = (c.tid & 255) >> 2, pc4 = (c.tid & 3) * 16, ldp = pr * KST8 + pc4;
    for (int L = c.bid; L < 4096; L += c.G) {
        int s, kh, qblk;
        if (L < 2048) { s = L >> 8; kh = (L >> 6) & 3; qblk = L & 63; } else { const int u = L - 2048; s = 8 + (u >> 9); kh = (u >> 7) & 3; qblk = u & 127; }
        const int S = seq_len(s); const long rb = seq_base(s);
        const int hq = kh * 4 + (c.wave >> 1), q0 = qblk * 64 + (c.wave & 1) * 32;
        i32x8 qf8;
        { const unsigned char* qp = Q8 + (rb + q0 + r32) * 1024 + hq * 64 + hi * 32; qf8 = cat8(*(const u32x4*)qp, *(const u32x4*)(qp + 16)); }
        const unsigned char* src = kld ? K8 + (rb + pr) * 256 + kh * 64 + pc4 : V8T + rb * 256 + (long)(kh * 64 + pr) * S + pc4;
        const long tstep = kld ? 64l * 256 : 64l;
        const int NT = S >> 6;
#define A_LOAD(tile) do { preg = *(const u32x4*)(src + (long)(tile) * tstep); } while (0)
#define A_STORE(tile) do { if (kld) *(LAS u32x4*)(KB + ((tile) % NK) * SLOT8 + ldp) = preg; else *(LAS u32x4*)(VB + ((tile) % NV) * SLOT8 + ldp) = preg; } while (0)
        u32x4 preg;
        A_LOAD(0); A_STORE(0); A_LOAD(1); A_STORE(1); A_LOAD(2);
        __syncthreads();
        f32x16 O0 = zero16(), O1 = zero16(), Ls = zero16(), sa0, sa1, sb0, sb1;
        i32x8 p8 = {0, 0, 0, 0, 0, 0, 0, 0};
        u32x4 vl0, vh0, vl1, vh1;
        float m, msc;
#define A_KFR(kbase) const u32x4 kl0_ = *(const LAS u32x4*)(kbase), kh0_ = *(const LAS u32x4*)((kbase) + 16), kl1_ = *(const LAS u32x4*)((kbase) + 32 * KST8), kh1_ = *(const LAS u32x4*)((kbase) + 32 * KST8 + 16)
#define A_QK(S0, S1) do { __builtin_amdgcn_s_setprio(1); S0 = MFMA8(cat8(kl0_, kh0_), qf8, zero16()); S1 = MFMA8(cat8(kl1_, kh1_), qf8, zero16()); __builtin_amdgcn_s_setprio(0); } while (0)
#define A_VFR(vbase) do { vl0 = *(const LAS u32x4*)(vbase); vh0 = *(const LAS u32x4*)((vbase) + 16); vl1 = *(const LAS u32x4*)((vbase) + 32 * KST8); vh1 = *(const LAS u32x4*)((vbase) + 32 * KST8 + 16); } while (0)
#define A_EXP(S0, S1) do { \
            _Pragma("unroll") for (int r = 0; r < 16; ++r) { S0[r] = fast_exp2(S0[r]); S1[r] = fast_exp2(S1[r]); } \
            _Pragma("unroll") for (int w = 0; w < 4; ++w) { p8[w] = (int)cvt_pk4_fp8_sc((unsigned)p8[w], S0[4 * w], S0[4 * w + 1], S0[4 * w + 2], S0[4 * w + 3], msc); \
                                                            p8[4 + w] = (int)cvt_pk4_fp8_sc((unsigned)p8[4 + w], S1[4 * w], S1[4 * w + 1], S1[4 * w + 2], S1[4 * w + 3], msc); } } while (0)
#define A_PV() do { __builtin_amdgcn_s_setprio(1); O0 = MFMA8(cat8(vl0, vh0), p8, O0); O1 = MFMA8(cat8(vl1, vh1), p8, O1); Ls = MFMA8(ones8, p8, Ls); __builtin_amdgcn_s_setprio(0); } while (0)
#define A_TAIL(t_) do { A_STORE((t_) + 2); asm volatile("" ::: "memory"); A_VFR(Vlane + ((t_) % NV) * SLOT8); asm volatile("s_waitcnt lgkmcnt(4)\n\ts_barrier" ::: "memory"); } while (0)
        { A_KFR(Klane); A_QK(sa0, sa1); }
        { const float mx = rowmax32x(sa0, sa1); m = __builtin_floorf(mx) - A8_TGT; msc = __int_as_float(((int)m + 127) << 23); }
        { A_KFR(Klane + SLOT8); A_EXP(sa0, sa1); A_QK(sb0, sb1); }
        A_TAIL(0);
#define A_BLOCK(t_, SI0, SI1, SO0, SO1) do { \
            { const int tl_ = (t_) + 2 < NT ? (t_) + 2 : NT - 1; A_LOAD(tl_); } \
            A_KFR(Klane + (((t_) + 1) % NK) * SLOT8); \
            A_PV(); \
            const float mx = rowmax32x(SI0, SI1); \
            if (__any(mx - m > A8_HI)) { \
                const float mn = __builtin_fmaxf(__builtin_floorf(mx) - A8_TGT, m), al = fast_exp2(m - mn); m = mn; msc = __int_as_float(((int)m + 127) << 23); \
                _Pragma("unroll") for (int r = 0; r < 16; ++r) { O0[r] *= al; O1[r] *= al; Ls[r] *= al; } } \
            A_EXP(SI0, SI1); \
            A_QK(SO0, SO1); \
            A_TAIL(t_); } while (0)
        for (int t = 1; t + 1 < NT; t += 2) { A_BLOCK(t, sb0, sb1, sa0, sa1); A_BLOCK(t + 1, sa0, sa1, sb0, sb1); }
        A_BLOCK(NT - 1, sb0, sb1, sa0, sa1);
        A_PV();
#undef A_KFR
#undef A_QK
#undef A_VFR
#undef A_EXP
#undef A_PV
#undef A_TAIL
#undef A_BLOCK
#undef A_LOAD
#undef A_STORE
        const float inv = fast_rcp(Ls[0]) * 64.0f;
        unsigned char* op = (unsigned char*)OB + (rb + q0 + r32) * DM + hq * 64 + 4 * hi;
#pragma unroll
        for (int j = 0; j < 4; ++j) {
            *(unsigned*)(op + 8 * j) = cvt_pk4_fp8(O0[4 * j] * inv, O0[4 * j + 1] * inv, O0[4 * j + 2] * inv, O0[4 * j + 3] * inv);
            *(unsigned*)(op + 32 + 8 * j) = cvt_pk4_fp8(O1[4 * j] * inv, O1[4 * j + 1] * inv, O1[4 * j + 2] * inv, O1[4 * j + 3] * inv); }
        __syncthreads();
    }
}

DI int t5_bucket(int rel) {
    const int n = rel < 0 ? -rel : rel;
    int large = 8 + (int)(logf((float)(n < 1 ? 1 : n) / 8.0f) / 2.772588722239781f * 8.0f);
    large = large < 15 ? large : 15;
    return (rel > 0 ? 16 : 0) + (n < 8 ? n : large);
}
DI void attn_d_phase(const Ctx& c, const bf16_t* QKV, bf16_t* OB, const float* rel_bias, const float* dlam, const float* ngain, float lambda_init) {
    constexpr int LQ = 2304, SLOT = 64 * KST;
    const int r32 = c.lane & 31, hi = c.lane >> 5;
    LAS char* KB = (LAS char*)c.lds; LAS char* VB = KB + 2 * SLOT;
    LAS float* LUT = (LAS float*)(c.lds + 4 * SLOT);
    for (int i = c.tid; i < 12 * 256; i += 512) { const int h = i >> 8, e = i & 255; const int rel = (e < 255 ? e : 254) - 127; LUT[i] = rel_bias[t5_bucket(rel) * 12 + h] * LOG2E; }
    float lam;
    { const int i = c.lane & 31; const float a = wave_sum(c.lane < 32 ? dlam[i] * dlam[32 + i] : 0.f), b = wave_sum(c.lane < 32 ? dlam[64 + i] * dlam[96 + i] : 0.f);
      lam = __expf(a) - __expf(b) + lambda_init; }
    const LAS char* Klane = KB + r32 * KST + hi * 16;
    const LAS char* Vlane = VB + (4 * hi + ((c.lane & 15) >> 2)) * KST + 32 * ((c.lane >> 4) & 1) + 8 * (c.lane & 3);
    bf16x8 kx;
    { u32x4 w; w.x = hi == 0 ? 0x3F803F80u : 0u; w.y = 0u; w.z = 0u; w.w = 0u; kx = __builtin_bit_cast(bf16x8, w); }
    __syncthreads();
    for (int L = c.bid; L < 3072; L += c.G) {
        int s, h, qblk;
        if (L < 1536) { s = L / 192; const int r = L % 192; h = r >> 4; qblk = r & 15; } else { const int u = L - 1536; s = 8 + u / 384; const int r = u % 384; h = r >> 5; qblk = r & 31; }
        const int S = seq_len(s); const long rb = seq_base(s);
        const int q0 = qblk * 256 + c.wave * 32;
        bf16x8 qf[2][2];
        { const bf16_t* qp = QKV + (rb + q0 + r32) * LQ + h * 64 + hi * 8;
#pragma unroll
          for (int mm = 0; mm < 2; ++mm)
#pragma unroll
              for (int ks = 0; ks < 2; ++ks) qf[mm][ks] = *(const bf16x8*)(qp + mm * 32 + ks * 16); }
        const bf16_t* kg = QKV + (rb + (c.tid >> 3)) * LQ + 768 + h * 64 + (c.tid & 7) * 8;
        const int ldst = (c.tid >> 3) * KST + (c.tid & 7) * 16;
        u32x4 kr = *(const u32x4*)kg, vr = *(const u32x4*)(kg + 768);
        *(LAS u32x4*)(KB + ldst) = kr; *(LAS u32x4*)(VB + ldst) = vr;
        asm volatile("" :: "v"(qf[0][0]), "v"(qf[0][1]), "v"(qf[1][0]), "v"(qf[1][1]));
        __syncthreads();
        f32x16 Oa0 = zero16(), Oa1 = zero16(), Ob0 = zero16(), Ob1 = zero16();
        const LAS float* lut = LUT + h * 256;
        const float bneg = lut[0], bpos = lut[254];
        bf16x8 qxa, qxb; float ra = make_qx(-100.f, hi, qxa), rbb = make_qx(-100.f, hi, qxb), la = 0.f, lb = 0.f, boff = 0.f;
        const int NT = S >> 6;
        for (int t = 0; t < NT; ++t) {
            const int buf = t & 1;
            if (t + 1 < NT) { const bf16_t* kn = kg + (long)(t + 1) * 64 * LQ; kr = *(const u32x4*)kn; vr = *(const u32x4*)(kn + 768); }
            const LAS char* Kt = Klane + buf * SLOT; const LAS char* Vt = Vlane + buf * SLOT;
            const int k0 = t * 64, dmin = k0 - (q0 + 31), dmax = k0 + 63 - q0;
            const bool near = (dmax > -127) && (dmin < 127);
            const float bnew = near ? 0.f : (dmax <= -127 ? bneg : bpos);
            if (bnew != boff) { ra = make_qx(ra + boff - bnew, hi, qxa); rbb = make_qx(rbb + boff - bnew, hi, qxb); boff = bnew; }
            bf16x8 pa[4], pb[4];
#define D_BRANCH(KOFF, QF, QX, RR, LL, O0_, O1_, PP) do { \
                f32x16 s0 = MFMA32(kx, QX, zero16()), s1 = MFMA32(kx, QX, zero16()); \
                _Pragma("unroll") for (int ks = 0; ks < 2; ++ks) { \
                    const bf16x8 k0_ = *(const LAS bf16x8*)(Kt + (KOFF) + ks * 32), k1_ = *(const LAS bf16x8*)(Kt + 32 * KST + (KOFF) + ks * 32); \
                    s0 = MFMA32(k0_, QF[ks], s0); s1 = MFMA32(k1_, QF[ks], s1); } \
                if (near) { int relb = k0 + 4 * hi - (q0 + r32); asm volatile("" : "+v"(relb)); \
                    _Pragma("unroll") for (int r = 0; r < 16; ++r) { int rel = relb + (r & 3) + 8 * (r >> 2); int r1 = rel + 32; \
                        rel = rel < -127 ? -127 : (rel > 127 ? 127 : rel); r1 = r1 < -127 ? -127 : (r1 > 127 ? 127 : r1); s0[r] += lut[rel + 127]; s1[r] += lut[r1 + 127]; \
                        if ((r & 3) == 3) __builtin_amdgcn_sched_barrier(0); } } \
                const float mx = rowmax32x(s0, s1); \
                if (__any(mx > ATT_THR)) { \
                    const float ro = RR; RR = make_qx(RR + __builtin_fmaxf(mx, 0.f), hi, QX); const float d = RR - ro, al = fast_exp2(-d); LL *= al; \
                    _Pragma("unroll") for (int r = 0; r < 16; ++r) { s0[r] -= d; s1[r] -= d; O0_[r] *= al; O1_[r] *= al; } } \
                exp_pack_x(s0, s1, PP); { const f32x16 t_ = s0 + s1; LL += sum16(t_); } } while (0)
            D_BRANCH(0, qf[0], qxa, ra, la, Oa0, Oa1, pa);
            D_BRANCH(64, qf[1], qxb, rbb, lb, Ob0, Ob1, pb);
#undef D_BRANCH
#pragma unroll
            for (int ks = 0; ks < 4; ++ks) {
                const LAS char* r0 = Vt + 16 * ks * KST;
                const s16x4 x0 = vtr(r0), x1 = vtr(r0 + 8 * KST), y0 = vtr(r0 + 64), y1 = vtr(r0 + 8 * KST + 64);
                const bf16x8 v0 = __builtin_shufflevector(x0, x1, 0, 1, 2, 3, 4, 5, 6, 7), v1 = __builtin_shufflevector(y0, y1, 0, 1, 2, 3, 4, 5, 6, 7);
                Oa0 = MFMA32(v0, pa[ks], Oa0); Oa1 = MFMA32(v1, pa[ks], Oa1); Ob0 = MFMA32(v0, pb[ks], Ob0); Ob1 = MFMA32(v1, pb[ks], Ob1);
            }
            if (t + 1 < NT) { *(LAS u32x4*)(KB + (buf ^ 1) * SLOT + ldst) = kr; *(LAS u32x4*)(VB + (buf ^ 1) * SLOT + ldst) = vr; }
            __syncthreads();
        }
        la += __shfl_xor(la, 32); lb += __shfl_xor(lb, 32);
        const float ia = fast_rcp(la), ib = lam * fast_rcp(lb);
        float ss = 0.f;
#pragma unroll
        for (int r = 0; r < 16; ++r) { Oa0[r] = Oa0[r] * ia - Ob0[r] * ib; Oa1[r] = Oa1[r] * ia - Ob1[r] * ib; ss += Oa0[r] * Oa0[r] + Oa1[r] * Oa1[r]; }
        ss += __shfl_xor(ss, 32);
        const float rn = rsqrtf(ss * (1.0f / 64.0f) + 1e-6f) * (1.0f - lambda_init);
        bf16_t* op = OB + (rb + q0 + r32) * 768 + h * 64 + 4 * hi;
#pragma unroll
        for (int j = 0; j < 4; ++j) {
            const f32x4 g0 = *(const f32x4*)(ngain + 8 * j + 4 * hi), g1 = *(const f32x4*)(ngain + 32 + 8 * j + 4 * hi);
            u32x2 w0, w1;
            w0.x = cvt_pk_bf16(Oa0[4 * j] * rn * g0[0], Oa0[4 * j + 1] * rn * g0[1]); w0.y = cvt_pk_bf16(Oa0[4 * j + 2] * rn * g0[2], Oa0[4 * j + 3] * rn * g0[3]);
            w1.x = cvt_pk_bf16(Oa1[4 * j] * rn * g1[0], Oa1[4 * j + 1] * rn * g1[1]); w1.y = cvt_pk_bf16(Oa1[4 * j + 2] * rn * g1[2], Oa1[4 * j + 3] * rn * g1[3]);
            *(u32x2*)(op + 8 * j) = w0; *(u32x2*)(op + 32 + 8 * j) = w1; }
    }
    __syncthreads();
}

DI void attn_b_phase(const Ctx& c, const bf16_t* QKV, bf16_t* OB, const float* rel_bias) {
    constexpr int LQ = 2304;
    const int r32 = c.lane & 31, hi = c.lane >> 5;
    LAS float* LUT = (LAS float*)c.lds;
    LAS char* Vw = (LAS char*)c.lds + 8192 + c.wave * (32 * KST);
    for (int i = c.tid; i < 12 * 132; i += 512) { const int gh = i / 132, jj = i % 132; const int g = gh >> 2, d = g == 0 ? 1 : (g == 1 ? 4 : 16);
        LUT[i] = jj <= 128 ? rel_bias[t5_bucket(d * (jj - 64)) * 12 + gh] * LOG2E : 0.f; }
    __syncthreads();
    for (int L = c.bid; L < 1024; L += c.G) {
        int s, rem;
        if (L < 512) { s = L >> 6; rem = L & 63; } else { s = 8 + ((L - 512) >> 7); rem = (L - 512) & 127; }
        const int S = seq_len(s); const long rb = seq_base(s);
        const int hh = rem & 3, rhalf = (rem >> 2) & 1, blk = rem >> 3;
        const int t0 = blk * 512 + rhalf * 8 + c.wave;
        const int qpos = t0 + 16 * r32;
        f32x16 O[3][2]; float mg[3], lg[3];
#pragma unroll
        for (int g = 0; g < 3; ++g) {
            const int d = g == 0 ? 1 : (g == 1 ? 4 : 16), dsh = g == 0 ? 0 : (g == 1 ? 2 : 4), ntile = g == 0 ? 20 : (g == 1 ? 8 : 5);
            const int head = g * 4 + hh;
            bf16x8 qf[4];
            { const bf16_t* qp = QKV + (rb + qpos) * LQ + head * 64 + hi * 8;
#pragma unroll
              for (int ks = 0; ks < 4; ++ks) qf[ks] = *(const bf16x8*)(qp + ks * 16); }
            const LAS float* lut = LUT + (g * 4 + hh) * 132;
            f32x16 O0 = zero16(), O1 = zero16(); float m = -INFINITY, l = 0.f;
            const int kbase = t0 - 64 * d;
#pragma unroll 1
            for (int j = 0; j < ntile; ++j) {
                int kp = kbase + d * (32 * j + r32); kp = kp < 0 ? 0 : (kp >= S ? S - 1 : kp);
                const bf16_t* kr = QKV + (rb + kp) * LQ + 768 + head * 64 + hi * 8;
                bf16x8 kf[4];
#pragma unroll
                for (int ks = 0; ks < 4; ++ks) kf[ks] = *(const bf16x8*)(kr + ks * 16);
                u32x4 vv[4];
#pragma unroll
                for (int i = 0; i < 4; ++i) { const int id = c.lane + 64 * i, e = id >> 3; int vp = kbase + d * (32 * j + e); vp = vp < 0 ? 0 : (vp >= S ? S - 1 : vp);
                    vv[i] = *(const u32x4*)(QKV + (rb + vp) * LQ + 1536 + head * 64 + (id & 7) * 8); }
                f32x16 sc = zero16();
#pragma unroll
                for (int ks = 0; ks < 4; ++ks) sc = MFMA32(kf[ks], qf[ks], sc);
                float mx = -INFINITY;
                if ((kbase + d * 32 * j >= 0) && (kbase + d * (32 * j + 31) < S)) {
                    const int JB = 32 * j + 4 * hi - (16 >> dsh) * r32;
#pragma unroll
                    for (int r = 0; r < 16; ++r) {
                        const int jj = JB + (r & 3) + 8 * (r >> 2);
                        const bool ok = (unsigned)jj <= 128u;
                        const float bv = lut[ok ? jj : 0];
                        sc[r] = ok ? sc[r] * (0.125f * LOG2E) + bv : -INFINITY;
                        mx = fmaxf(mx, sc[r]);
                    }
                } else {
#pragma unroll
                for (int r = 0; r < 16; ++r) {
                    const int e = (r & 3) + 8 * (r >> 2) + 4 * hi;
                    const int kpos = kbase + d * (32 * j + e), rel = kpos - qpos;
                    const int jj = (rel >> dsh) + 64;
                    const bool ok = (jj >= 0) && (jj <= 128) && (kpos >= 0) && (kpos < S);
                    const float bv = lut[ok ? jj : 0];
                    sc[r] = ok ? sc[r] * (0.125f * LOG2E) + bv : -INFINITY;
                    mx = fmaxf(mx, sc[r]);
                }
                }
                { const auto rr = __builtin_amdgcn_permlane32_swap(__float_as_uint(mx), __float_as_uint(mx), false, false); mx = fmaxf(__uint_as_float(rr[0]), __uint_as_float(rr[1])); }
                const float mn = fmaxf(m, mx), msafe = (mn == -INFINITY) ? 0.f : mn, alpha = fast_exp2(m - msafe);
                m = mn;
#pragma unroll
                for (int r = 0; r < 16; ++r) sc[r] = fast_exp2(sc[r] - msafe);
                l = l * alpha + sum16(sc);
                O0 = O0 * alpha; O1 = O1 * alpha;
#pragma unroll
                for (int i = 0; i < 4; ++i) { const int id = c.lane + 64 * i; *(LAS u32x4*)(Vw + (id >> 3) * KST + (id & 7) * 16) = vv[i]; }
                asm volatile("s_waitcnt lgkmcnt(0)" ::: "memory");
                pv_block(Vw, sc, O0, O1, c.lane);
                asm volatile("s_waitcnt lgkmcnt(0)" ::: "memory");
            }
            l += __shfl_xor(l, 32);
            O[g][0] = O0; O[g][1] = O1; mg[g] = m; lg[g] = l;
        }
        const float M = fmaxf(fmaxf(mg[0], mg[1]), mg[2]);
        const float e0 = fast_exp2(mg[0] - M), e1 = fast_exp2(mg[1] - M), e2 = fast_exp2(mg[2] - M);
        const float inv = fast_rcp(lg[0] * e0 + lg[1] * e1 + lg[2] * e2);
        const float wg[3] = {e0 * inv, e1 * inv, e2 * inv};
#pragma unroll
        for (int g = 0; g < 3; ++g) {
            bf16_t* op = OB + (rb + qpos) * 768 + (g * 4 + hh) * 64 + 4 * hi;
#pragma unroll
            for (int j = 0; j < 4; ++j) {
                u32x2 w0, w1;
                w0.x = cvt_pk_bf16(O[g][0][4 * j] * wg[g], O[g][0][4 * j + 1] * wg[g]); w0.y = cvt_pk_bf16(O[g][0][4 * j + 2] * wg[g], O[g][0][4 * j + 3] * wg[g]);
                w1.x = cvt_pk_bf16(O[g][1][4 * j] * wg[g], O[g][1][4 * j + 1] * wg[g]); w1.y = cvt_pk_bf16(O[g][1][4 * j + 2] * wg[g], O[g][1][4 * j + 3] * wg[g]);
                *(u32x2*)(op + 8 * j) = w0; *(u32x2*)(op + 32 + 8 * j) = w1; }
        }
    }
    __syncthreads();
}
DI void s5_tables(const Ctx& c, const float* lam_re, const float* lam_im, const float* log_dt, const float* b_re, const float* b_im, const float* c_re, const float* c_im,
                  bf16_t* Mt, bf16_t* Pt, float* APL, float* KKG) {
    LAS float* AP = (LAS float*)c.lds;
    LAS float* BB = AP + 2 * 33 * 64 * 2;
    LAS float* CC = BB + 2 * 64 * 16 * 2;
    for (int item = c.bid; item < 256; item += c.G) {
        const int g = item >> 2, qt = item & 3;
        if (c.tid < 128) {
            const int dir = c.tid >> 6, p = c.tid & 63;
            const float lr = lam_re[(dir * 64 + g) * 64 + p], li = lam_im[(dir * 64 + g) * 64 + p];
            const float dt = expf(log_dt[dir * 64 + g]);
            const float mag = expf(lr * dt);
            const float th = li * dt;
            float sn_, cs_; sincosf(th, &sn_, &cs_); const float ar = mag * cs_, ai = mag * sn_;
            const float den = lr * lr + li * li;
            const float zr = ((ar - 1.0f) * lr + ai * li) / den, zi = (ai * lr - (ar - 1.0f) * li) / den;
            double pr = 1.0, pi = 0.0;
            for (int t = 0; t <= 32; ++t) { AP[((dir * 33 + t) * 64 + p) * 2] = (float)pr; AP[((dir * 33 + t) * 64 + p) * 2 + 1] = (float)pi;
                const double nr = pr * (double)ar - pi * (double)ai, ni = pr * (double)ai + pi * (double)ar; pr = nr; pi = ni; }
            for (int j = 0; j < 16; ++j) { const float br = b_re[((dir * 64 + g) * 64 + p) * 16 + j], bi = b_im[((dir * 64 + g) * 64 + p) * 16 + j];
                BB[((dir * 64 + p) * 16 + j) * 2] = zr * br - zi * bi; BB[((dir * 64 + p) * 16 + j) * 2 + 1] = zr * bi + zi * br; }
        }
        for (int i = c.tid; i < 2 * 16 * 64; i += 512) { const int dir = i >> 10, r = i & 1023;
            CC[i * 2] = c_re[(dir * 64 + g) * 1024 + r]; CC[i * 2 + 1] = c_im[(dir * 64 + g) * 1024 + r]; }
        __syncthreads();
        if (qt == 0 && c.tid < 128) { const int dir = c.tid >> 6, p = c.tid & 63; APL[((g * 2 + dir) * 64 + p) * 2] = AP[((dir * 33 + 32) * 64 + p) * 2]; APL[((g * 2 + dir) * 64 + p) * 2 + 1] = AP[((dir * 33 + 32) * 64 + p) * 2 + 1]; }
        if (c.tid < 256) {
            const int dir = c.tid >> 7, tau = 8 * qt + ((c.tid >> 4) & 7), j = c.tid & 15;
            float acc[16];
#pragma unroll
            for (int jp = 0; jp < 16; ++jp) acc[jp] = 0.f;
            for (int p = 0; p < 64; ++p) {
                const f32x2 cc = *(const LAS f32x2*)(CC + ((dir * 16 + j) * 64 + p) * 2), ee = *(const LAS f32x2*)(AP + ((dir * 33 + tau) * 64 + p) * 2);
                const float wr = cc.x * ee.x - cc.y * ee.y, wi = cc.x * ee.y + cc.y * ee.x;
                const LAS f32x4* bb = (const LAS f32x4*)(BB + (dir * 64 + p) * 32);
#pragma unroll
                for (int q4 = 0; q4 < 8; ++q4) { const f32x4 b = bb[q4]; acc[2 * q4] += wr * b[0] - wi * b[1]; acc[2 * q4 + 1] += wr * b[2] - wi * b[3]; }
            }
            float* kk = KKG + ((size_t)g * 2 + dir) * 8192 + (tau * 16 + j) * 16;
#pragma unroll
            for (int q4 = 0; q4 < 4; ++q4) *(f32x4*)(kk + 4 * q4) = (f32x4){acc[4 * q4], acc[4 * q4 + 1], acc[4 * q4 + 2], acc[4 * q4 + 3]};
        }
        bf16_t* mt = Mt + (long)g * 512 * 768;
        for (int o = c.tid; o < 128 * 128; o += 512) {
            const int n = 128 * qt + (o >> 7), k = 512 + (o & 127) * 2, i = n >> 4, j = n & 15;
            float v[2];
#pragma unroll
            for (int e = 0; e < 2; ++e) { const int q = k + e - 512, dir = q >> 7, part = (q >> 6) & 1, p = q & 63, pw = dir == 0 ? i + 1 : 32 - i;
                const float cr = CC[((dir * 16 + j) * 64 + p) * 2], ci = CC[((dir * 16 + j) * 64 + p) * 2 + 1];
                const float er = AP[((dir * 33 + pw) * 64 + p) * 2], ei = AP[((dir * 33 + pw) * 64 + p) * 2 + 1];
                v[e] = part == 0 ? (cr * er - ci * ei) : -(cr * ei + ci * er); }
            *(unsigned*)(mt + (long)n * 768 + k) = cvt_pk_bf16(v[0], v[1]);
        }
        bf16_t* pt = Pt + (long)g * 256 * 512;
        for (int o = c.tid; o < 64 * 256; o += 512) {
            const int q = 64 * qt + (o >> 8), k = (o & 255) * 2, dir = q >> 7, part = (q >> 6) & 1, p = q & 63;
            float v[2];
#pragma unroll
            for (int e = 0; e < 2; ++e) { const int kk = k + e, s = kk >> 4, jp = kk & 15, pw = dir == 0 ? 31 - s : s;
                const float er = AP[((dir * 33 + pw) * 64 + p) * 2], ei = AP[((dir * 33 + pw) * 64 + p) * 2 + 1];
                const float br = BB[((dir * 64 + p) * 16 + jp) * 2], bi = BB[((dir * 64 + p) * 16 + jp) * 2 + 1];
                v[e] = part == 0 ? (er * br - ei * bi) : (er * bi + ei * br); }
            *(unsigned*)(pt + (long)q * 512 + k) = cvt_pk_bf16(v[0], v[1]);
        }
        __syncthreads();
    }
}
DI void s5_fill(const Ctx& c, const float* KKG, bf16_t* Mt) {
    LAS float* KK = (LAS float*)c.lds;
    for (int item = c.bid; item < 256; item += c.G) {
        const int g = item >> 2, qt = item & 3;
        for (int i = c.tid; i < 4096; i += 512) *(LAS f32x4*)(KK + 4 * i) = *(const f32x4*)(KKG + (size_t)g * 16384 + 4 * i);
        __syncthreads();
        bf16_t* mt = Mt + (long)g * 512 * 768;
        for (int o = c.tid; o < 128 * 256; o += 512) {
            const int n = 128 * qt + (o >> 8), k = (o & 255) * 2, i = n >> 4, j = n & 15;
            float v[2];
#pragma unroll
            for (int e = 0; e < 2; ++e) { const int kk = k + e, s = kk >> 4, jp = kk & 15; float x = 0.f;
                if (s <= i) x += KK[((i - s) * 16 + j) * 16 + jp];
                if (s >= i) x += KK[8192 + ((s - i) * 16 + j) * 16 + jp];
                v[e] = x; }
            *(unsigned*)(mt + (long)n * 768 + k) = cvt_pk_bf16(v[0], v[1]);
        }
        __syncthreads();
    }
}
DI void s5_scan(const Ctx& c, const float* PC, const float* APL, bf16_t* UH) {
    for (int wt = c.gw; wt < NSEQ * 64 * 2; wt += c.ngw) {
        const int dir = wt & 1, g = (wt >> 1) & 63, s = wt >> 7;
        const int c0 = seq_base(s) >> 5, nch = seq_len(s) >> 5;
        const float ar = APL[((g * 2 + dir) * 64 + c.lane) * 2], ai = APL[((g * 2 + dir) * 64 + c.lane) * 2 + 1];
        float sr = 0.f, si = 0.f;
        const float* pc = PC + ((long)g * 2048) * 256 + dir * 128 + c.lane;
        bf16_t* uh = UH + ((long)g * 2048) * 768 + 512 + dir * 128 + c.lane;
        for (int cb = 0; cb < nch; cb += 16) {
            float pr[16], pi[16];
#pragma unroll
            for (int u = 0; u < 16; ++u) { const int ch = dir == 0 ? c0 + cb + u : c0 + nch - 1 - (cb + u); pr[u] = pc[(long)ch * 256]; pi[u] = pc[(long)ch * 256 + 64]; }
#pragma unroll
            for (int u = 0; u < 16; ++u) { const int ch = dir == 0 ? c0 + cb + u : c0 + nch - 1 - (cb + u);
                uh[(long)ch * 768] = (bf16_t)(cvt_pk_bf16(sr, 0.f) & 0xffffu); uh[(long)ch * 768 + 64] = (bf16_t)(cvt_pk_bf16(si, 0.f) & 0xffffu);
                const float nr = ar * sr - ai * si + pr[u], ni = ar * si + ai * sr + pi[u]; sr = nr; si = ni; }
        }
    }
}
constexpr size_t MB = 1024 * 1024;
constexpr size_t WS_CTL = 0;
constexpr int    MAX_LAUNCH = 72;
constexpr size_t CTL_BYTES = 1 * MB;
constexpr size_t WS_XB   = WS_CTL + CTL_BYTES;
constexpr size_t WS_R2   = WS_XB + 128 * MB;
constexpr size_t WS_R1   = WS_R2 + 256 * MB;
constexpr size_t WS_WMIX = WS_R1 + 288 * MB;
constexpr size_t WS_WXQ  = WS_WMIX + 8 * MB;
constexpr size_t WS_WXKV = WS_WXQ + 2 * MB;
constexpr size_t WS_WXO  = WS_WXKV + 4 * MB;
constexpr size_t WS_WGU  = WS_WXO + 2 * MB;
constexpr size_t WS_WD   = WS_WGU + 64 * MB;
constexpr size_t WS_MEMB = WS_WD + 32 * MB;
constexpr size_t WS_MEMKV= WS_MEMB + 6 * MB;
constexpr size_t WS_GT   = WS_MEMKV + 12 * MB;
constexpr size_t WS_HT   = WS_GT + 24 * MB;
constexpr size_t WS_AFFT = WS_HT + 24 * MB;
constexpr size_t WS_IDX  = WS_AFFT + 4 * MB;
constexpr size_t WS_GATE = WS_IDX + 1 * MB;
constexpr size_t WS_INV  = WS_GATE + 1 * MB;
constexpr size_t WS_S5MT = WS_INV + 4 * MB;
constexpr size_t WS_S5PT = WS_S5MT + 48 * MB;
constexpr size_t WS_S5AP = WS_S5PT + 16 * MB;
constexpr size_t WS_S5KK = WS_S5AP + 1 * MB;
constexpr size_t WS_X8   = WS_S5KK + 4 * MB;
constexpr size_t WS_END  = WS_X8 + 64 * MB;

constexpr int LDS_BYTES = 152 * 1024;
constexpr int LDS_MISC = 148 * 1024;

#define XB ((bf16_t*)(wsl + WS_XB))
#define OB ((bf16_t*)(wsl + WS_R2))
#define YE ((bf16_t*)(wsl + WS_R2))
#define PC ((float*)(wsl + WS_R2 + 128 * MB))
#define QKV ((bf16_t*)(wsl + WS_R1))
#define HB ((bf16_t*)(wsl + WS_R1))
#define UH ((bf16_t*)(wsl + WS_R1))
#define WMIX ((bf16_t*)(wsl + WS_WMIX))
#define WXQ ((bf16_t*)(wsl + WS_WXQ))
#define WXKV ((bf16_t*)(wsl + WS_WXKV))
#define WXO ((bf16_t*)(wsl + WS_WXO))
#define WGU ((bf16_t*)(wsl + WS_WGU))
#define WD ((bf16_t*)(wsl + WS_WD))
#define MEMB ((bf16_t*)(wsl + WS_MEMB))
#define MEMKV ((bf16_t*)(wsl + WS_MEMKV))
#define GT ((bf16_t*)(wsl + WS_GT))
#define HT ((bf16_t*)(wsl + WS_HT))
#define AFFT ((float*)(wsl + WS_AFFT))
#define IDX ((int*)(wsl + WS_IDX))
#define GATE ((float*)(wsl + WS_GATE))
#define INV ((int*)(wsl + WS_INV))
#define S5MT ((bf16_t*)(wsl + WS_S5MT))
#define S5PT ((bf16_t*)(wsl + WS_S5PT))
#define S5AP ((float*)(wsl + WS_S5AP))
#define S5KK ((float*)(wsl + WS_S5KK))
#define WMIX2 (WMIX + 2304 * 1024)
#define AQ8 ((unsigned char*)(wsl + WS_R2 + 128 * MB))
#define AK8 ((unsigned char*)(wsl + WS_R2 + 192 * MB))
#define AV8T ((unsigned char*)(wsl + WS_R2 + 208 * MB))
#define X8 ((bf16_t*)(wsl + WS_X8))
#define HSUB ((bf16_t*)(wsl + WS_R1))
DI const float* inp_ld(int k) { unsigned a = (unsigned)(148 * 1024 + 64 + 8 * k); asm volatile("" : "+v"(a));
    const LAS unsigned* t = (const LAS unsigned*)a; const unsigned lo = __builtin_amdgcn_readfirstlane(t[0]), hi = __builtin_amdgcn_readfirstlane(t[1]);
    return (const float*)(const __attribute__((address_space(1))) float*)(((unsigned long long)hi << 32) | lo); }
#define INP(k) inp_ld(k)
struct Params { const float* in[33]; float* out; unsigned char* ws; int ph_lo, ph_hi, li, pad; };

#define IN(k) (lo <= (k) && (k) < hi)
#define SEAM(k) do { if ((k) + 1 < hi) xcd_barrier(bar); } while (0)
#define RELANE() do { int t_ = threadIdx.x; asm volatile("" : "+v"(t_)); c.tid = t_; c.lane = t_ & 63; \
        int g_ = c.G, b_ = c.bid, w_ = c.wave; asm volatile("" : "+s"(g_), "+s"(b_), "+s"(w_)); c.G = g_; c.bid = b_; c.wave = w_; c.gw = b_ * 8 + w_; c.ngw = g_ * 8; } while (0)
template <int li>
DI void layer_body(Ctx& c, LAS unsigned char* lds, unsigned char* ws, float* XF, const XcdBarrier& bar, const int lo0, const int hi0) {
        const int pb = 1 + li * 16;
        int lo = lo0, hi = hi0; asm volatile("" : "+s"(lo), "+s"(hi));
        unsigned char* wsl; { unsigned long long w_ = (unsigned long long)ws; asm volatile("" : "+s"(w_)); wsl = (unsigned char*)(__attribute__((address_space(1))) unsigned char*)w_; }
        const float* lng = INP(5) + (size_t)li * 3 * DM; const float* lnb = INP(6) + (size_t)li * 3 * DM;
        if (IN(pb + 0)) { RELANE();
            TJob j0, j1;
            if (li == 0) { j0 = tjob(INP(7), 1024, 1536, 1536, WMIX, 1024, 0, 3); j1 = tjob(INP(10), 1024, 1024, 1024, WMIX2, 1024, 0, 2); }
            else if (li == 1) { j0 = tjob(INP(11), 1024, 2304, 2304, WMIX, 1024, 0, 3); j1 = tjob(INP(12), 768, 1024, 1024, WMIX2, 768, 0); }
            else if (li == 2) { j0 = tjob(INP(21), 1024, 1024, 2048, WMIX, 1024, 1); j1 = tjob(INP(21) + 1024, 1024, 1024, 2048, WMIX, 1024, 2); }
            else { j0 = tjob(INP(22), 1024, 2304, 2304, WMIX, 1024, 0, 1); j1 = tjob(INP(25), 768, 1024, 1024, WMIX2, 768, 0); }
            const TJob j2 = tjob(INP(27) + (size_t)li * 1024 * 2048, 1024, 2048, 2048, WXKV, 1024, 0), j3 = tjob(INP(28) + (size_t)li * 1024 * 1024, 1024, 1024, 1024, WXO, 1024, 0);
            convert_layer_weights(c, j0, j1, j2, j3, INP(30) + (size_t)li * 16 * 1024 * 1024, INP(31) + (size_t)li * 16 * 1024 * 1024, INP(32) + (size_t)li * 16 * 1024 * 1024, WGU, WD);
            cvt_copy_bf16(c, INP(26) + (size_t)li * 1024 * 1024, WXQ, 1024 * 1024);
            __syncthreads();
            if (li == 2) s5_tables(c, INP(13), INP(14), INP(15), INP(16), INP(17), INP(18), INP(19), S5MT, S5PT, S5AP, S5KK);
            SEAM(pb + 0);
        }
        if (IN(pb + 1)) { RELANE();
            pg8::Sched S = pg8::make_sched_(c.G, c.bid, MEMB, 2048, WXKV, 2048, 12, 8);
            pg8::EpiBf16 E{MEMKV, 0, 0, 2048, nullptr, 0, 0, 0, 1.0f};
            pg8::gemm_phase<pg8::EpiBf16, false>(lds, S, E, 1024, c.tid);
            if (li == 2) s5_fill(c, S5KK, S5MT);
            SEAM(pb + 1);
        }
        if (IN(pb + 2)) { RELANE();
            {
                pg8::Sched S = pg8::make_sched_(c.G, c.bid, MEMKV, 4096, WXQ, 2048, 1, 4);
                S.nb2 = 4; S.total = 12 * 4 * 4; S.aS1 = 256l * 4096; S.aS2 = 512; S.bS1 = 0; S.bS2 = 512;
                pg8::EpiF16 E{GT, 1024l * 1024, 256l * 1024, 1024, nullptr, 0, 0, 1 << 30, 0.0625f * LOG2E};
                pg8::gemm_phase<pg8::EpiF16, false>(lds, S, E, 256, c.tid);
            }
            RELANE();
            {
                pg8::Sched S = pg8::make_sched_(c.G, c.bid, WXO, 2048, MEMKV + 1024, 4096, 4, 1);
                S.nb2 = 4; S.total = 12 * 4 * 4; S.aS1 = 0; S.aS2 = 512; S.bS1 = 256l * 4096; S.bS2 = 512;
                pg8::EpiF8 E{(unsigned char*)HT, 1024l * 1024, 256, 1024, 1.0f / 16.0f};
                pg8::gemm_phase<pg8::EpiF8, false>(lds, S, E, 256, c.tid);
            }
        }
        if (li == 0) {
            if (IN(pb + 3)) { RELANE(); pg8::Sched S = pg8::make_sched_(c.G, c.bid, X8, 1024, WMIX, 1024, 256, 6); pg8::EpiBf16 E{QKV, 0, 0, 1536, nullptr, 0, 0, 0, 1.0f};
                pg8::gemm_phase<pg8::EpiBf16, false, 2>(lds, S, E, 512, c.tid); SEAM(pb + 3); }
            if (IN(pb + 4)) { RELANE(); prep_a(c, QKV, INP(8), INP(9), AQ8, AK8, AV8T); SEAM(pb + 4); }
            if (IN(pb + 5)) { RELANE(); attn_a_phase(c, AQ8, AK8, AV8T, OB); SEAM(pb + 5); }
            if (IN(pb + 6)) { RELANE(); pg8::Sched S = pg8::make_sched_(c.G, c.bid, OB, 1024, WMIX2, 1024, 256, 4); pg8::EpiF8 E{(unsigned char*)HSUB, 0, 0, 1024, 64.0f};
                pg8::gemm_phase<pg8::EpiF8, false, 2>(lds, S, E, 512, c.tid); SEAM(pb + 6); }
        } else if (li == 1) {
            if (IN(pb + 3)) { RELANE(); pg8::Sched S = pg8::make_sched_(c.G, c.bid, X8, 1024, WMIX, 1024, 256, 9); pg8::EpiBf16 E{QKV, 0, 0, 2304, nullptr, 0, 0, 0, 1.0f};
                pg8::gemm_phase<pg8::EpiBf16, false, 2>(lds, S, E, 512, c.tid); SEAM(pb + 3); }
            if (IN(pb + 5)) { RELANE(); attn_b_phase(c, QKV, OB, INP(4)); SEAM(pb + 5); }
            if (IN(pb + 6)) { RELANE(); pg8::Sched S = pg8::make_sched_(c.G, c.bid, OB, 1536, WMIX2, 1536, 256, 4); pg8::EpiF8 E{(unsigned char*)HSUB, 0, 0, 1024, 1.0f / 64.0f};
                pg8::gemm_phase<pg8::EpiF8, false>(lds, S, E, 768, c.tid); SEAM(pb + 6); }
        } else if (li == 2) {
            if (IN(pb + 3)) { RELANE();
                pg8::Sched S = pg8::make_sched_(c.G, c.bid, UH, 1536, S5PT, 1024, 8, 1); S.total = 64 * 8; S.aS1 = 2048l * 1536; S.bS1 = 256l * 1024;
                pg8::EpiF32 E{PC, 2048l * 256, 256};
                pg8::gemm_phase<pg8::EpiF32, false>(lds, S, E, 512, c.tid); SEAM(pb + 3); }
            if (IN(pb + 4)) { RELANE(); s5_scan(c, PC, S5AP, UH); SEAM(pb + 4); }
            if (IN(pb + 5)) { RELANE();
                pg8::Sched S = pg8::make_sched_(c.G, c.bid, UH, 1536, S5MT, 1536, 8, 2); S.total = 64 * 16; S.aS1 = 2048l * 1536; S.bS1 = 512l * 1536;
                pg8::EpiS5Out E{OB, XB, INP(20)};
                pg8::gemm_phase<pg8::EpiS5Out, false>(lds, S, E, 768, c.tid); SEAM(pb + 5); }
            if (IN(pb + 6)) { RELANE(); pg8::Sched S = pg8::make_sched_(c.G, c.bid, OB, 2048, WMIX, 2048, 256, 8); pg8::EpiGluBf16 E{HSUB};
                pg8::gemm_phase<pg8::EpiGluBf16, false>(lds, S, E, 1024, c.tid); SEAM(pb + 6); }
        } else {
            if (IN(pb + 3)) { RELANE(); pg8::Sched S = pg8::make_sched_(c.G, c.bid, XB, 2048, WMIX, 2048, 256, 9); pg8::EpiBf16 E{QKV, 0, 0, 2304, nullptr, 0, 0, 768, 0.17677669529663687f * LOG2E};
                pg8::gemm_phase<pg8::EpiBf16, false, true>(lds, S, E, 1024, c.tid); SEAM(pb + 3); }
            if (IN(pb + 5)) { RELANE(); attn_d_phase(c, QKV, OB, INP(4), INP(23), INP(24), 0.8f - 0.6f * 0.4065696597405991f); SEAM(pb + 5); }
            if (IN(pb + 6)) { RELANE(); pg8::Sched S = pg8::make_sched_(c.G, c.bid, OB, 1536, WMIX2, 1536, 256, 4); pg8::EpiBf16 E{HSUB, 0, 0, 1024, nullptr, 0, 0, 0, 1.0f};
                pg8::gemm_phase<pg8::EpiBf16, false>(lds, S, E, 768, c.tid); SEAM(pb + 6); }
        }
        if (IN(pb + 8)) { RELANE(); ln_phase<(li < 2 ? (8 | 64) : 8)>(c, nullptr, XB, lng, lnb, nullptr, nullptr, nullptr, nullptr, nullptr, nullptr, HSUB); SEAM(pb + 8); }
        if (IN(pb + 9)) { RELANE();
            pg8::Sched S = pg8::make_sched_(c.G, c.bid, XB, 2048, GT, 2048, 256, 4); S.cross = 1; S.bS1 = 1024l * 2048;
            pg8::EpiSoftmax256F8 E{OB};
            pg8::gemm_phase<pg8::EpiSoftmax256F8, false, true>(lds, S, E, 1024, c.tid); SEAM(pb + 9);
        }
        if (IN(pb + 10)) { RELANE();
            pg8::Sched S = pg8::make_sched_(c.G, c.bid, OB, 1024, HT, 1024, 256, 4); S.cross = 1; S.bS1 = 1024l * 1024;
            pg8::EpiF8 E{(unsigned char*)HSUB, 0, 0, 1024, 64.0f};
            pg8::gemm_phase<pg8::EpiF8, false, 2>(lds, S, E, 512, c.tid); SEAM(pb + 10);
        }
        if (IN(pb + 11)) { RELANE();
            ln_phase<10 | 64>(c, nullptr, XB, lng + DM, lnb + DM, nullptr, nullptr, INP(29) + (size_t)li * 1024 * 16, AFFT, INV, X8, HSUB);
            SEAM(pb + 11); }
        if (IN(pb + 12)) { RELANE(); topk_phase(c, AFFT, IDX, GATE, INV); SEAM(pb + 12); }
        if (IN(pb + 13)) { RELANE();
            pg8::Sched S = pg8::make_sched_(c.G, c.bid, X8, 1024, WGU, 1024, 16, 8);
            S.nb2 = 16; S.total = 2 * 16 * 16 * 8; S.aS1 = (long)NGRP_TOK * 1024; S.aS2 = 0; S.bS1 = 0; S.bS2 = 2048l * 1024; S.GI = IDX; S.giS1 = 16 * CAP; S.giS2 = CAP; S.gather = 1;
#if MOE_DOWN_FP8
            pg8::EpiSwiGLU8 E{HB};
            pg8::gemm_phase<pg8::EpiSwiGLU8, true, 2>(lds, S, E, 512, c.tid); SEAM(pb + 13);
#else
            pg8::EpiSwiGLU E{HB};
            pg8::gemm_phase<pg8::EpiSwiGLU, true, 2>(lds, S, E, 512, c.tid); SEAM(pb + 13);
#endif
        }
        if (IN(pb + 14)) { RELANE();
#if MOE_DOWN_FP8
            pg8::Sched S = pg8::make_sched_(c.G, c.bid, HB, 1024, WD, 1024, 16, 4);
            S.nb2 = 16; S.total = 2 * 16 * 16 * 4; S.aS1 = 16l * CAP * 1024; S.aS2 = (long)CAP * 1024; S.bS1 = 0; S.bS2 = 1024l * 1024;
            pg8::EpiF8 E{(unsigned char*)YE, 16l * CAP * 1024, (long)CAP * 1024, 1024, 8.0f};
            pg8::gemm_phase<pg8::EpiF8, false, 2>(lds, S, E, 512, c.tid); SEAM(pb + 14);
#else
            pg8::Sched S = pg8::make_sched_(c.G, c.bid, HB, 2048, WD, 2048, 16, 4);
            S.nb2 = 16; S.total = 2 * 16 * 16 * 4; S.aS1 = 16l * CAP * 2048; S.aS2 = (long)CAP * 2048; S.bS1 = 0; S.bS2 = 1024l * 2048;
            pg8::EpiBf16 E{YE, 16l * CAP * 1024, (long)CAP * 1024, 1024, GATE, 16 * CAP, CAP, 0, 1.0f};
            pg8::gemm_phase<pg8::EpiBf16, false>(lds, S, E, 1024, c.tid); SEAM(pb + 14);
#endif
        }
        if (IN(pb + 15)) { RELANE();
            const float* gsc = MOE_DOWN_FP8 ? GATE : nullptr;
            if (li == 1) ln_phase<5>(c, nullptr, XB, lng + 2 * DM, lnb + 2 * DM, YE, INV, nullptr, nullptr, nullptr, UH, nullptr, gsc);
            else if (li == 3) ln_phase<17>(c, XF, XB, lng + 2 * DM, lnb + 2 * DM, YE, INV, nullptr, nullptr, nullptr, nullptr, nullptr, gsc);
            else if (li == 0) ln_phase<33>(c, nullptr, XB, lng + 2 * DM, lnb + 2 * DM, YE, INV, nullptr, nullptr, nullptr, X8, nullptr, gsc);
            else ln_phase<1>(c, nullptr, XB, lng + 2 * DM, lnb + 2 * DM, YE, INV, nullptr, nullptr, nullptr, nullptr, nullptr, gsc);
            SEAM(pb + 15);
        }
}

__global__ void __launch_bounds__(512, 2) fwd_kernel(Params P) {
    extern __shared__ __attribute__((aligned(16))) unsigned char lds_raw[];
    LAS unsigned char* lds = (LAS unsigned char*)lds_raw;
    Ctx c; c.lds = lds; c.tid = threadIdx.x; c.lane = c.tid & 63; c.wave = __builtin_amdgcn_readfirstlane(c.tid >> 6); c.G = gridDim.x; c.bid = blockIdx.x;
    c.gw = c.bid * 8 + c.wave; c.ngw = c.G * 8;
    volatile LAS unsigned* misc = (volatile LAS unsigned*)(lds + LDS_MISC);
    if (c.tid < 4) misc[c.tid] = 0u;
    if (c.tid < 33) ((LAS unsigned long long*)(lds + LDS_MISC + 64))[c.tid] = (unsigned long long)P.in[c.tid];
    __syncthreads();
    unsigned char* ws = P.ws;
    const int lo0 = P.ph_lo, hi0 = P.ph_hi;
    XcdBarrier bar; bar.bar = (unsigned*)(ws + WS_CTL) + (size_t)P.li * XCD_BAR_WORDS; bar.x = 0; bar.st = misc;
    if (hi0 - lo0 > 1) bar = xcd_barrier_post(bar.bar, misc);
    float* XF = P.out;
    { const int lo = lo0, hi = hi0;
    if (IN(0)) {
        unsigned char* wsl = ws;
        init_x(c, INP(0), INP(1), XB, X8);
        cvt_copy_bf16(c, INP(2), MEMB, (long)2048 * DM);
        cvt_copy_bf16(c, INP(3), MEMB + (long)2048 * DM, (long)1024 * DM);
    } }
    layer_body<0>(c, lds, ws, XF, bar, lo0, hi0); layer_body<1>(c, lds, ws, XF, bar, lo0, hi0); layer_body<2>(c, lds, ws, XF, bar, lo0, hi0); layer_body<3>(c, lds, ws, XF, bar, lo0, hi0);
}

constexpr int N_PHASES = 65;
static bool phase_exists(int k) {
    if (k == 0) return true;
    const int li = (k - 1) / 16, r = (k - 1) % 16;
    if (r == 7) return false;
    if (r == 4) return li == 0 || li == 2;
    return true;
}

#ifndef MK_PER_PHASE
#define MK_PER_PHASE 0
#endif

extern "C" void kernel_launch(void* const* d_in, const int* in_sizes, int n_in, void* d_out, int out_size, void* d_ws, size_t ws_size, hipStream_t stream) {
    static int grid = 0;
    if (grid == 0) {
        if (n_in != 33 || out_size != NTOK * DM || ws_size < WS_END) { fprintf(stderr, "kernel_launch: unexpected shapes (n_in %d out %d ws %zu need %zu)\n", n_in, out_size, ws_size, (size_t)WS_END); grid = -1; return; }
        int dev = 0, cus = 0, per_cu = 0;
        if (hipGetDevice(&dev) != hipSuccess || hipDeviceGetAttribute(&cus, hipDeviceAttributeMultiprocessorCount, dev) != hipSuccess) { grid = -1; return; }
        if (hipFuncSetAttribute((const void*)fwd_kernel, hipFuncAttributeMaxDynamicSharedMemorySize, LDS_BYTES) != hipSuccess) { fprintf(stderr, "kernel_launch: hipFuncSetAttribute failed\n"); grid = -1; return; }
        if (hipOccupancyMaxActiveBlocksPerMultiprocessor(&per_cu, (const void*)fwd_kernel, 512, LDS_BYTES) != hipSuccess || per_cu < 1) { fprintf(stderr, "kernel_launch: occupancy query says %d\n", per_cu); (void)hipGetLastError(); }
        grid = cus;
    }
    if (grid < 0) return;
    (void)hipMemsetAsync((char*)d_ws + WS_CTL, 0, CTL_BYTES, stream);
    Params p{};
    for (int i = 0; i < 33; ++i) p.in[i] = (const float*)d_in[i];
    p.out = (float*)d_out; p.ws = (unsigned char*)d_ws; p.pad = 0;
#if MK_PER_PHASE
    int li = 0;
    for (int k = 0; k < N_PHASES; ++k) { if (!phase_exists(k)) continue; p.ph_lo = k; p.ph_hi = k + 1; p.li = li++;
        hipLaunchKernelGGL(fwd_kernel, dim3(grid), dim3(512), LDS_BYTES, stream, p); }
#else
    p.ph_lo = 0; p.ph_hi = N_PHASES; p.li = 0;
    hipLaunchKernelGGL(fwd_kernel, dim3(grid), dim3(512), LDS_BYTES, stream, p);
#if defined(PROBE_LO)
    p.ph_lo = PROBE_LO; p.ph_hi = PROBE_HI; p.li = 1; p.out = (float*)((unsigned char*)d_ws + WS_R2);
    hipLaunchKernelGGL(fwd_kernel, dim3(grid), dim3(512), LDS_BYTES, stream, p);
#endif
#endif
}
```

```cpp
#include <hip/hip_runtime.h>
#include <stdint.h>
#include <stdio.h>

#define LAS __attribute__((address_space(3)))
#define DI __device__ __forceinline__
typedef unsigned short bf16_t;
typedef short bf16x8 __attribute__((ext_vector_type(8)));
typedef short s16x4 __attribute__((ext_vector_type(4)));
typedef float f32x4 __attribute__((ext_vector_type(4)));
typedef float f32x2 __attribute__((ext_vector_type(2)));
typedef float f32x16 __attribute__((ext_vector_type(16)));
typedef unsigned u32x4 __attribute__((ext_vector_type(4)));
typedef unsigned u32x2 __attribute__((ext_vector_type(2)));

constexpr int DM = 1024;
constexpr int NTOK = 65536;
constexpr int NGRP_TOK = 32768;
constexpr int NSEQ = 12;
constexpr int MEMLEN = 256;
constexpr int NEXP = 16, CAP = 4096;
constexpr float ALPHA = 1.681792830507429f;
constexpr float LN_EPS = 1e-5f;
constexpr float LOG2E = 1.4426950408889634f;

typedef __bf16 bf16x2_t __attribute__((ext_vector_type(2)));
DI unsigned cvt_pk_bf16(float lo, float hi) { const f32x2 f = {lo, hi}; const bf16x2_t v = __builtin_convertvector(f, bf16x2_t); return __builtin_bit_cast(unsigned, v); }
DI float bf2f(unsigned b) { return __uint_as_float(b << 16); }
typedef _Float16 f16x2_t __attribute__((ext_vector_type(2)));
typedef _Float16 f16x8 __attribute__((ext_vector_type(8)));
DI unsigned cvt_pk_f16(float lo, float hi) { const f32x2 f = {lo, hi}; const f16x2_t v = __builtin_convertvector(f, f16x2_t); return __builtin_bit_cast(unsigned, v); }
typedef int i32x8 __attribute__((ext_vector_type(8)));
DI unsigned cvt_pk4_fp8(float a, float b, float c2, float d) { int p_ = __builtin_amdgcn_cvt_pk_fp8_f32(a, b, 0, false); p_ = __builtin_amdgcn_cvt_pk_fp8_f32(c2, d, p_, true); return (unsigned)p_; }
typedef short s16x2_ __attribute__((ext_vector_type(2)));
DI unsigned cvt_pk4_fp8_sc(unsigned old, float a, float b, float c2, float d, float sc) { s16x2_ r = __builtin_bit_cast(s16x2_, old); r = __builtin_amdgcn_cvt_scalef32_pk_fp8_f32(r, a, b, sc, false); r = __builtin_amdgcn_cvt_scalef32_pk_fp8_f32(r, c2, d, sc, true); return __builtin_bit_cast(unsigned, r); }
DI unsigned cvt_pk2_fp8(float a, float b) { return (unsigned)__builtin_amdgcn_cvt_pk_fp8_f32(a, b, 0, false) & 0xffffu; }
#ifndef MOE_DOWN_FP8
#define MOE_DOWN_FP8 1
#endif
constexpr float W8_SCALE = 64.0f;
DI f32x2 unpk_f16(unsigned w) { const f16x2_t h = __builtin_bit_cast(f16x2_t, w); return (f32x2){(float)h[0], (float)h[1]}; }
DI float wave_sum(float v) {
#pragma unroll
    for (int o = 32; o >= 1; o >>= 1) v += __shfl_xor(v, o);
    return v; }
DI float wave_max(float v) {
#pragma unroll
    for (int o = 32; o >= 1; o >>= 1) v = fmaxf(v, __shfl_xor(v, o));
    return v; }
DI float fast_exp2(float x) { return __builtin_amdgcn_exp2f(x); }
DI float fast_rcp(float x) { return __builtin_amdgcn_rcpf(x); }
DI float sigmoidf_(float x) { return fast_rcp(1.0f + fast_exp2(-x * LOG2E)); }
DI float gelu_tanh(float y) { const float u = 0.7978845608028654f * (y + 0.044715f * y * y * y); return y * sigmoidf_(2.0f * u); }
DI int seq_of_row(int n) { return n < NGRP_TOK ? (n >> 12) : 8 + ((n - NGRP_TOK) >> 13); }
DI int seq_len(int s) { return s < 8 ? 4096 : 8192; }
DI int seq_base(int s) { return s < 8 ? s * 4096 : NGRP_TOK + (s - 8) * 8192; }

#define XB_TMO      128
#define XB_XCNT(j)  (256  + 64 * (j))
#define XB_XSUB(j)  (1280 + 64 * (j))
#define XB_XGEN(j)  (2304 + 64 * (j))
#define XB_TOP      3328
#define XB_TOPGEN   3392
#define XCD_BAR_WORDS 3456
#define XB_SPIN_CAP (1u << 20)

DI unsigned xb_ld(unsigned* p)              { return __hip_atomic_load(p, __ATOMIC_RELAXED, __HIP_MEMORY_SCOPE_AGENT); }
DI unsigned xb_add(unsigned* p, unsigned v) { return __hip_atomic_fetch_add(p, v, __ATOMIC_RELAXED, __HIP_MEMORY_SCOPE_AGENT); }
DI unsigned xb_xcc_id() { return (unsigned)__builtin_amdgcn_s_getreg((3 << 11) | 20) & 0xFu; }
#define XB_SPIN(cond, bar) do { unsigned _sp = 0; while (cond) { __builtin_amdgcn_s_sleep(1); \
    if ((++_sp & 255u) == 0u) { if (xb_ld(&(bar)[XB_TMO])) break; if (_sp > XB_SPIN_CAP) { atomicAdd(&(bar)[XB_TMO], 1u); break; } } } } while (0)

struct XcdBarrier { unsigned* bar; unsigned x; volatile LAS unsigned* st; };

DI XcdBarrier xcd_barrier_post(unsigned* bar, volatile LAS unsigned* st) {
    XcdBarrier b; b.bar = bar; b.x = xb_xcc_id(); b.st = st;
    if (threadIdx.x == 0) (void)xb_add(&bar[XB_XCNT(b.x)], 1u);
    return b;
}
DI void xcd_barrier_complete(unsigned* bar, unsigned x, unsigned& nloc, unsigned& nx) {
    const unsigned G = gridDim.x * gridDim.y * gridDim.z;
    unsigned sum, cnt, mine, sp = 0u;
    for (;;) {
        sum = 0u; cnt = 0u; mine = 0u;
#pragma unroll
        for (unsigned j = 0; j < 16; ++j) { const unsigned c = xb_ld(&bar[XB_XCNT(j)]); sum += c; cnt += (c > 0u) ? 1u : 0u; mine = (j == x) ? c : mine; }
        if (sum == G) break;
        __builtin_amdgcn_s_sleep(1);
        if ((++sp & 255u) == 0u) { if (xb_ld(&bar[XB_TMO])) break; if (sp > XB_SPIN_CAP) { atomicAdd(&bar[XB_TMO], 1u); break; } }
    }
    nloc = mine > 0u ? mine : 1u; nx = cnt > 0u ? cnt : 1u;
}
DI void xcd_barrier(const XcdBarrier& b) {
    asm volatile("s_waitcnt vmcnt(0)" ::: "memory");
    __syncthreads();
    if (threadIdx.x == 0) {
        unsigned* bar = b.bar;
        __builtin_amdgcn_s_waitcnt(0);
        unsigned nloc = b.st[0], nx = b.st[1];
        if (nloc == 0u) { xcd_barrier_complete(bar, b.x, nloc, nx); b.st[0] = nloc; b.st[1] = nx; }
        const unsigned old = xb_add(&bar[XB_XSUB(b.x)], 1u);
        const unsigned gen = old / nloc;
        if (old + 1u == (gen + 1u) * nloc) {
            __builtin_amdgcn_fence(__ATOMIC_RELEASE, "agent");
            asm volatile("s_waitcnt vmcnt(0)" ::: "memory");
            const unsigned og = xb_add(&bar[XB_TOP], 1u);
            const unsigned tg = og / nx;
            if (og + 1u == (tg + 1u) * nx) xb_add(&bar[XB_TOPGEN], 1u);
            else XB_SPIN(xb_ld(&bar[XB_TOPGEN]) == tg, bar);
            __builtin_amdgcn_fence(__ATOMIC_ACQUIRE, "agent");
            xb_add(&bar[XB_XGEN(b.x)], 1u);
            asm volatile("s_waitcnt vmcnt(0)" ::: "memory");
        } else {
            XB_SPIN(xb_ld(&bar[XB_XGEN(b.x)]) == gen, bar);
            __builtin_amdgcn_fence(__ATOMIC_ACQUIRE, "agent");
            asm volatile("s_waitcnt vmcnt(0)" ::: "memory");
        }
    }
    __syncthreads();
}
namespace pg8 {
constexpr int BM = 256, BK = 64, HALF = 128, HTB = HALF * BK * 2, STAGE_BYTES = 8 * HTB;

DI int lds_byte(int r, int c) { const int st = (r >> 4) * 2 + (c >> 5), rr = r & 15, cc = c & 31, ob = rr * 64 + cc * 2; return st * 1024 + (ob ^ (((ob >> 9) & 1) << 5)); }
DI void stage_rc(int b, int& R, int& C) { const int st = b / 1024, sb = b % 1024, swz = sb ^ (((sb >> 9) & 1) << 5); R = (st >> 1) * 16 + swz / 64; C = (st & 1) * 32 + (swz % 64) / 2; }
DI int perm32(int rho) { const int n = rho >> 4, i = rho & 15; return 8 * (i >> 2) + 4 * n + (i & 3); }

struct Unit { const char* a; const char* b; const int* gi; int pm, pn, b1, b2; };

DI int cross_batch(int pm) { return pm < 128 ? (pm >> 4) : 8 + ((pm - 128) >> 5); }

struct Sched {
    const char* A; const char* B; const int* GI;
    long aS1, aS2, bS1, bS2; int giS1, giS2;
    unsigned lda, ldb;
    int nb2, nM, nN, total, G, c, cross, gather;
    DI bool next(int i, Unit& u) const {
        const long L = (long)i * G + c; if (L >= total) return false;
        int w = (int)L; { const int q = total / 8, r = total % 8, xcd = w % 8, off = w / 8; w = (xcd < r ? xcd * (q + 1) : r * (q + 1) + (xcd - r) * q) + off; }
        const int per = nM * nN, bz = w / per, l = w % per;
        const int nig = 8 * nN, gid = l / nig, fm = gid * 8, gsz = (nM - fm) < 8 ? (nM - fm) : 8;
        u.pm = fm + ((l % nig) % gsz); u.pn = (l % nig) / gsz;
        u.b1 = bz / nb2; u.b2 = bz % nb2;
        const int bb = cross ? cross_batch(u.pm) : u.b1;
        u.a = A + (long)u.b1 * aS1 + (long)u.b2 * aS2 + (gather ? 0l : (long)u.pm * 256 * lda);
        u.gi = GI + (long)u.b1 * giS1 + (long)u.b2 * giS2 + u.pm * 256;
        u.b = B + (long)bb * bS1 + (long)u.b2 * bS2 + (long)u.pn * 256 * ldb;
        return true;
    }
};
DI Sched make_sched_(int G, int bid, const void* A, unsigned lda, const void* B, unsigned ldb, int nM, int nN) {
    Sched s; s.A = (const char*)A; s.B = (const char*)B; s.GI = nullptr; s.aS1 = s.aS2 = s.bS1 = s.bS2 = 0; s.giS1 = s.giS2 = 0; s.lda = lda; s.ldb = ldb;
    s.nb2 = 1; s.nM = nM; s.nN = nN; s.total = nM * nN; s.G = G; s.c = bid; s.cross = 0; s.gather = 0; return s; }

typedef f32x4 Acc[2][2][4][2];

template <class Epi, bool GATHER, int OPM = 0  >
DI void gemm_phase(LAS unsigned char* lds, const Sched& S, const Epi& E, const int K, const int tid_in) {
    const int tid = tid_in, wid = __builtin_amdgcn_readfirstlane(tid >> 6), lane = tid & 63, wr = wid >> 2, wc = wid & 3, fr = lane & 15, fq = lane >> 4;
    const int nt = K / BK;
    const unsigned lda = S.lda, ldb = S.ldb;
    unsigned voffA[2], voffB[2];
#pragma unroll
    for (int i = 0; i < 2; ++i) { int R, C; stage_rc(tid * 16 + i * 8192, R, C); const int Rb = Epi::PERM ? ((R & ~31) + perm32(R & 31)) : R;
        voffA[i] = (unsigned)R * lda + (unsigned)C * 2u; voffB[i] = (unsigned)Rb * ldb + (unsigned)C * 2u; }
    const unsigned hstepA = 128u * lda, hstepB = 128u * ldb;
    const size_t kstep = (size_t)(BK * 2);
    const unsigned ldsw = (unsigned)wid * 1024u;
    const int aoff = lds_byte(wr * 64 + fr, fq * 8), boff = lds_byte(wc * 32 + fr, fq * 8);
#define PG8_SA(b, h) (((b) * 2 + (h)) * HTB)
#define PG8_SB(b, h) ((4 + (b) * 2 + (h)) * HTB)
#define PG8_GLDS(bufoff, gp, _i) __builtin_amdgcn_global_load_lds((const unsigned*)(gp), (LAS unsigned*)(lds + (bufoff) + ldsw + (_i) * 8192), 16, 0, 0)
#define PG8_STAGE_A(b, h, base, OFF) do { _Pragma("unroll") for (int _i = 0; _i < 2; ++_i) \
        PG8_GLDS(PG8_SA(b, h), (base) + (GATHER ? OFF[h][_i] : (voffA[_i] + (unsigned)(h) * hstepA)), _i); } while (0)
#define PG8_STAGE_B(b, h, base) do { _Pragma("unroll") for (int _i = 0; _i < 2; ++_i) \
        PG8_GLDS(PG8_SB(b, h), (base) + (voffB[_i] + (unsigned)(h) * hstepB), _i); } while (0)
#define PG8_LDA(dst, b, h) do { _Pragma("unroll") for (int m = 0; m < 4; ++m) _Pragma("unroll") for (int k = 0; k < 2; ++k) dst[m][k] = *(const LAS bf16x8*)(lds + PG8_SA(b, h) + aoff + m * 2048 + k * 1024); } while (0)
#define PG8_LDB(dst, b, h) do { _Pragma("unroll") for (int n = 0; n < 2; ++n) _Pragma("unroll") for (int k = 0; k < 2; ++k) dst[n][k] = *(const LAS bf16x8*)(lds + PG8_SB(b, h) + boff + n * 2048 + k * 1024); } while (0)
#define PG8_MMA(ai, bj, At, Bt) do { __builtin_amdgcn_s_setprio(1); \
        if (OPM == 2) { _Pragma("unroll") for (int m = 0; m < 4; ++m) _Pragma("unroll") for (int n = 0; n < 2; ++n) { \
            typedef short s16x16_ __attribute__((ext_vector_type(16))); \
            const i32x8 a8_ = __builtin_bit_cast(i32x8, (s16x16_)__builtin_shufflevector(At[m][0], At[m][1], 0, 1, 2, 3, 4, 5, 6, 7, 8, 9, 10, 11, 12, 13, 14, 15)); \
            const i32x8 b8_ = __builtin_bit_cast(i32x8, (s16x16_)__builtin_shufflevector(Bt[n][0], Bt[n][1], 0, 1, 2, 3, 4, 5, 6, 7, 8, 9, 10, 11, 12, 13, 14, 15)); \
            acc[ai][bj][m][n] = __builtin_amdgcn_mfma_scale_f32_16x16x128_f8f6f4(b8_, a8_, acc[ai][bj][m][n], 0, 0, 0, 127, 0, 127); } } \
        else { _Pragma("unroll") for (int m = 0; m < 4; ++m) _Pragma("unroll") for (int n = 0; n < 2; ++n) _Pragma("unroll") for (int k = 0; k < 2; ++k) \
        acc[ai][bj][m][n] = OPM == 1 ? __builtin_amdgcn_mfma_f32_16x16x32_f16(__builtin_bit_cast(f16x8, Bt[n][k]), __builtin_bit_cast(f16x8, At[m][k]), acc[ai][bj][m][n], 0, 0, 0) \
                                : __builtin_amdgcn_mfma_f32_16x16x32_bf16(Bt[n][k], At[m][k], acc[ai][bj][m][n], 0, 0, 0); } __builtin_amdgcn_s_setprio(0); } while (0)
#define PG8_GOFF(dst, gi_) do { int _t = tid; asm volatile("" : "+v"(_t)); _Pragma("unroll") for (int _i = 0; _i < 2; ++_i) { int _R, _C; stage_rc(_t * 16 + _i * 8192, _R, _C); \
        _Pragma("unroll") for (int _h = 0; _h < 2; ++_h) dst[_h][_i] = (unsigned)(gi_)[_h * 128 + _R] * lda + (unsigned)_C * 2u; } } while (0)
#define PG8_WAIT_V(n) asm volatile("s_waitcnt vmcnt(" #n ")" ::: "memory")
#define PG8_WAIT_L(n) asm volatile("s_waitcnt lgkmcnt(" #n ")" ::: "memory")
#define PG8_BAR __builtin_amdgcn_s_barrier()
#define PG8_SCHED __builtin_amdgcn_sched_barrier(0)
    Unit cur, nxt; int ui = 0;
    if (!S.next(0, cur)) return;
    Acc acc;
#pragma unroll
    for (int a = 0; a < 2; ++a)
#pragma unroll
        for (int b = 0; b < 2; ++b)
#pragma unroll
            for (int m = 0; m < 4; ++m)
#pragma unroll
                for (int n = 0; n < 2; ++n) acc[a][b][m][n] = (f32x4){0.f, 0.f, 0.f, 0.f};
    bf16x8 At[4][2], B0[2][2], B1[2][2];
    unsigned cO[2][2], nO[2][2];
#pragma unroll
    for (int h = 0; h < 2; ++h)
#pragma unroll
        for (int i = 0; i < 2; ++i) { cO[h][i] = 0u; nO[h][i] = 0u; }
    if (GATHER) { PG8_GOFF(cO, cur.gi); }
    const char* cA = cur.a; const char* cB = cur.b;
    PG8_STAGE_B(0, 0, cB); PG8_STAGE_A(0, 0, cA, cO); PG8_STAGE_B(0, 1, cB); PG8_STAGE_A(0, 1, cA, cO);
    if (wr == 1) PG8_BAR;
    PG8_WAIT_V(4); PG8_BAR;
    PG8_STAGE_B(1, 0, cB + kstep); PG8_STAGE_A(1, 0, cA + kstep, cO); PG8_STAGE_B(1, 1, cB + kstep);
    PG8_WAIT_V(6); PG8_BAR;
    for (;;) {
        const bool has_next = S.next(ui + 1, nxt);
        const char* nA = has_next ? nxt.a : cA; const char* nB = has_next ? nxt.b : cB;
        if (GATHER) {
            if (has_next) { PG8_GOFF(nO, nxt.gi); }
        }
        for (int t = 0; t < nt; t += 2) {
            const bool last = (t == nt - 2);
            const char* a1 = cA + (size_t)(t + 1) * kstep;
            const char* a2 = last ? nA : cA + (size_t)(t + 2) * kstep; const char* b2 = last ? nB : cB + (size_t)(t + 2) * kstep;
            const char* a3 = a2 + kstep; const char* b3 = b2 + kstep;
            PG8_LDB(B0, 0, 0); PG8_SCHED; PG8_LDA(At, 0, 0); PG8_STAGE_A(1, 1, a1, cO);
            if (GATHER) { if (last) {
#pragma unroll
                for (int h = 0; h < 2; ++h)
#pragma unroll
                    for (int i = 0; i < 2; ++i) cO[h][i] = nO[h][i]; } }
            PG8_WAIT_L(8); PG8_BAR; PG8_WAIT_L(0); PG8_MMA(0, 0, At, B0); PG8_BAR; PG8_SCHED;
            PG8_LDB(B1, 0, 1); PG8_STAGE_B(0, 0, b2);
            PG8_BAR; PG8_WAIT_L(0); PG8_MMA(0, 1, At, B1); PG8_BAR;
            PG8_LDA(At, 0, 1); PG8_STAGE_A(0, 0, a2, cO);
            PG8_BAR; PG8_WAIT_L(0); PG8_MMA(1, 0, At, B0); PG8_BAR; PG8_SCHED;
            PG8_STAGE_B(0, 1, b2);
            PG8_WAIT_V(6); PG8_BAR; PG8_MMA(1, 1, At, B1); PG8_BAR;
            PG8_LDB(B0, 1, 0); PG8_SCHED; PG8_LDA(At, 1, 0); PG8_STAGE_A(0, 1, a2, cO);
            PG8_WAIT_L(8); PG8_BAR; PG8_WAIT_L(0); PG8_MMA(0, 0, At, B0); PG8_BAR; PG8_SCHED;
            PG8_LDB(B1, 1, 1); PG8_STAGE_B(1, 0, b3);
            PG8_BAR; PG8_WAIT_L(0); PG8_MMA(0, 1, At, B1); PG8_BAR;
            PG8_LDA(At, 1, 1); PG8_STAGE_A(1, 0, a3, cO);
            PG8_BAR; PG8_WAIT_L(0); PG8_MMA(1, 0, At, B0); PG8_BAR; PG8_SCHED;
            PG8_STAGE_B(1, 1, b3);
            PG8_WAIT_V(6); PG8_BAR; PG8_MMA(1, 1, At, B1); PG8_BAR;
        }
        E(acc, cur, wr, wc, fr, fq, lds, ui);
        if (!has_next) break;
#pragma unroll
        for (int a = 0; a < 2; ++a)
#pragma unroll
            for (int b = 0; b < 2; ++b)
#pragma unroll
                for (int m = 0; m < 4; ++m)
#pragma unroll
                    for (int n = 0; n < 2; ++n) acc[a][b][m][n] = (f32x4){0.f, 0.f, 0.f, 0.f};
        cur = nxt; cA = nA; cB = nB; ++ui;
    }
    PG8_WAIT_V(0);
    if (wr == 0) PG8_BAR;
    PG8_BAR;
#undef PG8_SA
#undef PG8_SB
#undef PG8_GLDS
#undef PG8_STAGE_A
#undef PG8_STAGE_B
#undef PG8_LDA
#undef PG8_LDB
#undef PG8_MMA
#undef PG8_GOFF
#undef PG8_WAIT_V
#undef PG8_WAIT_L
#undef PG8_SCHED
}
#define PG8_BAR_ASM asm volatile("s_waitcnt lgkmcnt(0)\n\ts_barrier" ::: "memory")

template <bool F16OUT> struct EpiPk16 {
    static constexpr bool PERM = true;
    bf16_t* O; long oS1, oS2; int ldo; const float* rs; int rsS1, rsS2; int slim; float sval;
    DI void operator()(const Acc& acc, const Unit& u, int wr, int wc, int fr, int fq, LAS unsigned char*, int) const {
        __builtin_amdgcn_sched_barrier(0);
        bf16_t* base = O + u.b1 * oS1 + u.b2 * oS2 + (long)(u.pm * 256 + wr * 64 + fr) * ldo + u.pn * 256 + wc * 32 + 8 * fq;
        const float* rsp = rs ? rs + u.b1 * rsS1 + u.b2 * rsS2 + u.pm * 256 + wr * 64 + fr : nullptr;
#pragma unroll
        for (int ai = 0; ai < 2; ++ai)
#pragma unroll
            for (int m = 0; m < 4; ++m) {
                bf16_t* rowp = base + (long)(ai * HALF + m * 16) * ldo;
                const float rsc = rsp ? rsp[ai * HALF + m * 16] : 1.0f;
#pragma unroll
                for (int bj = 0; bj < 2; ++bj) {
                    const float sc = rsc * ((u.pn * 256 + bj * HALF + wc * 32) < slim ? sval : 1.0f);
                    const f32x4 v0 = acc[ai][bj][m][0] * sc, v1 = acc[ai][bj][m][1] * sc;
                    u32x4 w;
                    if (F16OUT) { w.x = cvt_pk_f16(v0[0], v0[1]); w.y = cvt_pk_f16(v0[2], v0[3]); w.z = cvt_pk_f16(v1[0], v1[1]); w.w = cvt_pk_f16(v1[2], v1[3]); }
                    else { w.x = cvt_pk_bf16(v0[0], v0[1]); w.y = cvt_pk_bf16(v0[2], v0[3]); w.z = cvt_pk_bf16(v1[0], v1[1]); w.w = cvt_pk_bf16(v1[2], v1[3]); }
                    *(u32x4*)(rowp + bj * HALF) = w; } }
    }
};
typedef EpiPk16<false> EpiBf16;
struct EpiF8 {
    static constexpr bool PERM = true;
    unsigned char* O; long oS1, oS2; int ldo; float sc;
    DI void operator()(const Acc& acc, const Unit& u, int wr, int wc, int fr, int fq, LAS unsigned char*, int) const {
        __builtin_amdgcn_sched_barrier(0);
        unsigned char* base = O + u.b1 * oS1 + u.b2 * oS2 + (long)(u.pm * 256 + wr * 64 + fr) * ldo + u.pn * 256 + wc * 32 + 8 * fq;
#pragma unroll
        for (int ai = 0; ai < 2; ++ai)
#pragma unroll
            for (int m = 0; m < 4; ++m) {
                unsigned char* rowp = base + (long)(ai * HALF + m * 16) * ldo;
#pragma unroll
                for (int bj = 0; bj < 2; ++bj) {
                    const f32x4 v0 = acc[ai][bj][m][0], v1 = acc[ai][bj][m][1];
                    u32x2 w; w.x = cvt_pk4_fp8_sc(0u, v0[0], v0[1], v0[2], v0[3], sc); w.y = cvt_pk4_fp8_sc(0u, v1[0], v1[1], v1[2], v1[3], sc);
                    *(u32x2*)(rowp + bj * HALF) = w; } }
    }
};
typedef EpiPk16<true> EpiF16;
struct EpiResid {
    static constexpr bool PERM = false;
    float* X;
    DI void operator()(const Acc& acc, const Unit& u, int wr, int wc, int fr, int fq, LAS unsigned char*, int) const {
        float* base = X + (long)(u.pm * 256 + wr * 64 + fr) * DM + u.pn * 256 + wc * 32 + 4 * fq;
#pragma unroll
        for (int ai = 0; ai < 2; ++ai)
#pragma unroll
            for (int m = 0; m < 4; ++m) { float* rowp = base + (long)(ai * HALF + m * 16) * DM;
#pragma unroll
                for (int bj = 0; bj < 2; ++bj)
#pragma unroll
                    for (int n = 0; n < 2; ++n) { f32x4* p = (f32x4*)(rowp + bj * HALF + n * 16); *p = *p * ALPHA + acc[ai][bj][m][n]; } }
    }
};
struct EpiGluResid {
    static constexpr bool PERM = false;
    float* X;
    DI void operator()(const Acc& acc, const Unit& u, int wr, int wc, int fr, int fq, LAS unsigned char*, int) const {
        float* base = X + (long)(u.pm * 256 + wr * 64 + fr) * DM + u.pn * 128 + wc * 32 + 4 * fq;
#pragma unroll
        for (int ai = 0; ai < 2; ++ai)
#pragma unroll
            for (int m = 0; m < 4; ++m) { float* rowp = base + (long)(ai * HALF + m * 16) * DM;
#pragma unroll
                for (int n = 0; n < 2; ++n) { f32x4* p = (f32x4*)(rowp + n * 16); const f32x4 a = acc[ai][0][m][n], g = acc[ai][1][m][n]; f32x4 x = *p;
#pragma unroll
                    for (int j = 0; j < 4; ++j) x[j] = x[j] * ALPHA + a[j] * sigmoidf_(g[j]);
                    *p = x; } }
    }
};
struct EpiGluBf16 {
    static constexpr bool PERM = true;
    bf16_t* H;
    DI void operator()(const Acc& acc, const Unit& u, int wr, int wc, int fr, int fq, LAS unsigned char*, int) const {
        bf16_t* base = H + (long)(u.pm * 256 + wr * 64 + fr) * DM + u.pn * 128 + wc * 32 + 8 * fq;
#pragma unroll
        for (int ai = 0; ai < 2; ++ai)
#pragma unroll
            for (int m = 0; m < 4; ++m) { bf16_t* rowp = base + (long)(ai * HALF + m * 16) * DM;
                float h[8];
#pragma unroll
                for (int n = 0; n < 2; ++n)
#pragma unroll
                    for (int j = 0; j < 4; ++j) h[n * 4 + j] = acc[ai][0][m][n][j] * sigmoidf_(acc[ai][1][m][n][j]);
                u32x4 w; w.x = cvt_pk_bf16(h[0], h[1]); w.y = cvt_pk_bf16(h[2], h[3]); w.z = cvt_pk_bf16(h[4], h[5]); w.w = cvt_pk_bf16(h[6], h[7]);
                *(u32x4*)rowp = w; }
    }
};
template <bool F8OUT> struct EpiSwiGLU_ {
    static constexpr bool PERM = true;
    bf16_t* H;
    DI void operator()(const Acc& acc, const Unit& u, int wr, int wc, int fr, int fq, LAS unsigned char*, int) const {
        const long row0 = (long)(u.b1 * 16 + u.b2) * CAP + u.pm * 256 + wr * 64 + fr; const int col0 = u.pn * 128 + wc * 32 + 8 * fq;
#pragma unroll
        for (int ai = 0; ai < 2; ++ai)
#pragma unroll
            for (int m = 0; m < 4; ++m) {
                float h[8];
#pragma unroll
                for (int n = 0; n < 2; ++n)
#pragma unroll
                    for (int j = 0; j < 4; ++j) { const float g = acc[ai][0][m][n][j] * (1.0f / W8_SCALE); h[n * 4 + j] = g * sigmoidf_(g) * (acc[ai][1][m][n][j] * (1.0f / W8_SCALE)); }
                const long r = row0 + ai * HALF + m * 16;
                if (F8OUT) { u32x2 w; w.x = cvt_pk4_fp8(h[0], h[1], h[2], h[3]); w.y = cvt_pk4_fp8(h[4], h[5], h[6], h[7]); *(u32x2*)((unsigned char*)H + r * DM + col0) = w; }
                else { u32x4 w; w.x = cvt_pk_bf16(h[0], h[1]); w.y = cvt_pk_bf16(h[2], h[3]); w.z = cvt_pk_bf16(h[4], h[5]); w.w = cvt_pk_bf16(h[6], h[7]); *(u32x4*)(H + r * DM + col0) = w; }
                __builtin_amdgcn_sched_barrier(0); }
    }
};
typedef EpiSwiGLU_<false> EpiSwiGLU;
typedef EpiSwiGLU_<true> EpiSwiGLU8;
struct EpiF32 {
    static constexpr bool PERM = false;
    float* C; long oS1; int ldo;
    DI void operator()(const Acc& acc, const Unit& u, int wr, int wc, int fr, int fq, LAS unsigned char*, int) const {
        float* base = C + u.b1 * oS1 + (long)(u.pm * 256 + wr * 64 + fr) * ldo + u.pn * 256 + wc * 32 + 4 * fq;
#pragma unroll
        for (int ai = 0; ai < 2; ++ai)
#pragma unroll
            for (int m = 0; m < 4; ++m) { float* rowp = base + (long)(ai * HALF + m * 16) * ldo;
#pragma unroll
                for (int bj = 0; bj < 2; ++bj)
#pragma unroll
                    for (int n = 0; n < 2; ++n) *(f32x4*)(rowp + bj * HALF + n * 16) = acc[ai][bj][m][n]; }
    }
};
template <bool F8> struct EpiSoftmax256_ {
    static constexpr bool PERM = true;
    bf16_t* Pm;
    DI void operator()(const Acc& acc, const Unit& u, int wr, int wc, int fr, int fq, LAS unsigned char* lds, int ui) const {
        LAS f32x2* T = (LAS f32x2*)(lds + STAGE_BYTES + (ui & 1) * 8192);
        float mloc[2][4];
#pragma unroll
        for (int ai = 0; ai < 2; ++ai)
#pragma unroll
            for (int m = 0; m < 4; ++m) {
                float mx = -3.0e38f;
#pragma unroll
                for (int bj = 0; bj < 2; ++bj)
#pragma unroll
                    for (int n = 0; n < 2; ++n) { const f32x4 x = acc[ai][bj][m][n]; mx = fmaxf(fmaxf(mx, fmaxf(x[0], x[1])), fmaxf(x[2], x[3])); }
                mx = fmaxf(mx, __shfl_xor(mx, 16)); mx = fmaxf(mx, __shfl_xor(mx, 32));
                float s = 0.f;
#pragma unroll
                for (int bj = 0; bj < 2; ++bj)
#pragma unroll
                    for (int n = 0; n < 2; ++n) { const f32x4 x = acc[ai][bj][m][n]; s += (fast_exp2(x[0] - mx) + fast_exp2(x[1] - mx)) + (fast_exp2(x[2] - mx) + fast_exp2(x[3] - mx)); }
                s += __shfl_xor(s, 16); s += __shfl_xor(s, 32);
                mloc[ai][m] = mx;
                if (fq == 0) T[(ai * HALF + wr * 64 + m * 16 + fr) * 4 + wc] = (f32x2){mx, s};
            }
        PG8_BAR_ASM;
        bf16_t* base = Pm + (long)(u.pm * 256 + wr * 64 + fr) * DM + u.pn * 256 + wc * 32 + 8 * fq;
#pragma unroll
        for (int ai = 0; ai < 2; ++ai)
#pragma unroll
            for (int m = 0; m < 4; ++m) {
                const int row = ai * HALF + wr * 64 + m * 16 + fr;
                const f32x2 t0 = T[row * 4 + 0], t1 = T[row * 4 + 1], t2 = T[row * 4 + 2], t3 = T[row * 4 + 3];
                const float M = fmaxf(fmaxf(t0.x, t1.x), fmaxf(t2.x, t3.x));
                const float Lsum = t0.y * fast_exp2(t0.x - M) + t1.y * fast_exp2(t1.x - M) + t2.y * fast_exp2(t2.x - M) + t3.y * fast_exp2(t3.x - M);
                const float inv = fast_rcp(Lsum) * (F8 ? 256.0f : 1.0f);
                bf16_t* rowp = base + (long)(ai * HALF + m * 16) * DM;
                unsigned char* rowp8 = (unsigned char*)Pm + (long)(u.pm * 256 + row) * DM + u.pn * 256 + wc * 32 + 8 * fq;
#pragma unroll
                for (int bj = 0; bj < 2; ++bj) { const f32x4 x0 = acc[ai][bj][m][0], x1 = acc[ai][bj][m][1]; float p[8];
#pragma unroll
                    for (int j = 0; j < 4; ++j) { p[j] = fast_exp2(x0[j] - M) * inv; p[4 + j] = fast_exp2(x1[j] - M) * inv; }
                    if (F8) { u32x2 w8; w8.x = cvt_pk4_fp8(p[0], p[1], p[2], p[3]); w8.y = cvt_pk4_fp8(p[4], p[5], p[6], p[7]); *(u32x2*)(rowp8 + bj * HALF) = w8; }
                    else { u32x4 w; w.x = cvt_pk_bf16(p[0], p[1]); w.y = cvt_pk_bf16(p[2], p[3]); w.z = cvt_pk_bf16(p[4], p[5]); w.w = cvt_pk_bf16(p[6], p[7]);
                        *(u32x4*)(rowp + bj * HALF) = w; } } }
        (void)mloc;
    }
};
typedef EpiSoftmax256_<false> EpiSoftmax256;
typedef EpiSoftmax256_<true> EpiSoftmax256F8;
struct EpiS5Out {
    static constexpr bool PERM = true;
    bf16_t* Z; const bf16_t* X16; const float* dskip;
    DI void operator()(const Acc& acc, const Unit& u, int wr, int wc, int fr, int fq, LAS unsigned char*, int) const {
        const int g = u.b1;
#pragma unroll
        for (int ai = 0; ai < 2; ++ai)
#pragma unroll
            for (int m = 0; m < 4; ++m) {
                const int chunk = u.pm * 256 + ai * HALF + wr * 64 + m * 16 + fr;
#pragma unroll
                for (int bj = 0; bj < 2; ++bj) {
                    const int col = u.pn * 256 + bj * HALF + wc * 32 + 8 * fq, i = col >> 4, j = col & 15;
                    const long off = (long)(chunk * 32 + i) * DM + g * 16 + j;
                    const u32x4 xw = *(const u32x4*)(X16 + off); const f32x2 x01 = unpk_f16(xw.x), x23 = unpk_f16(xw.y), x45 = unpk_f16(xw.z), x67 = unpk_f16(xw.w);
                    const f32x4 xa = {x01.x, x01.y, x23.x, x23.y}, xb = {x45.x, x45.y, x67.x, x67.y};
                    const f32x4 da = *(const f32x4*)(dskip + g * 16 + j), db = *(const f32x4*)(dskip + g * 16 + j + 4);
                    float y[8];
#pragma unroll
                    for (int q = 0; q < 4; ++q) { y[q] = gelu_tanh(acc[ai][bj][m][0][q] + da[q] * xa[q]); y[4 + q] = gelu_tanh(acc[ai][bj][m][1][q] + db[q] * xb[q]); }
                    u32x4 w; w.x = cvt_pk_bf16(y[0], y[1]); w.y = cvt_pk_bf16(y[2], y[3]); w.z = cvt_pk_bf16(y[4], y[5]); w.w = cvt_pk_bf16(y[6], y[7]);
                    *(u32x4*)(Z + off) = w; } }
    }
};
}
struct Ctx { LAS unsigned char* lds; int tid, lane, wave, G, bid, gw, ngw; };

DI void cvt_copy_bf16(const Ctx& c, const float* src, bf16_t* dst, long n) {
    for (long i = ((long)c.bid * 512 + c.tid) * 4; i < n; i += (long)c.G * 512 * 4) {
        const f32x4 v = *(const f32x4*)(src + i); u32x2 w; w.x = cvt_pk_bf16(v[0], v[1]); w.y = cvt_pk_bf16(v[2], v[3]); *(u32x2*)(dst + i) = w; }
}
DI void init_x(const Ctx& c, const float* xp, const float* xs, bf16_t* X16, bf16_t* X8_) {
    const long half = (long)NGRP_TOK * DM;
    for (long i = ((long)c.bid * 512 + c.tid) * 4; i < 2 * half; i += (long)c.G * 512 * 4) {
        const f32x4 v = i < half ? *(const f32x4*)(xp + i) : *(const f32x4*)(xs + (i - half));
        u32x2 w; w.x = cvt_pk_f16(v[0], v[1]); w.y = cvt_pk_f16(v[2], v[3]); *(u32x2*)(X16 + i) = w;
        *(unsigned*)((unsigned char*)X8_ + i) = cvt_pk4_fp8(v[0], v[1], v[2], v[3]); }
}
DI long il_row(int n, int which) { return (long)(n >> 7) * 256 + which * 128 + (n & 127); }
struct TJob { const float* W; bf16_t* Wt; int tn  , ldw, ldt, mode, nit, f16; };
DI TJob tjob(const float* W, int K, int N, int ldw, bf16_t* Wt, int ldt, int mode, int f16 = 0) { TJob j; j.W = W; j.Wt = Wt; j.tn = N / 256; j.ldw = ldw; j.ldt = ldt; j.mode = mode; j.nit = (K / 64) * (N / 256); j.f16 = f16; return j; }
#define CONV_DECODE(it_, W_, Wt_, ldw_, ldt_, mode_, k0_, n0_, f16_) do { int tn_, r_; \
    if ((it_) < n3) { const bool b0 = (it_) < n0, b1 = (it_) < n1, b2 = (it_) < n2; \
        W_ = b0 ? j0.W : (b1 ? j1.W : (b2 ? j2.W : j3.W)); Wt_ = b0 ? j0.Wt : (b1 ? j1.Wt : (b2 ? j2.Wt : j3.Wt)); \
        tn_ = b0 ? j0.tn : (b1 ? j1.tn : (b2 ? j2.tn : j3.tn)); ldw_ = b0 ? j0.ldw : (b1 ? j1.ldw : (b2 ? j2.ldw : j3.ldw)); \
        ldt_ = b0 ? j0.ldt : (b1 ? j1.ldt : (b2 ? j2.ldt : j3.ldt)); mode_ = b0 ? j0.mode : (b1 ? j1.mode : (b2 ? j2.mode : j3.mode)); \
        r_ = (it_) - (b0 ? 0 : (b1 ? n0 : (b2 ? n1 : n2))); f16_ = b0 ? j0.f16 : (b1 ? j1.f16 : (b2 ? j2.f16 : j3.f16)); \
    } else { const int q_ = (it_) - n3, e_ = q_ / 192, m_ = (q_ % 192) >> 6; r_ = q_ & 63; \
        W_ = (m_ == 0 ? wg : (m_ == 1 ? wu : wd)) + (size_t)e_ * 1024 * 1024; \
        Wt_ = m_ == 2 ? (MOE_DOWN_FP8 ? (bf16_t*)((unsigned char*)WD + (size_t)e_ * 1024 * 1024) : WD + (size_t)e_ * 1024 * 1024) : (bf16_t*)((unsigned char*)WGU + (size_t)e_ * 2048 * 1024); \
        tn_ = 4; ldw_ = 1024; ldt_ = 1024; mode_ = m_ == 2 ? 0 : m_ + 1; f16_ = (m_ == 2 && !MOE_DOWN_FP8) ? 0 : 2; }        \
    k0_ = (r_ / tn_) * 64; n0_ = (r_ % tn_) * 256; } while (0)
DI void convert_layer_weights(const Ctx& c, const TJob& j0, const TJob& j1, const TJob& j2, const TJob& j3, const float* wg, const float* wu, const float* wd, bf16_t* WGU, bf16_t* WD) {
    const int n0 = j0.nit, n1 = n0 + j1.nit, n2 = n1 + j2.nit, n3 = n2 + j3.nit, total = n3 + 16 * 3 * 64;
    LAS float* scr = (LAS float*)c.lds;
    int it = c.bid;
    if (it >= total) return;
    const float* cW; bf16_t* cWt; int cldw, cldt, cmode, ck0, cn0, cf16;
    CONV_DECODE(it, cW, cWt, cldw, cldt, cmode, ck0, cn0, cf16);
    f32x4 a[8];
    { const float* src = cW + (long)(ck0 + c.wave * 8) * cldw + cn0 + c.lane * 4;
#pragma unroll
      for (int i = 0; i < 8; ++i) a[i] = *(const f32x4*)(src + (long)i * cldw); }
    for (;;) {
#pragma unroll
        for (int i = 0; i < 8; ++i) { const int k = c.wave * 8 + i;
#pragma unroll
            for (int q = 0; q < 4; ++q) scr[k * 257 + c.lane * 4 + q] = a[i][q]; }
        __syncthreads();
        const int itn = it + c.G; const bool more = itn < total;
        const float* nW = cW; bf16_t* nWt = cWt; int nldw = cldw, nldt = cldt, nmode = cmode, nk0 = ck0, nn0 = cn0, nf16 = cf16;
        if (more) { CONV_DECODE(itn, nW, nWt, nldw, nldt, nmode, nk0, nn0, nf16);
            const float* src = nW + (long)(nk0 + c.wave * 8) * nldw + nn0 + c.lane * 4;
#pragma unroll
            for (int i = 0; i < 8; ++i) a[i] = *(const f32x4*)(src + (long)i * nldw); }
        const int sub = c.lane >> 5, kk = (c.lane & 31) * 2;
#pragma unroll 4
        for (int j = 0; j < 16; ++j) { const int n = c.wave * 32 + 2 * j + sub;
            const float v0 = scr[kk * 257 + n], v1 = scr[(kk + 1) * 257 + n];
            const long orow = cmode == 0 ? (long)(cn0 + n) : il_row(cn0 + n, cmode - 1);
            if (cf16 >= 2) { const float ws_ = cf16 == 2 ? W8_SCALE : 1.0f; *(unsigned short*)((unsigned char*)cWt + orow * cldt + ck0 + kk) = (unsigned short)cvt_pk2_fp8(v0 * ws_, v1 * ws_); continue; }
            *(unsigned*)(cWt + orow * cldt + ck0 + kk) = cf16 ? cvt_pk_f16(v0, v1) : cvt_pk_bf16(v0, v1); }
        __syncthreads();
        if (!more) break;
        it = itn; cW = nW; cWt = nWt; cldw = nldw; cldt = nldt; cmode = nmode; ck0 = nk0; cn0 = nn0; cf16 = nf16;
    }
}
#undef CONV_DECODE

template <int MODE>
DI void ln_phase(const Ctx& c, float* OUTF, bf16_t* X16, const float* g, const float* b,
                 const bf16_t* YE, const int* INV_in, const float* wr_lds_src  , float* AFFT, int* INV_out, bf16_t* UH, const bf16_t* HB_in = nullptr, const float* GATE_in = nullptr) {
    LAS float* wT = (LAS float*)c.lds;
    if (MODE & 2) {
        for (int i = c.tid; i < 16 * 1024; i += 512) { const int cc = i >> 4, e = i & 15; wT[e * 1024 + cc] = wr_lds_src[i]; }
        __syncthreads();
    }
    f32x4 gv[4], bv[4];
#pragma unroll
    for (int j = 0; j < 4; ++j) { gv[j] = *(const f32x4*)(g + j * 256 + c.lane * 4); bv[j] = *(const f32x4*)(b + j * 256 + c.lane * 4); }
    f32x4 vprev[4]; int rowprev = 0, itn = 0;
#pragma unroll
    for (int j = 0; j < 4; ++j) vprev[j] = (f32x4){0.f, 0.f, 0.f, 0.f};
    for (int row = c.gw; row < NTOK; row += c.ngw, ++itn) {
        bf16_t* xr = X16 + (long)row * DM + c.lane * 4;
        f32x4 v[4];
#pragma unroll
        for (int j = 0; j < 4; ++j) { const u32x2 w = *(const u32x2*)(xr + j * 256); const f32x2 a = unpk_f16(w.x), bq = unpk_f16(w.y); v[j] = (f32x4){a.x, a.y, bq.x, bq.y}; }
        if ((MODE & 8) && (MODE & 64)) {
            const unsigned char* hr = (const unsigned char*)HB_in + (long)row * DM + c.lane * 4;
#pragma unroll
            for (int j = 0; j < 4; ++j) { const unsigned w = *(const unsigned*)(hr + j * 256);
                const f32x2 lo = __builtin_amdgcn_cvt_pk_f32_fp8((int)w, false), hi2 = __builtin_amdgcn_cvt_pk_f32_fp8((int)w, true);
                v[j][0] = v[j][0] * ALPHA + lo[0] * (1.0f / 64.0f); v[j][1] = v[j][1] * ALPHA + lo[1] * (1.0f / 64.0f); v[j][2] = v[j][2] * ALPHA + hi2[0] * (1.0f / 64.0f); v[j][3] = v[j][3] * ALPHA + hi2[1] * (1.0f / 64.0f); }
        } else if (MODE & 8) {
            const bf16_t* hr = HB_in + (long)row * DM + c.lane * 4;
#pragma unroll
            for (int j = 0; j < 4; ++j) { const u32x2 w = *(const u32x2*)(hr + j * 256);
                v[j][0] = v[j][0] * ALPHA + bf2f(w.x & 0xffffu); v[j][1] = v[j][1] * ALPHA + bf2f(w.x >> 16); v[j][2] = v[j][2] * ALPHA + bf2f(w.y & 0xffffu); v[j][3] = v[j][3] * ALPHA + bf2f(w.y >> 16); }
        }
        if (MODE & 1) {
#pragma unroll
            for (int j = 0; j < 4; ++j) v[j] = v[j] * ALPHA;
            const int grp = row >> 15;
            const int myp = c.lane < 16 ? INV_in[(long)row * 16 + c.lane] : -1;
            unsigned long long msk = __ballot(myp >= 0);
            while (msk) {
                int pos[4]; bool ok[4]; float gt[4];
#pragma unroll
                for (int q = 0; q < 4; ++q) { ok[q] = msk != 0ull; const int e = ok[q] ? __builtin_ctzll(msk) : 0; msk &= msk - 1ull; const int pz = __builtin_amdgcn_readlane(myp, e); pos[q] = ok[q] ? ((grp * 16 + e) * CAP + pz) : 0;
                    gt[q] = GATE_in ? GATE_in[pos[q]] * 0.125f : 1.0f; }
                unsigned w[4][4];
#pragma unroll
                for (int q = 0; q < 4; ++q) if (ok[q]) { const unsigned char* yr = (const unsigned char*)YE + (long)pos[q] * DM + c.lane * 4;
#pragma unroll
                    for (int j = 0; j < 4; ++j) w[q][j] = *(const unsigned*)(yr + j * 256); }
#pragma unroll
                for (int q = 0; q < 4; ++q) if (ok[q]) {
#pragma unroll
                    for (int j = 0; j < 4; ++j) { const f32x2 lo = __builtin_amdgcn_cvt_pk_f32_fp8((int)w[q][j], false), hi2 = __builtin_amdgcn_cvt_pk_f32_fp8((int)w[q][j], true);
                        v[j][0] += gt[q] * lo[0]; v[j][1] += gt[q] * lo[1]; v[j][2] += gt[q] * hi2[0]; v[j][3] += gt[q] * hi2[1]; } }
            }
        }
        float s = 0.f;
#pragma unroll
        for (int j = 0; j < 4; ++j) s += (v[j][0] + v[j][1]) + (v[j][2] + v[j][3]);
        const float mean = wave_sum(s) * (1.0f / DM);
        float q = 0.f;
#pragma unroll
        for (int j = 0; j < 4; ++j) { const f32x4 d = v[j] - mean; q += (d[0] * d[0] + d[1] * d[1]) + (d[2] * d[2] + d[3] * d[3]); }
        const float rstd = rsqrtf(wave_sum(q) * (1.0f / DM) + LN_EPS);
#pragma unroll
        for (int j = 0; j < 4; ++j) { v[j] = (v[j] - mean) * rstd * gv[j] + bv[j]; if (MODE & 16) *(f32x4*)(OUTF + (long)row * DM + c.lane * 4 + j * 256) = v[j]; }
#pragma unroll
        for (int j = 0; j < 4; ++j) { u32x2 w; w.x = cvt_pk_f16(v[j][0], v[j][1]); w.y = cvt_pk_f16(v[j][2], v[j][3]); if (!(MODE & 16)) *(u32x2*)(xr + j * 256) = w;
            if (MODE & (2 | 32)) *(unsigned*)((unsigned char*)UH + (long)row * DM + c.lane * 4 + j * 256) = cvt_pk4_fp8(v[j][0], v[j][1], v[j][2], v[j][3]);
            if (MODE & 4) { const int gi = j * 16 + (c.lane >> 2);
                u32x2 wb; wb.x = cvt_pk_bf16(v[j][0], v[j][1]); wb.y = cvt_pk_bf16(v[j][2], v[j][3]);
                *(u32x2*)(UH + ((long)gi * 2048 + (row >> 5)) * 768 + (row & 31) * 16 + (c.lane & 3) * 4) = wb; } }
        if ((MODE & 2) && !(itn & 1)) {
#pragma unroll
            for (int j = 0; j < 4; ++j) vprev[j] = v[j];
            rowprev = row;
        }
        if ((MODE & 2) && (itn & 1)) {
            float pe2[2][16];
            f32x2 xy[4][4];
#pragma unroll
            for (int j = 0; j < 4; ++j)
#pragma unroll
                for (int k = 0; k < 4; ++k) xy[j][k] = (f32x2){vprev[j][k], v[j][k]};
#pragma unroll
            for (int e = 0; e < 16; ++e) { f32x2 a = {0.f, 0.f};
#pragma unroll
                for (int j = 0; j < 4; ++j) { const f32x4 w = *(const LAS f32x4*)(wT + e * 1024 + j * 256 + c.lane * 4);
#pragma unroll
                    for (int k = 0; k < 4; ++k) a = xy[j][k] * (f32x2){w[k], w[k]} + a; }
                pe2[0][e] = a.x; pe2[1][e] = a.y; if (e & 1) __builtin_amdgcn_sched_barrier(0); }
#pragma unroll
            for (int hh = 0; hh < 2; ++hh) { const int rrow = hh == 0 ? rowprev : row;
            float pe[16];
#pragma unroll
            for (int e = 0; e < 16; ++e) pe[e] = pe2[hh][e];
            float q8[8], q4[4], q2[2], q1;
            { const bool up = (c.lane & 32) != 0;
#pragma unroll
              for (int k = 0; k < 8; ++k) { const float keep = up ? pe[k + 8] : pe[k], give = up ? pe[k] : pe[k + 8]; q8[k] = keep + __shfl_xor(give, 32); } }
            { const bool up = (c.lane & 16) != 0;
#pragma unroll
              for (int k = 0; k < 4; ++k) { const float keep = up ? q8[k + 4] : q8[k], give = up ? q8[k] : q8[k + 4]; q4[k] = keep + __shfl_xor(give, 16); } }
            { const bool up = (c.lane & 8) != 0;
#pragma unroll
              for (int k = 0; k < 2; ++k) { const float keep = up ? q4[k + 2] : q4[k], give = up ? q4[k] : q4[k + 2]; q2[k] = keep + __shfl_xor(give, 8); } }
            { const bool up = (c.lane & 4) != 0; const float keep = up ? q2[1] : q2[0], give = up ? q2[0] : q2[1]; q1 = keep + __shfl_xor(give, 4); }
            q1 += __shfl_xor(q1, 2); q1 += __shfl_xor(q1, 1);
            float mx = q1;
#pragma unroll
            for (int o = 32; o >= 4; o >>= 1) mx = fmaxf(mx, __shfl_xor(mx, o));
            const float ex = __expf(q1 - mx);
            float den = ex;
#pragma unroll
            for (int o = 32; o >= 4; o >>= 1) den += __shfl_xor(den, o);
            if ((c.lane & 3) == 0) { const int e = c.lane >> 2;
                AFFT[((long)(rrow >> 15) * 16 + e) * NGRP_TOK + (rrow & (NGRP_TOK - 1))] = ex / den; INV_out[(long)rrow * 16 + e] = -1; }
            }
        }
    }
    if (MODE & 2) __syncthreads();
}

DI void topk_phase(const Ctx& c, const float* AFFT, int* IDX, float* GATE, int* INV) {
    LAS unsigned* hist = (LAS unsigned*)c.lds;
    LAS unsigned* sel = hist + 8192;
    LAS unsigned* wsum = hist + 8196;
    for (int prob = c.bid; prob < 2 * NEXP; prob += c.G) {
        const unsigned* a = (const unsigned*)(AFFT + (long)prob * NGRP_TOK + c.tid * 64);
        unsigned prefix = 0u, mask = 0u; unsigned krem = CAP;
#pragma unroll 1
        for (int pass = 0; pass < 4; ++pass) {
            const int shift = 24 - 8 * pass;
            for (int i = c.tid; i < 8192; i += 512) hist[i] = 0u;
            __syncthreads();
#pragma unroll 2
            for (int i = 0; i < 16; ++i) { const u32x4 v = *(const u32x4*)(a + i * 4);
#pragma unroll
                for (int q = 0; q < 4; ++q) if ((v[q] & mask) == prefix) __hip_atomic_fetch_add(&hist[(((v[q] >> shift) & 255u) << 5) | (c.lane & 31)], 1u, __ATOMIC_RELAXED, __HIP_MEMORY_SCOPE_WORKGROUP); }
            __syncthreads();
            if (c.tid < 256) { unsigned t_ = 0u;
#pragma unroll 8
                for (int r = 0; r < 32; ++r) t_ += hist[(c.tid << 5) | ((r + c.tid) & 31)];
                sel[16 + c.tid] = t_; }
            __syncthreads();
            if (c.wave == 0) {
                const unsigned c0 = sel[16 + 4 * c.lane], c1 = sel[16 + 4 * c.lane + 1], c2 = sel[16 + 4 * c.lane + 2], c3 = sel[16 + 4 * c.lane + 3];
                const unsigned s = c0 + c1 + c2 + c3;
                unsigned suf = s;
#pragma unroll
                for (int o = 1; o < 64; o <<= 1) { const unsigned t = __shfl_down(suf, o); if (c.lane + o < 64) suf += t; }
                unsigned above = suf - s;
                if (above < krem && krem <= above + c3) { sel[0] = 4 * c.lane + 3; sel[1] = krem - above; } above += c3;
                if (above < krem && krem <= above + c2) { sel[0] = 4 * c.lane + 2; sel[1] = krem - above; } above += c2;
                if (above < krem && krem <= above + c1) { sel[0] = 4 * c.lane + 1; sel[1] = krem - above; } above += c1;
                if (above < krem && krem <= above + c0) { sel[0] = 4 * c.lane + 0; sel[1] = krem - above; }
            }
            __syncthreads();
            prefix |= sel[0] << shift; mask |= 255u << shift; krem = sel[1];
            __syncthreads();
        }
        unsigned cg = 0u, ce = 0u;
#pragma unroll 2
        for (int i = 0; i < 16; ++i) { const u32x4 v = *(const u32x4*)(a + i * 4);
#pragma unroll
            for (int q = 0; q < 4; ++q) { cg += v[q] > prefix ? 1u : 0u; ce += v[q] == prefix ? 1u : 0u; } }
        const unsigned pk = cg | (ce << 16); unsigned inc = pk;
#pragma unroll
        for (int o = 1; o < 64; o <<= 1) { const unsigned t = __shfl_up(inc, o); if (c.lane >= o) inc += t; }
        if (c.lane == 63) wsum[c.wave] = inc;
        __syncthreads();
        unsigned wbase = 0u;
        for (int w = 0; w < c.wave; ++w) wbase += wsum[w];
        const unsigned exc = wbase + inc - pk;
        unsigned pg = exc & 0xffffu, pe = exc >> 16;
        const unsigned ngt = CAP - krem;
        int* idx = IDX + (long)prob * CAP; float* gate = GATE + (long)prob * CAP;
        const int grp = prob >> 4, e = prob & 15;
#pragma unroll 1
        for (int i = 0; i < 16; ++i) { const u32x4 v = *(const u32x4*)(a + i * 4);
#pragma unroll
            for (int q = 0; q < 4; ++q) {
                int pos = -1;
                if (v[q] > prefix) pos = (int)(pg++);
                else if (v[q] == prefix) { if (pe < krem) pos = (int)(ngt + pe); ++pe; }
                if (pos >= 0) { const int n = c.tid * 64 + i * 4 + q; idx[pos] = n; gate[pos] = __uint_as_float(v[q]); INV[((long)grp * NGRP_TOK + n) * 16 + e] = pos; }
            } }
        __syncthreads();
    }
}

DI void prep_a(const Ctx& c, const bf16_t* QKV, const float* qgain, const float* kgain, unsigned char* Q8, unsigned char* K8, unsigned char* V8T) {
    LAS float* CS = (LAS float*)c.lds;
    for (int i = c.tid; i < 2048; i += 512) { const int pos = i >> 4, j = i & 15; float sn, cs; sincosf((float)pos * exp2f(-(float)j * (13.287712379549449f / 16.0f)), &sn, &cs); CS[i] = cs; CS[2048 + i] = sn; }
    __syncthreads();
    const int hl = c.lane >> 3, half = (c.lane >> 2) & 1, jq = c.lane & 3;
    const int d1 = half * 32 + jq * 4;
    const long nitem = (long)NTOK * 5 / 2;
    for (long it = c.gw; it < nitem; it += c.ngw) {
        const long hg = it * 8 + hl;
        const int row = (int)(hg / 20), hd = (int)(hg % 20);
        const int s = seq_of_row(row), t = row - seq_base(s);
        const int pos = half == 0 ? (t >> 6) : (t & 63);
        const bf16_t* p = QKV + (long)row * 1536 + hd * 64 + d1;
        const u32x2 a = *(const u32x2*)p, b = *(const u32x2*)(p + 16);
        float x1[4] = {bf2f(a.x & 0xffffu), bf2f(a.x >> 16), bf2f(a.y & 0xffffu), bf2f(a.y >> 16)}, x2[4] = {bf2f(b.x & 0xffffu), bf2f(b.x >> 16), bf2f(b.y & 0xffffu), bf2f(b.y >> 16)};
        float ss = 0.f;
#pragma unroll
        for (int q = 0; q < 4; ++q) ss += x1[q] * x1[q] + x2[q] * x2[q];
        ss += __shfl_xor(ss, 1); ss += __shfl_xor(ss, 2); ss += __shfl_xor(ss, 4);
        const float rinv = rsqrtf(ss * (1.0f / 64.0f) + 1e-6f) * (hd < 16 ? 0.125f * LOG2E : 1.0f);
        const float* gn = (hd < 16 ? qgain : kgain) + d1;
        const f32x4 g1 = *(const f32x4*)gn, g2 = *(const f32x4*)(gn + 16);
        const f32x4 cs = *(const LAS f32x4*)(CS + pos * 16 + jq * 4), sn = *(const LAS f32x4*)(CS + 2048 + pos * 16 + jq * 4);
        float o1[4], o2[4];
#pragma unroll
        for (int q = 0; q < 4; ++q) { const float y1 = x1[q] * rinv * g1[q], y2 = x2[q] * rinv * g2[q]; o1[q] = y1 * cs[q] - y2 * sn[q]; o2[q] = y1 * sn[q] + y2 * cs[q]; }
        unsigned char* o8 = hd < 16 ? Q8 + (long)row * 1024 + hd * 64 + d1 : K8 + (long)row * 256 + (hd - 16) * 64 + d1;
        *(unsigned*)o8 = cvt_pk4_fp8(o1[0], o1[1], o1[2], o1[3]); *(unsigned*)(o8 + 16) = cvt_pk4_fp8(o2[0], o2[1], o2[2], o2[3]);
    }
    for (int it = c.gw; it < (NTOK / 64) * 4; it += c.ngw) {
        const int tile = it >> 2, kh = it & 3, row = tile * 64 + c.lane;
        const int sq = seq_of_row(row); const long rb = seq_base(sq); const int S = seq_len(sq), tl = (int)(tile * 64 - rb);
        const int k = c.lane, w = k & 31, pos = ((w >> 2) & 1) * 32 + (k >> 5) * 16 + (w >> 3) * 4 + (w & 3);
        const bf16_t* vp = QKV + (long)row * 1536 + 1280 + kh * 64;
        unsigned char* dst = V8T + rb * 256 + (long)(kh * 64) * S + tl + pos;
#pragma unroll
        for (int q = 0; q < 8; ++q) { const u32x4 v = *(const u32x4*)(vp + q * 8);
            const unsigned p0 = cvt_pk4_fp8(bf2f(v.x & 0xffffu), bf2f(v.x >> 16), bf2f(v.y & 0xffffu), bf2f(v.y >> 16)), p1 = cvt_pk4_fp8(bf2f(v.z & 0xffffu), bf2f(v.z >> 16), bf2f(v.w & 0xffffu), bf2f(v.w >> 16));
#pragma unroll
            for (int e = 0; e < 4; ++e) { dst[(long)(q * 8 + e) * S] = (unsigned char)(p0 >> (8 * e)); dst[(long)(q * 8 + 4 + e) * S] = (unsigned char)(p1 >> (8 * e)); } }
    }
    __syncthreads();
}
#define MFMA32(a, b, c) __builtin_amdgcn_mfma_f32_32x32x16_bf16((a), (b), (c), 0, 0, 0)
typedef short v4i16_t __attribute__((ext_vector_type(4)));
constexpr int KST = 144;
DI s16x4 vtr(const LAS char* p) { return __builtin_bit_cast(s16x4, __builtin_amdgcn_ds_read_tr16_b64_v4i16((LAS v4i16_t*)p)); }
DI bf16x8 pack8(const f32x16& p, int s) {
    u32x4 w; w.x = cvt_pk_bf16(p[8 * s], p[8 * s + 1]); w.y = cvt_pk_bf16(p[8 * s + 2], p[8 * s + 3]); w.z = cvt_pk_bf16(p[8 * s + 4], p[8 * s + 5]); w.w = cvt_pk_bf16(p[8 * s + 6], p[8 * s + 7]);
    return __builtin_bit_cast(bf16x8, w); }
DI float max16(const f32x16& s) {
    float a = fmaxf(fmaxf(s[0], s[1]), fmaxf(s[2], s[3])), b = fmaxf(fmaxf(s[4], s[5]), fmaxf(s[6], s[7]));
    float cc = fmaxf(fmaxf(s[8], s[9]), fmaxf(s[10], s[11])), d = fmaxf(fmaxf(s[12], s[13]), fmaxf(s[14], s[15]));
    return fmaxf(fmaxf(a, b), fmaxf(cc, d)); }
DI float sum16(const f32x16& s) {
    return ((s[0] + s[1]) + (s[2] + s[3])) + ((s[4] + s[5]) + (s[6] + s[7])) + ((s[8] + s[9]) + (s[10] + s[11])) + ((s[12] + s[13]) + (s[14] + s[15])); }
DI f32x16 zero16() { f32x16 z;
#pragma unroll
    for (int i = 0; i < 16; ++i) z[i] = 0.f;
    return z; }
DI void pv_block(const LAS char* Vt, const f32x16& p, f32x16& O0, f32x16& O1, int lane) {
    const int hi = lane >> 5, blk = (lane >> 4) & 1, q4 = (lane & 15) >> 2, pp = lane & 3;
#pragma unroll
    for (int s = 0; s < 2; ++s) {
        const bf16x8 pf = pack8(p, s);
        const LAS char* r0 = Vt + (16 * s + 4 * hi + q4) * KST + 32 * blk + 8 * pp;
        const s16x4 a0 = vtr(r0), a1 = vtr(r0 + 8 * KST), b0 = vtr(r0 + 64), b1 = vtr(r0 + 8 * KST + 64);
        const bf16x8 v0 = __builtin_shufflevector(a0, a1, 0, 1, 2, 3, 4, 5, 6, 7), v1 = __builtin_shufflevector(b0, b1, 0, 1, 2, 3, 4, 5, 6, 7);
        O0 = MFMA32(v0, pf, O0); O1 = MFMA32(v1, pf, O1);
    }
}
constexpr float ATT_THR = 8.0f;
#define LDS_BARRIER() asm volatile("s_waitcnt lgkmcnt(0)\n\ts_barrier" ::: "memory")
#define MX3(a, b, c) __builtin_fmaxf(__builtin_fmaxf((a), (b)), (c))
DI float rowmax32x(const f32x16& p0, const f32x16& p1) {
    float a = MX3(p0[0], p0[1], p1[0]), b = MX3(p0[2], p0[3], p1[1]); a = MX3(a, p1[2], p1[3]);
#pragma unroll
    for (int r = 4; r < 16; r += 4) { a = MX3(a, p0[r], p0[r + 1]); b = MX3(b, p0[r + 2], p0[r + 3]); a = MX3(a, p1[r], p1[r + 1]); b = MX3(b, p1[r + 2], p1[r + 3]); }
    const float mm = __builtin_fmaxf(a, b);
    const auto rr = __builtin_amdgcn_permlane32_swap(__float_as_uint(mm), __float_as_uint(mm), false, false);
    return __builtin_fmaxf(__uint_as_float(rr[0]), __uint_as_float(rr[1])); }
DI float make_qx(float m, int hi, bf16x8& qx) {
    const unsigned h = cvt_pk_bf16(-m, 0.f) & 0xffffu; const float hf = bf2f(h);
    const unsigned lo = cvt_pk_bf16(-m - hf, 0.f) & 0xffffu; const float lf = bf2f(lo);
    u32x4 w; w.x = hi == 0 ? (h | (lo << 16)) : 0u; w.y = 0u; w.z = 0u; w.w = 0u; qx = __builtin_bit_cast(bf16x8, w);
    return -(hf + lf); }
DI void qk_tile_x(const LAS char* Klane, const bf16x8 (&qf)[4], const bf16x8& kx, const bf16x8& qx, f32x16& s0, f32x16& s1) {
    s0 = MFMA32(kx, qx, zero16()); s1 = MFMA32(kx, qx, zero16());
#pragma unroll
    for (int ks = 0; ks < 4; ++ks) {
        const bf16x8 k0 = *(const LAS bf16x8*)(Klane + ks * 32), k1 = *(const LAS bf16x8*)(Klane + 32 * KST + ks * 32);
        s0 = MFMA32(k0, qf[ks], s0); s1 = MFMA32(k1, qf[ks], s1); }
}
DI void exp_pack_x(f32x16& s0, f32x16& s1, bf16x8 (&pf)[4]) {
#pragma unroll
    for (int r = 0; r < 16; ++r) { s0[r] = fast_exp2(s0[r]); s1[r] = fast_exp2(s1[r]); }
    pf[0] = pack8(s0, 0); pf[1] = pack8(s0, 1); pf[2] = pack8(s1, 0); pf[3] = pack8(s1, 1);
}
DI void pv_tile_x(const LAS char* Vlane, const bf16x8 (&pf)[4], const bf16x8& ones, f32x16& O0, f32x16& O1, f32x16& Ls) {
#pragma unroll
    for (int ks = 0; ks < 4; ++ks) {
        const LAS char* r0 = Vlane + 16 * ks * KST;
        const s16x4 a0 = vtr(r0), a1 = vtr(r0 + 8 * KST), b0 = vtr(r0 + 64), b1 = vtr(r0 + 8 * KST + 64);
        const bf16x8 v0 = __builtin_shufflevector(a0, a1, 0, 1, 2, 3, 4, 5, 6, 7), v1 = __builtin_shufflevector(b0, b1, 0, 1, 2, 3, 4, 5, 6, 7);
        O0 = MFMA32(v0, pf[ks], O0); O1 = MFMA32(v1, pf[ks], O1); Ls = MFMA32(ones, pf[ks], Ls);
    }
}
DI void pv_tile(const LAS char* Vt, const bf16x8 (&pf)[4], f32x16& O0, f32x16& O1, int lane) {
    const int hi = lane >> 5, blk = (lane >> 4) & 1, q4 = (lane & 15) >> 2, pp = lane & 3;
#pragma unroll
    for (int ks = 0; ks < 4; ++ks) {
        const LAS char* r0 = Vt + (16 * ks + 4 * hi + q4) * KST + 32 * blk + 8 * pp;
        const s16x4 a0 = vtr(r0), a1 = vtr(r0 + 8 * KST), b0 = vtr(r0 + 64), b1 = vtr(r0 + 8 * KST + 64);
        const bf16x8 v0 = __builtin_shufflevector(a0, a1, 0, 1, 2, 3, 4, 5, 6, 7), v1 = __builtin_shufflevector(b0, b1, 0, 1, 2, 3, 4, 5, 6, 7);
        O0 = MFMA32(v0, pf[ks], O0); O1 = MFMA32(v1, pf[ks], O1);
    }
}
#define MFMA_ACC(acc, a, b) acc = MFMA32(a, b, acc)
constexpr int KST8 = 80;
constexpr float A8_TGT = 6.0f, A8_HI = 8.0f;
#define MFMA8(a, b, c) __builtin_amdgcn_mfma_scale_f32_32x32x64_f8f6f4((a), (b), (c), 0, 0, 0, 127, 0, 127)
DI i32x8 cat8(const u32x4& lo, const u32x4& hi) { return __builtin_bit_cast(i32x8, __builtin_shufflevector(lo, hi, 0, 1, 2, 3, 4, 5, 6, 7)); }
DI void attn_a_phase(const Ctx& c, const unsigned char* Q8, const unsigned char* K8, const unsigned char* V8T, bf16_t* OB) {
    constexpr int SLOT8 = 64 * KST8, NK = 3, NV = 4;
    const int r32 = c.lane & 31, hi = c.lane >> 5;
    LAS char* KB = (LAS char*)c.lds; LAS char* VB = KB + NK * SLOT8;
    const LAS char* Klane = KB + r32 * KST8 + hi * 32;
    const LAS char* Vlane = VB + r32 * KST8 + hi * 32;
    i32x8 ones8 = {0x38383838, 0x38383838, 0x38383838, 0x38383838, 0x38383838, 0x38383838, 0x38383838, 0x38383838};
    asm volatile("" : "+v"(ones8));
    const bool kld = c.wave < 4;
    const int pr = (c.tid & 255) >> 2, pc4 = (c.tid & 3) * 16, ldp = pr * KST8 + pc4;
    for (int L = c.bid; L < 4096; L += c.G) {
        int s, kh, qblk;
        if (L < 2048) { s = L >> 8; kh = (L >> 6) & 3; qblk = L & 63; } else { const int u = L - 2048; s = 8 + (u >> 9); kh = (u >> 7) & 3; qblk = u & 127; }
        const int S = seq_len(s); const long rb = seq_base(s);
        const int hq = kh * 4 + (c.wave >> 1), q0 = qblk * 64 + (c.wave & 1) * 32;
        i32x8 qf8;
        { const unsigned char* qp = Q8 + (rb + q0 + r32) * 1024 + hq * 64 + hi * 32; qf8 = cat8(*(const u32x4*)qp, *(const u32x4*)(qp + 16)); }
        const unsigned char* src = kld ? K8 + (rb + pr) * 256 + kh * 64 + pc4 : V8T + rb * 256 + (long)(kh * 64 + pr) * S + pc4;
        const long tstep = kld ? 64l * 256 : 64l;
        const int NT = S >> 6;
#define A_LOAD(tile) do { preg = *(const u32x4*)(src + (long)(tile) * tstep); } while (0)
#define A_STORE(tile) do { if (kld) *(LAS u32x4*)(KB + ((tile) % NK) * SLOT8 + ldp) = preg; else *(LAS u32x4*)(VB + ((tile) % NV) * SLOT8 + ldp) = preg; } while (0)
        u32x4 preg;
        A_LOAD(0); A_STORE(0); A_LOAD(1); A_STORE(1); A_LOAD(2);
        __syncthreads();
        f32x16 O0 = zero16(), O1 = zero16(), Ls = zero16(), sa0, sa1, sb0, sb1;
        i32x8 p8 = {0, 0, 0, 0, 0, 0, 0, 0};
        u32x4 vl0, vh0, vl1, vh1;
        float m, msc;
#define A_KFR(kbase) const u32x4 kl0_ = *(const LAS u32x4*)(kbase), kh0_ = *(const LAS u32x4*)((kbase) + 16), kl1_ = *(const LAS u32x4*)((kbase) + 32 * KST8), kh1_ = *(const LAS u32x4*)((kbase) + 32 * KST8 + 16)
#define A_QK(S0, S1) do { __builtin_amdgcn_s_setprio(1); S0 = MFMA8(cat8(kl0_, kh0_), qf8, zero16()); S1 = MFMA8(cat8(kl1_, kh1_), qf8, zero16()); __builtin_amdgcn_s_setprio(0); } while (0)
#define A_VFR(vbase) do { vl0 = *(const LAS u32x4*)(vbase); vh0 = *(const LAS u32x4*)((vbase) + 16); vl1 = *(const LAS u32x4*)((vbase) + 32 * KST8); vh1 = *(const LAS u32x4*)((vbase) + 32 * KST8 + 16); } while (0)
#define A_EXP(S0, S1) do { \
            _Pragma("unroll") for (int r = 0; r < 16; ++r) { S0[r] = fast_exp2(S0[r]); S1[r] = fast_exp2(S1[r]); } \
            _Pragma("unroll") for (int w = 0; w < 4; ++w) { p8[w] = (int)cvt_pk4_fp8_sc((unsigned)p8[w], S0[4 * w], S0[4 * w + 1], S0[4 * w + 2], S0[4 * w + 3], msc); \
                                                            p8[4 + w] = (int)cvt_pk4_fp8_sc((unsigned)p8[4 + w], S1[4 * w], S1[4 * w + 1], S1[4 * w + 2], S1[4 * w + 3], msc); } } while (0)
#define A_PV() do { __builtin_amdgcn_s_setprio(1); O0 = MFMA8(cat8(vl0, vh0), p8, O0); O1 = MFMA8(cat8(vl1, vh1), p8, O1); Ls = MFMA8(ones8, p8, Ls); __builtin_amdgcn_s_setprio(0); } while (0)
#define A_TAIL(t_) do { A_STORE((t_) + 2); asm volatile("" ::: "memory"); A_VFR(Vlane + ((t_) % NV) * SLOT8); asm volatile("s_waitcnt lgkmcnt(4)\n\ts_barrier" ::: "memory"); } while (0)
        { A_KFR(Klane); A_QK(sa0, sa1); }
        { const float mx = rowmax32x(sa0, sa1); m = __builtin_floorf(mx) - A8_TGT; msc = __int_as_float(((int)m + 127) << 23); }
        { A_KFR(Klane + SLOT8); A_EXP(sa0, sa1); A_QK(sb0, sb1); }
        A_TAIL(0);
#define A_BLOCK(t_, SI0, SI1, SO0, SO1) do { \
            { const int tl_ = (t_) + 2 < NT ? (t_) + 2 : NT - 1; A_LOAD(tl_); } \
            A_KFR(Klane + (((t_) + 1) % NK) * SLOT8); \
            A_PV(); \
            const float mx = rowmax32x(SI0, SI1); \
            if (__any(mx - m > A8_HI)) { \
                const float mn = __builtin_fmaxf(__builtin_floorf(mx) - A8_TGT, m), al = fast_exp2(m - mn); m = mn; msc = __int_as_float(((int)m + 127) << 23); \
                _Pragma("unroll") for (int r = 0; r < 16; ++r) { O0[r] *= al; O1[r] *= al; Ls[r] *= al; } } \
            A_EXP(SI0, SI1); \
            A_QK(SO0, SO1); \
            A_TAIL(t_); } while (0)
        for (int t = 1; t + 1 < NT; t += 2) { A_BLOCK(t, sb0, sb1, sa0, sa1); A_BLOCK(t + 1, sa0, sa1, sb0, sb1); }
        A_BLOCK(NT - 1, sb0, sb1, sa0, sa1);
        A_PV();
#undef A_KFR
#undef A_QK
#undef A_VFR
#undef A_EXP
#undef A_PV
#undef A_TAIL
#undef A_BLOCK
#undef A_LOAD
#undef A_STORE
        const float inv = fast_rcp(Ls[0]) * 64.0f;
        unsigned char* op = (unsigned char*)OB + (rb + q0 + r32) * DM + hq * 64 + 4 * hi;
#pragma unroll
        for (int j = 0; j < 4; ++j) {
            *(unsigned*)(op + 8 * j) = cvt_pk4_fp8(O0[4 * j] * inv, O0[4 * j + 1] * inv, O0[4 * j + 2] * inv, O0[4 * j + 3] * inv);
            *(unsigned*)(op + 32 + 8 * j) = cvt_pk4_fp8(O1[4 * j] * inv, O1[4 * j + 1] * inv, O1[4 * j + 2] * inv, O1[4 * j + 3] * inv); }
        __syncthreads();
    }
}

DI int t5_bucket(int rel) {
    const int n = rel < 0 ? -rel : rel;
    int large = 8 + (int)(logf((float)(n < 1 ? 1 : n) / 8.0f) / 2.772588722239781f * 8.0f);
    large = large < 15 ? large : 15;
    return (rel > 0 ? 16 : 0) + (n < 8 ? n : large);
}
DI void attn_d_phase(const Ctx& c, const bf16_t* QKV, bf16_t* OB, const float* rel_bias, const float* dlam, const float* ngain, float lambda_init) {
    constexpr int LQ = 2304, SLOT = 64 * KST;
    const int r32 = c.lane & 31, hi = c.lane >> 5;
    LAS char* KB = (LAS char*)c.lds; LAS char* VB = KB + 2 * SLOT;
    LAS float* LUT = (LAS float*)(c.lds + 4 * SLOT);
    for (int i = c.tid; i < 12 * 256; i += 512) { const int h = i >> 8, e = i & 255; const int rel = (e < 255 ? e : 254) - 127; LUT[i] = rel_bias[t5_bucket(rel) * 12 + h] * LOG2E; }
    float lam;
    { const int i = c.lane & 31; const float a = wave_sum(c.lane < 32 ? dlam[i] * dlam[32 + i] : 0.f), b = wave_sum(c.lane < 32 ? dlam[64 + i] * dlam[96 + i] : 0.f);
      lam = __expf(a) - __expf(b) + lambda_init; }
    const LAS char* Klane = KB + r32 * KST + hi * 16;
    const LAS char* Vlane = VB + (4 * hi + ((c.lane & 15) >> 2)) * KST + 32 * ((c.lane >> 4) & 1) + 8 * (c.lane & 3);
    bf16x8 kx;
    { u32x4 w; w.x = hi == 0 ? 0x3F803F80u : 0u; w.y = 0u; w.z = 0u; w.w = 0u; kx = __builtin_bit_cast(bf16x8, w); }
    __syncthreads();
    for (int L = c.bid; L < 3072; L += c.G) {
        int s, h, qblk;
        if (L < 1536) { s = L / 192; const int r = L % 192; h = r >> 4; qblk = r & 15; } else { const int u = L - 1536; s = 8 + u / 384; const int r = u % 384; h = r >> 5; qblk = r & 31; }
        const int S = seq_len(s); const long rb = seq_base(s);
        const int q0 = qblk * 256 + c.wave * 32;
        bf16x8 qf[2][2];
        { const bf16_t* qp = QKV + (rb + q0 + r32) * LQ + h * 64 + hi * 8;
#pragma unroll
          for (int mm = 0; mm < 2; ++mm)
#pragma unroll
              for (int ks = 0; ks < 2; ++ks) qf[mm][ks] = *(const bf16x8*)(qp + mm * 32 + ks * 16); }
        const bf16_t* kg = QKV + (rb + (c.tid >> 3)) * LQ + 768 + h * 64 + (c.tid & 7) * 8;
        const int ldst = (c.tid >> 3) * KST + (c.tid & 7) * 16;
        u32x4 kr = *(const u32x4*)kg, vr = *(const u32x4*)(kg + 768);
        *(LAS u32x4*)(KB + ldst) = kr; *(LAS u32x4*)(VB + ldst) = vr;
        asm volatile("" :: "v"(qf[0][0]), "v"(qf[0][1]), "v"(qf[1][0]), "v"(qf[1][1]));
        __syncthreads();
        f32x16 Oa0 = zero16(), Oa1 = zero16(), Ob0 = zero16(), Ob1 = zero16();
        const LAS float* lut = LUT + h * 256;
        const float bneg = lut[0], bpos = lut[254];
        bf16x8 qxa, qxb; float ra = make_qx(-100.f, hi, qxa), rbb = make_qx(-100.f, hi, qxb), la = 0.f, lb = 0.f, boff = 0.f;
        const int NT = S >> 6;
        for (int t = 0; t < NT; ++t) {
            const int buf = t & 1;
            if (t + 1 < NT) { const bf16_t* kn = kg + (long)(t + 1) * 64 * LQ; kr = *(const u32x4*)kn; vr = *(const u32x4*)(kn + 768); }
            const LAS char* Kt = Klane + buf * SLOT; const LAS char* Vt = Vlane + buf * SLOT;
            const int k0 = t * 64, dmin = k0 - (q0 + 31), dmax = k0 + 63 - q0;
            const bool near = (dmax > -127) && (dmin < 127);
            const float bnew = near ? 0.f : (dmax <= -127 ? bneg : bpos);
            if (bnew != boff) { ra = make_qx(ra + boff - bnew, hi, qxa); rbb = make_qx(rbb + boff - bnew, hi, qxb); boff = bnew; }
            bf16x8 pa[4], pb[4];
#define D_BRANCH(KOFF, QF, QX, RR, LL, O0_, O1_, PP) do { \
                f32x16 s0 = MFMA32(kx, QX, zero16()), s1 = MFMA32(kx, QX, zero16()); \
                _Pragma("unroll") for (int ks = 0; ks < 2; ++ks) { \
                    const bf16x8 k0_ = *(const LAS bf16x8*)(Kt + (KOFF) + ks * 32), k1_ = *(const LAS bf16x8*)(Kt + 32 * KST + (KOFF) + ks * 32); \
                    s0 = MFMA32(k0_, QF[ks], s0); s1 = MFMA32(k1_, QF[ks], s1); } \
                if (near) { int relb = k0 + 4 * hi - (q0 + r32); asm volatile("" : "+v"(relb)); \
                    _Pragma("unroll") for (int r = 0; r < 16; ++r) { int rel = relb + (r & 3) + 8 * (r >> 2); int r1 = rel + 32; \
                        rel = rel < -127 ? -127 : (rel > 127 ? 127 : rel); r1 = r1 < -127 ? -127 : (r1 > 127 ? 127 : r1); s0[r] += lut[rel + 127]; s1[r] += lut[r1 + 127]; \
                        if ((r & 3) == 3) __builtin_amdgcn_sched_barrier(0); } } \
                const float mx = rowmax32x(s0, s1); \
                if (__any(mx > ATT_THR)) { \
                    const float ro = RR; RR = make_qx(RR + __builtin_fmaxf(mx, 0.f), hi, QX); const float d = RR - ro, al = fast_exp2(-d); LL *= al; \
                    _Pragma("unroll") for (int r = 0; r < 16; ++r) { s0[r] -= d; s1[r] -= d; O0_[r] *= al; O1_[r] *= al; } } \
                exp_pack_x(s0, s1, PP); { const f32x16 t_ = s0 + s1; LL += sum16(t_); } } while (0)
            D_BRANCH(0, qf[0], qxa, ra, la, Oa0, Oa1, pa);
            D_BRANCH(64, qf[1], qxb, rbb, lb, Ob0, Ob1, pb);
#undef D_BRANCH
#pragma unroll
            for (int ks = 0; ks < 4; ++ks) {
                const LAS char* r0 = Vt + 16 * ks * KST;
                const s16x4 x0 = vtr(r0), x1 = vtr(r0 + 8 * KST), y0 = vtr(r0 + 64), y1 = vtr(r0 + 8 * KST + 64);
                const bf16x8 v0 = __builtin_shufflevector(x0, x1, 0, 1, 2, 3, 4, 5, 6, 7), v1 = __builtin_shufflevector(y0, y1, 0, 1, 2, 3, 4, 5, 6, 7);
                Oa0 = MFMA32(v0, pa[ks], Oa0); Oa1 = MFMA32(v1, pa[ks], Oa1); Ob0 = MFMA32(v0, pb[ks], Ob0); Ob1 = MFMA32(v1, pb[ks], Ob1);
            }
            if (t + 1 < NT) { *(LAS u32x4*)(KB + (buf ^ 1) * SLOT + ldst) = kr; *(LAS u32x4*)(VB + (buf ^ 1) * SLOT + ldst) = vr; }
            __syncthreads();
        }
        la += __shfl_xor(la, 32); lb += __shfl_xor(lb, 32);
        const float ia = fast_rcp(la), ib = lam * fast_rcp(lb);
        float ss = 0.f;
#pragma unroll
        for (int r = 0; r < 16; ++r) { Oa0[r] = Oa0[r] * ia - Ob0[r] * ib; Oa1[r] = Oa1[r] * ia - Ob1[r] * ib; ss += Oa0[r] * Oa0[r] + Oa1[r] * Oa1[r]; }
        ss += __shfl_xor(ss, 32);
        const float rn = rsqrtf(ss * (1.0f / 64.0f) + 1e-6f) * (1.0f - lambda_init);
        bf16_t* op = OB + (rb + q0 + r32) * 768 + h * 64 + 4 * hi;
#pragma unroll
        for (int j = 0; j < 4; ++j) {
            const f32x4 g0 = *(const f32x4*)(ngain + 8 * j + 4 * hi), g1 = *(const f32x4*)(ngain + 32 + 8 * j + 4 * hi);
            u32x2 w0, w1;
            w0.x = cvt_pk_bf16(Oa0[4 * j] * rn * g0[0], Oa0[4 * j + 1] * rn * g0[1]); w0.y = cvt_pk_bf16(Oa0[4 * j + 2] * rn * g0[2], Oa0[4 * j + 3] * rn * g0[3]);
            w1.x = cvt_pk_bf16(Oa1[4 * j] * rn * g1[0], Oa1[4 * j + 1] * rn * g1[1]); w1.y = cvt_pk_bf16(Oa1[4 * j + 2] * rn * g1[2], Oa1[4 * j + 3] * rn * g1[3]);
            *(u32x2*)(op + 8 * j) = w0; *(u32x2*)(op + 32 + 8 * j) = w1; }
    }
    __syncthreads();
}

DI void attn_b_phase(const Ctx& c, const bf16_t* QKV, bf16_t* OB, const float* rel_bias) {
    constexpr int LQ = 2304;
    const int r32 = c.lane & 31, hi = c.lane >> 5;
    LAS float* LUT = (LAS float*)c.lds;
    LAS char* Vw = (LAS char*)c.lds + 8192 + c.wave * (32 * KST);
    for (int i = c.tid; i < 12 * 132; i += 512) { const int gh = i / 132, jj = i % 132; const int g = gh >> 2, d = g == 0 ? 1 : (g == 1 ? 4 : 16);
        LUT[i] = jj <= 128 ? rel_bias[t5_bucket(d * (jj - 64)) * 12 + gh] * LOG2E : 0.f; }
    __syncthreads();
    for (int L = c.bid; L < 1024; L += c.G) {
        int s, rem;
        if (L < 512) { s = L >> 6; rem = L & 63; } else { s = 8 + ((L - 512) >> 7); rem = (L - 512) & 127; }
        const int S = seq_len(s); const long rb = seq_base(s);
        const int hh = rem & 3, rhalf = (rem >> 2) & 1, blk = rem >> 3;
        const int t0 = blk * 512 + rhalf * 8 + c.wave;
        const int qpos = t0 + 16 * r32;
        f32x16 O[3][2]; float mg[3], lg[3];
#pragma unroll
        for (int g = 0; g < 3; ++g) {
            const int d = g == 0 ? 1 : (g == 1 ? 4 : 16), dsh = g == 0 ? 0 : (g == 1 ? 2 : 4), ntile = g == 0 ? 20 : (g == 1 ? 8 : 5);
            const int head = g * 4 + hh;
            bf16x8 qf[4];
            { const bf16_t* qp = QKV + (rb + qpos) * LQ + head * 64 + hi * 8;
#pragma unroll
              for (int ks = 0; ks < 4; ++ks) qf[ks] = *(const bf16x8*)(qp + ks * 16); }
            const LAS float* lut = LUT + (g * 4 + hh) * 132;
            f32x16 O0 = zero16(), O1 = zero16(); float m = -INFINITY, l = 0.f;
            const int kbase = t0 - 64 * d;
#pragma unroll 1
            for (int j = 0; j < ntile; ++j) {
                int kp = kbase + d * (32 * j + r32); kp = kp < 0 ? 0 : (kp >= S ? S - 1 : kp);
                const bf16_t* kr = QKV + (rb + kp) * LQ + 768 + head * 64 + hi * 8;
                bf16x8 kf[4];
#pragma unroll
                for (int ks = 0; ks < 4; ++ks) kf[ks] = *(const bf16x8*)(kr + ks * 16);
                u32x4 vv[4];
#pragma unroll
                for (int i = 0; i < 4; ++i) { const int id = c.lane + 64 * i, e = id >> 3; int vp = kbase + d * (32 * j + e); vp = vp < 0 ? 0 : (vp >= S ? S - 1 : vp);
                    vv[i] = *(const u32x4*)(QKV + (rb + vp) * LQ + 1536 + head * 64 + (id & 7) * 8); }
                f32x16 sc = zero16();
#pragma unroll
                for (int ks = 0; ks < 4; ++ks) sc = MFMA32(kf[ks], qf[ks], sc);
                float mx = -INFINITY;
                if ((kbase + d * 32 * j >= 0) && (kbase + d * (32 * j + 31) < S)) {
                    const int JB = 32 * j + 4 * hi - (16 >> dsh) * r32;
#pragma unroll
                    for (int r = 0; r < 16; ++r) {
                        const int jj = JB + (r & 3) + 8 * (r >> 2);
                        const bool ok = (unsigned)jj <= 128u;
                        const float bv = lut[ok ? jj : 0];
                        sc[r] = ok ? sc[r] * (0.125f * LOG2E) + bv : -INFINITY;
                        mx = fmaxf(mx, sc[r]);
                    }
                } else {
#pragma unroll
                for (int r = 0; r < 16; ++r) {
                    const int e = (r & 3) + 8 * (r >> 2) + 4 * hi;
                    const int kpos = kbase + d * (32 * j + e), rel = kpos - qpos;
                    const int jj = (rel >> dsh) + 64;
                    const bool ok = (jj >= 0) && (jj <= 128) && (kpos >= 0) && (kpos < S);
                    const float bv = lut[ok ? jj : 0];
                    sc[r] = ok ? sc[r] * (0.125f * LOG2E) + bv : -INFINITY;
                    mx = fmaxf(mx, sc[r]);
                }
                }
                { const auto rr = __builtin_amdgcn_permlane32_swap(__float_as_uint(mx), __float_as_uint(mx), false, false); mx = fmaxf(__uint_as_float(rr[0]), __uint_as_float(rr[1])); }
                const float mn = fmaxf(m, mx), msafe = (mn == -INFINITY) ? 0.f : mn, alpha = fast_exp2(m - msafe);
                m = mn;
#pragma unroll
                for (int r = 0; r < 16; ++r) sc[r] = fast_exp2(sc[r] - msafe);
                l = l * alpha + sum16(sc);
                O0 = O0 * alpha; O1 = O1 * alpha;
#pragma unroll
                for (int i = 0; i < 4; ++i) { const int id = c.lane + 64 * i; *(LAS u32x4*)(Vw + (id >> 3) * KST + (id & 7) * 16) = vv[i]; }
                asm volatile("s_waitcnt lgkmcnt(0)" ::: "memory");
                pv_block(Vw, sc, O0, O1, c.lane);
                asm volatile("s_waitcnt lgkmcnt(0)" ::: "memory");
            }
            l += __shfl_xor(l, 32);
            O[g][0] = O0; O[g][1] = O1; mg[g] = m; lg[g] = l;
        }
        const float M = fmaxf(fmaxf(mg[0], mg[1]), mg[2]);
        const float e0 = fast_exp2(mg[0] - M), e1 = fast_exp2(mg[1] - M), e2 = fast_exp2(mg[2] - M);
        const float inv = fast_rcp(lg[0] * e0 + lg[1] * e1 + lg[2] * e2);
        const float wg[3] = {e0 * inv, e1 * inv, e2 * inv};
#pragma unroll
        for (int g = 0; g < 3; ++g) {
            bf16_t* op = OB + (rb + qpos) * 768 + (g * 4 + hh) * 64 + 4 * hi;
#pragma unroll
            for (int j = 0; j < 4; ++j) {
                u32x2 w0, w1;
                w0.x = cvt_pk_bf16(O[g][0][4 * j] * wg[g], O[g][0][4 * j + 1] * wg[g]); w0.y = cvt_pk_bf16(O[g][0][4 * j + 2] * wg[g], O[g][0][4 * j + 3] * wg[g]);
                w1.x = cvt_pk_bf16(O[g][1][4 * j] * wg[g], O[g][1][4 * j + 1] * wg[g]); w1.y = cvt_pk_bf16(O[g][1][4 * j + 2] * wg[g], O[g][1][4 * j + 3] * wg[g]);
                *(u32x2*)(op + 8 * j) = w0; *(u32x2*)(op + 32 + 8 * j) = w1; }
        }
    }
    __syncthreads();
}
DI void s5_tables(const Ctx& c, const float* lam_re, const float* lam_im, const float* log_dt, const float* b_re, const float* b_im, const float* c_re, const float* c_im,
                  bf16_t* Mt, bf16_t* Pt, float* APL, float* KKG) {
    LAS float* AP = (LAS float*)c.lds;
    LAS float* BB = AP + 2 * 33 * 64 * 2;
    LAS float* CC = BB + 2 * 64 * 16 * 2;
    for (int item = c.bid; item < 256; item += c.G) {
        const int g = item >> 2, qt = item & 3;
        if (c.tid < 128) {
            const int dir = c.tid >> 6, p = c.tid & 63;
            const float lr = lam_re[(dir * 64 + g) * 64 + p], li = lam_im[(dir * 64 + g) * 64 + p];
            const float dt = expf(log_dt[dir * 64 + g]);
            const float mag = expf(lr * dt);
            const float th = li * dt;
            float sn_, cs_; sincosf(th, &sn_, &cs_); const float ar = mag * cs_, ai = mag * sn_;
            const float den = lr * lr + li * li;
            const float zr = ((ar - 1.0f) * lr + ai * li) / den, zi = (ai * lr - (ar - 1.0f) * li) / den;
            double pr = 1.0, pi = 0.0;
            for (int t = 0; t <= 32; ++t) { AP[((dir * 33 + t) * 64 + p) * 2] = (float)pr; AP[((dir * 33 + t) * 64 + p) * 2 + 1] = (float)pi;
                const double nr = pr * (double)ar - pi * (double)ai, ni = pr * (double)ai + pi * (double)ar; pr = nr; pi = ni; }
            for (int j = 0; j < 16; ++j) { const float br = b_re[((dir * 64 + g) * 64 + p) * 16 + j], bi = b_im[((dir * 64 + g) * 64 + p) * 16 + j];
                BB[((dir * 64 + p) * 16 + j) * 2] = zr * br - zi * bi; BB[((dir * 64 + p) * 16 + j) * 2 + 1] = zr * bi + zi * br; }
        }
        for (int i = c.tid; i < 2 * 16 * 64; i += 512) { const int dir = i >> 10, r = i & 1023;
            CC[i * 2] = c_re[(dir * 64 + g) * 1024 + r]; CC[i * 2 + 1] = c_im[(dir * 64 + g) * 1024 + r]; }
        __syncthreads();
        if (qt == 0 && c.tid < 128) { const int dir = c.tid >> 6, p = c.tid & 63; APL[((g * 2 + dir) * 64 + p) * 2] = AP[((dir * 33 + 32) * 64 + p) * 2]; APL[((g * 2 + dir) * 64 + p) * 2 + 1] = AP[((dir * 33 + 32) * 64 + p) * 2 + 1]; }
        if (c.tid < 256) {
            const int dir = c.tid >> 7, tau = 8 * qt + ((c.tid >> 4) & 7), j = c.tid & 15;
            float acc[16];
#pragma unroll
            for (int jp = 0; jp < 16; ++jp) acc[jp] = 0.f;
            for (int p = 0; p < 64; ++p) {
                const f32x2 cc = *(const LAS f32x2*)(CC + ((dir * 16 + j) * 64 + p) * 2), ee = *(const LAS f32x2*)(AP + ((dir * 33 + tau) * 64 + p) * 2);
                const float wr = cc.x * ee.x - cc.y * ee.y, wi = cc.x * ee.y + cc.y * ee.x;
                const LAS f32x4* bb = (const LAS f32x4*)(BB + (dir * 64 + p) * 32);
#pragma unroll
                for (int q4 = 0; q4 < 8; ++q4) { const f32x4 b = bb[q4]; acc[2 * q4] += wr * b[0] - wi * b[1]; acc[2 * q4 + 1] += wr * b[2] - wi * b[3]; }
            }
            float* kk = KKG + ((size_t)g * 2 + dir) * 8192 + (tau * 16 + j) * 16;
#pragma unroll
            for (int q4 = 0; q4 < 4; ++q4) *(f32x4*)(kk + 4 * q4) = (f32x4){acc[4 * q4], acc[4 * q4 + 1], acc[4 * q4 + 2], acc[4 * q4 + 3]};
        }
        bf16_t* mt = Mt + (long)g * 512 * 768;
        for (int o = c.tid; o < 128 * 128; o += 512) {
            const int n = 128 * qt + (o >> 7), k = 512 + (o & 127) * 2, i = n >> 4, j = n & 15;
            float v[2];
#pragma unroll
            for (int e = 0; e < 2; ++e) { const int q = k + e - 512, dir = q >> 7, part = (q >> 6) & 1, p = q & 63, pw = dir == 0 ? i + 1 : 32 - i;
                const float cr = CC[((dir * 16 + j) * 64 + p) * 2], ci = CC[((dir * 16 + j) * 64 + p) * 2 + 1];
                const float er = AP[((dir * 33 + pw) * 64 + p) * 2], ei = AP[((dir * 33 + pw) * 64 + p) * 2 + 1];
                v[e] = part == 0 ? (cr * er - ci * ei) : -(cr * ei + ci * er); }
            *(unsigned*)(mt + (long)n * 768 + k) = cvt_pk_bf16(v[0], v[1]);
        }
        bf16_t* pt = Pt + (long)g * 256 * 512;
        for (int o = c.tid; o < 64 * 256; o += 512) {
            const int q = 64 * qt + (o >> 8), k = (o & 255) * 2, dir = q >> 7, part = (q >> 6) & 1, p = q & 63;
            float v[2];
#pragma unroll
            for (int e = 0; e < 2; ++e) { const int kk = k + e, s = kk >> 4, jp = kk & 15, pw = dir == 0 ? 31 - s : s;
                const float er = AP[((dir * 33 + pw) * 64 + p) * 2], ei = AP[((dir * 33 + pw) * 64 + p) * 2 + 1];
                const float br = BB[((dir * 64 + p) * 16 + jp) * 2], bi = BB[((dir * 64 + p) * 16 + jp) * 2 + 1];
                v[e] = part == 0 ? (er * br - ei * bi) : (er * bi + ei * br); }
            *(unsigned*)(pt + (long)q * 512 + k) = cvt_pk_bf16(v[0], v[1]);
        }
        __syncthreads();
    }
}
DI void s5_fill(const Ctx& c, const float* KKG, bf16_t* Mt) {
    LAS float* KK = (LAS float*)c.lds;
    for (int item = c.bid; item < 256; item += c.G) {
        const int g = item >> 2, qt = item & 3;
        for (int i = c.tid; i < 4096; i += 512) *(LAS f32x4*)(KK + 4 * i) = *(const f32x4*)(KKG + (size_t)g * 16384 + 4 * i);
        __syncthreads();
        bf16_t* mt = Mt + (long)g * 512 * 768;
        for (int o = c.tid; o < 128 * 256; o += 512) {
            const int n = 128 * qt + (o >> 8), k = (o & 255) * 2, i = n >> 4, j = n & 15;
            float v[2];
#pragma unroll
            for (int e = 0; e < 2; ++e) { const int kk = k + e, s = kk >> 4, jp = kk & 15; float x = 0.f;
                if (s <= i) x += KK[((i - s) * 16 + j) * 16 + jp];
                if (s >= i) x += KK[8192 + ((s - i) * 16 + j) * 16 + jp];
                v[e] = x; }
            *(unsigned*)(mt + (long)n * 768 + k) = cvt_pk_bf16(v[0], v[1]);
        }
        __syncthreads();
    }
}
DI void s5_scan(const Ctx& c, const float* PC, const float* APL, bf16_t* UH) {
    for (int wt = c.gw; wt < NSEQ * 64 * 2; wt += c.ngw) {
        const int dir = wt & 1, g = (wt >> 1) & 63, s = wt >> 7;
        const int c0 = seq_base(s) >> 5, nch = seq_len(s) >> 5;
        const float ar = APL[((g * 2 + dir) * 64 + c.lane) * 2], ai = APL[((g * 2 + dir) * 64 + c.lane) * 2 + 1];
        float sr = 0.f, si = 0.f;
        const float* pc = PC + ((long)g * 2048) * 256 + dir * 128 + c.lane;
        bf16_t* uh = UH + ((long)g * 2048) * 768 + 512 + dir * 128 + c.lane;
        for (int cb = 0; cb < nch; cb += 16) {
            float pr[16], pi[16];
#pragma unroll
            for (int u = 0; u < 16; ++u) { const int ch = dir == 0 ? c0 + cb + u : c0 + nch - 1 - (cb + u); pr[u] = pc[(long)ch * 256]; pi[u] = pc[(long)ch * 256 + 64]; }
#pragma unroll
            for (int u = 0; u < 16; ++u) { const int ch = dir == 0 ? c0 + cb + u : c0 + nch - 1 - (cb + u);
                uh[(long)ch * 768] = (bf16_t)(cvt_pk_bf16(sr, 0.f) & 0xffffu); uh[(long)ch * 768 + 64] = (bf16_t)(cvt_pk_bf16(si, 0.f) & 0xffffu);
                const float nr = ar * sr - ai * si + pr[u], ni = ar * si + ai * sr + pi[u]; sr = nr; si = ni; }
        }
    }
}
constexpr size_t MB = 1024 * 1024;
constexpr size_t WS_CTL = 0;
constexpr int    MAX_LAUNCH = 72;
constexpr size_t CTL_BYTES = 1 * MB;
constexpr size_t WS_XB   = WS_CTL + CTL_BYTES;
constexpr size_t WS_R2   = WS_XB + 128 * MB;
constexpr size_t WS_R1   = WS_R2 + 256 * MB;
constexpr size_t WS_WMIX = WS_R1 + 288 * MB;
constexpr size_t WS_WXQ  = WS_WMIX + 8 * MB;
constexpr size_t WS_WXKV = WS_WXQ + 2 * MB;
constexpr size_t WS_WXO  = WS_WXKV + 4 * MB;
constexpr size_t WS_WGU  = WS_WXO + 2 * MB;
constexpr size_t WS_WD   = WS_WGU + 64 * MB;
constexpr size_t WS_MEMB = WS_WD + 32 * MB;
constexpr size_t WS_MEMKV= WS_MEMB + 6 * MB;
constexpr size_t WS_GT   = WS_MEMKV + 12 * MB;
constexpr size_t WS_HT   = WS_GT + 24 * MB;
constexpr size_t WS_AFFT = WS_HT + 24 * MB;
constexpr size_t WS_IDX  = WS_AFFT + 4 * MB;
constexpr size_t WS_GATE = WS_IDX + 1 * MB;
constexpr size_t WS_INV  = WS_GATE + 1 * MB;
constexpr size_t WS_S5MT = WS_INV + 4 * MB;
constexpr size_t WS_S5PT = WS_S5MT + 48 * MB;
constexpr size_t WS_S5AP = WS_S5PT + 16 * MB;
constexpr size_t WS_S5KK = WS_S5AP + 1 * MB;
constexpr size_t WS_X8   = WS_S5KK + 4 * MB;
constexpr size_t WS_END  = WS_X8 + 64 * MB;

constexpr int LDS_BYTES = 152 * 1024;
constexpr int LDS_MISC = 148 * 1024;

#define XB ((bf16_t*)(wsl + WS_XB))
#define OB ((bf16_t*)(wsl + WS_R2))
#define YE ((bf16_t*)(wsl + WS_R2))
#define PC ((float*)(wsl + WS_R2 + 128 * MB))
#define QKV ((bf16_t*)(wsl + WS_R1))
#define HB ((bf16_t*)(wsl + WS_R1))
#define UH ((bf16_t*)(wsl + WS_R1))
#define WMIX ((bf16_t*)(wsl + WS_WMIX))
#define WXQ ((bf16_t*)(wsl + WS_WXQ))
#define WXKV ((bf16_t*)(wsl + WS_WXKV))
#define WXO ((bf16_t*)(wsl + WS_WXO))
#define WGU ((bf16_t*)(wsl + WS_WGU))
#define WD ((bf16_t*)(wsl + WS_WD))
#define MEMB ((bf16_t*)(wsl + WS_MEMB))
#define MEMKV ((bf16_t*)(wsl + WS_MEMKV))
#define GT ((bf16_t*)(wsl + WS_GT))
#define HT ((bf16_t*)(wsl + WS_HT))
#define AFFT ((float*)(wsl + WS_AFFT))
#define IDX ((int*)(wsl + WS_IDX))
#define GATE ((float*)(wsl + WS_GATE))
#define INV ((int*)(wsl + WS_INV))
#define S5MT ((bf16_t*)(wsl + WS_S5MT))
#define S5PT ((bf16_t*)(wsl + WS_S5PT))
#define S5AP ((float*)(wsl + WS_S5AP))
#define S5KK ((float*)(wsl + WS_S5KK))
#define WMIX2 (WMIX + 2304 * 1024)
#define AQ8 ((unsigned char*)(wsl + WS_R2 + 128 * MB))
#define AK8 ((unsigned char*)(wsl + WS_R2 + 192 * MB))
#define AV8T ((unsigned char*)(wsl + WS_R2 + 208 * MB))
#define X8 ((bf16_t*)(wsl + WS_X8))
#define HSUB ((bf16_t*)(wsl + WS_R1))
DI const float* inp_ld(int k) { unsigned a = (unsigned)(148 * 1024 + 64 + 8 * k); asm volatile("" : "+v"(a));
    const LAS unsigned* t = (const LAS unsigned*)a; const unsigned lo = __builtin_amdgcn_readfirstlane(t[0]), hi = __builtin_amdgcn_readfirstlane(t[1]);
    return (const float*)(const __attribute__((address_space(1))) float*)(((unsigned long long)hi << 32) | lo); }
#define INP(k) inp_ld(k)
struct Params { const float* in[33]; float* out; unsigned char* ws; int ph_lo, ph_hi, li, pad; };

#define IN(k) (lo <= (k) && (k) < hi)
#define SEAM(k) do { if ((k) + 1 < hi) xcd_barrier(bar); } while (0)
#define RELANE() do { int t_ = threadIdx.x; asm volatile("" : "+v"(t_)); c.tid = t_; c.lane = t_ & 63; \
        int g_ = c.G, b_ = c.bid, w_ = c.wave; asm volatile("" : "+s"(g_), "+s"(b_), "+s"(w_)); c.G = g_; c.bid = b_; c.wave = w_; c.gw = b_ * 8 + w_; c.ngw = g_ * 8; } while (0)
template <int li>
DI void layer_body(Ctx& c, LAS unsigned char* lds, unsigned char* ws, float* XF, const XcdBarrier& bar, const int lo0, const int hi0) {
        const int pb = 1 + li * 16;
        int lo = lo0, hi = hi0; asm volatile("" : "+s"(lo), "+s"(hi));
        unsigned char* wsl; { unsigned long long w_ = (unsigned long long)ws; asm volatile("" : "+s"(w_)); wsl = (unsigned char*)(__attribute__((address_space(1))) unsigned char*)w_; }
        const float* lng = INP(5) + (size_t)li * 3 * DM; const float* lnb = INP(6) + (size_t)li * 3 * DM;
        if (IN(pb + 0)) { RELANE();
            TJob j0, j1;
            if (li == 0) { j0 = tjob(INP(7), 1024, 1536, 1536, WMIX, 1024, 0, 3); j1 = tjob(INP(10), 1024, 1024, 1024, WMIX2, 1024, 0, 2); }
            else if (li == 1) { j0 = tjob(INP(11), 1024, 2304, 2304, WMIX, 1024, 0, 3); j1 = tjob(INP(12), 768, 1024, 1024, WMIX2, 768, 0); }
            else if (li == 2) { j0 = tjob(INP(21), 1024, 1024, 2048, WMIX, 1024, 1); j1 = tjob(INP(21) + 1024, 1024, 1024, 2048, WMIX, 1024, 2); }
            else { j0 = tjob(INP(22), 1024, 2304, 2304, WMIX, 1024, 0, 1); j1 = tjob(INP(25), 768, 1024, 1024, WMIX2, 768, 0); }
            const TJob j2 = tjob(INP(27) + (size_t)li * 1024 * 2048, 1024, 2048, 2048, WXKV, 1024, 0), j3 = tjob(INP(28) + (size_t)li * 1024 * 1024, 1024, 1024, 1024, WXO, 1024, 0);
            convert_layer_weights(c, j0, j1, j2, j3, INP(30) + (size_t)li * 16 * 1024 * 1024, INP(31) + (size_t)li * 16 * 1024 * 1024, INP(32) + (size_t)li * 16 * 1024 * 1024, WGU, WD);
            cvt_copy_bf16(c, INP(26) + (size_t)li * 1024 * 1024, WXQ, 1024 * 1024);
            __syncthreads();
            if (li == 2) s5_tables(c, INP(13), INP(14), INP(15), INP(16), INP(17), INP(18), INP(19), S5MT, S5PT, S5AP, S5KK);
            SEAM(pb + 0);
        }
        if (IN(pb + 1)) { RELANE();
            pg8::Sched S = pg8::make_sched_(c.G, c.bid, MEMB, 2048, WXKV, 2048, 12, 8);
            pg8::EpiBf16 E{MEMKV, 0, 0, 2048, nullptr, 0, 0, 0, 1.0f};
            pg8::gemm_phase<pg8::EpiBf16, false>(lds, S, E, 1024, c.tid);
            if (li == 2) s5_fill(c, S5KK, S5MT);
        }
        if (li == 0) {
            if (IN(pb + 3)) { RELANE(); pg8::Sched S = pg8::make_sched_(c.G, c.bid, X8, 1024, WMIX, 1024, 256, 6); pg8::EpiBf16 E{QKV, 0, 0, 1536, nullptr, 0, 0, 0, 1.0f};
                pg8::gemm_phase<pg8::EpiBf16, false, 2>(lds, S, E, 512, c.tid); SEAM(pb + 3); }
            if (IN(pb + 4)) { RELANE(); prep_a(c, QKV, INP(8), INP(9), AQ8, AK8, AV8T); SEAM(pb + 4); }
            if (IN(pb + 5)) { RELANE(); attn_a_phase(c, AQ8, AK8, AV8T, OB); SEAM(pb + 5); }
            if (IN(pb + 6)) { RELANE(); pg8::Sched S = pg8::make_sched_(c.G, c.bid, OB, 1024, WMIX2, 1024, 256, 4); pg8::EpiF8 E{(unsigned char*)HSUB, 0, 0, 1024, 64.0f};
                pg8::gemm_phase<pg8::EpiF8, false, 2>(lds, S, E, 512, c.tid); SEAM(pb + 6); }
        } else if (li == 1) {
            if (IN(pb + 3)) { RELANE(); pg8::Sched S = pg8::make_sched_(c.G, c.bid, X8, 1024, WMIX, 1024, 256, 9); pg8::EpiBf16 E{QKV, 0, 0, 2304, nullptr, 0, 0, 0, 1.0f};
                pg8::gemm_phase<pg8::EpiBf16, false, 2>(lds, S, E, 512, c.tid); SEAM(pb + 3); }
            if (IN(pb + 5)) { RELANE(); attn_b_phase(c, QKV, OB, INP(4)); SEAM(pb + 5); }
            if (IN(pb + 6)) { RELANE(); pg8::Sched S = pg8::make_sched_(c.G, c.bid, OB, 1536, WMIX2, 1536, 256, 4); pg8::EpiF8 E{(unsigned char*)HSUB, 0, 0, 1024, 1.0f / 64.0f};
                pg8::gemm_phase<pg8::EpiF8, false>(lds, S, E, 768, c.tid); SEAM(pb + 6); }
        } else if (li == 2) {
            if (IN(pb + 3)) { RELANE();
                pg8::Sched S = pg8::make_sched_(c.G, c.bid, UH, 1536, S5PT, 1024, 8, 1); S.total = 64 * 8; S.aS1 = 2048l * 1536; S.bS1 = 256l * 1024;
                pg8::EpiF32 E{PC, 2048l * 256, 256};
                pg8::gemm_phase<pg8::EpiF32, false>(lds, S, E, 512, c.tid); SEAM(pb + 3); }
            if (IN(pb + 4)) { RELANE(); s5_scan(c, PC, S5AP, UH); SEAM(pb + 4); }
            if (IN(pb + 5)) { RELANE();
                pg8::Sched S = pg8::make_sched_(c.G, c.bid, UH, 1536, S5MT, 1536, 8, 2); S.total = 64 * 16; S.aS1 = 2048l * 1536; S.bS1 = 512l * 1536;
                pg8::EpiS5Out E{OB, XB, INP(20)};
                pg8::gemm_phase<pg8::EpiS5Out, false>(lds, S, E, 768, c.tid); SEAM(pb + 5); }
            if (IN(pb + 6)) { RELANE(); pg8::Sched S = pg8::make_sched_(c.G, c.bid, OB, 2048, WMIX, 2048, 256, 8); pg8::EpiGluBf16 E{HSUB};
                pg8::gemm_phase<pg8::EpiGluBf16, false>(lds, S, E, 1024, c.tid); SEAM(pb + 6); }
        } else {
            if (IN(pb + 3)) { RELANE(); pg8::Sched S = pg8::make_sched_(c.G, c.bid, XB, 2048, WMIX, 2048, 256, 9); pg8::EpiBf16 E{QKV, 0, 0, 2304, nullptr, 0, 0, 768, 0.17677669529663687f * LOG2E};
                pg8::gemm_phase<pg8::EpiBf16, false, true>(lds, S, E, 1024, c.tid); SEAM(pb + 3); }
            if (IN(pb + 5)) { RELANE(); attn_d_phase(c, QKV, OB, INP(4), INP(23), INP(24), 0.8f - 0.6f * 0.4065696597405991f); SEAM(pb + 5); }
            if (IN(pb + 6)) { RELANE(); pg8::Sched S = pg8::make_sched_(c.G, c.bid, OB, 1536, WMIX2, 1536, 256, 4); pg8::EpiBf16 E{HSUB, 0, 0, 1024, nullptr, 0, 0, 0, 1.0f};
                pg8::gemm_phase<pg8::EpiBf16, false>(lds, S, E, 768, c.tid); SEAM(pb + 6); }
        }
        if (IN(pb + 2)) { RELANE();
            {
                pg8::Sched S = pg8::make_sched_(c.G, c.bid, MEMKV, 4096, WXQ, 2048, 1, 4);
                S.nb2 = 4; S.total = 12 * 4 * 4; S.aS1 = 256l * 4096; S.aS2 = 512; S.bS1 = 0; S.bS2 = 512;
                pg8::EpiF16 E{GT, 1024l * 1024, 256l * 1024, 1024, nullptr, 0, 0, 1 << 30, 0.0625f * LOG2E};
                pg8::gemm_phase<pg8::EpiF16, false>(lds, S, E, 256, c.tid);
            }
            RELANE();
            {
                pg8::Sched S = pg8::make_sched_(c.G, c.bid, WXO, 2048, MEMKV + 1024, 4096, 4, 1);
                S.nb2 = 4; S.total = 12 * 4 * 4; S.aS1 = 0; S.aS2 = 512; S.bS1 = 256l * 4096; S.bS2 = 512;
                pg8::EpiF8 E{(unsigned char*)HT, 1024l * 1024, 256, 1024, 1.0f / 16.0f};
                pg8::gemm_phase<pg8::EpiF8, false>(lds, S, E, 256, c.tid);
            }
        }
        if (IN(pb + 8)) { RELANE(); ln_phase<(li < 2 ? (8 | 64) : 8)>(c, nullptr, XB, lng, lnb, nullptr, nullptr, nullptr, nullptr, nullptr, nullptr, HSUB); SEAM(pb + 8); }
        if (IN(pb + 9)) { RELANE();
            pg8::Sched S = pg8::make_sched_(c.G, c.bid, XB, 2048, GT, 2048, 256, 4); S.cross = 1; S.bS1 = 1024l * 2048;
            pg8::EpiSoftmax256F8 E{OB};
            pg8::gemm_phase<pg8::EpiSoftmax256F8, false, true>(lds, S, E, 1024, c.tid); SEAM(pb + 9);
        }
        if (IN(pb + 10)) { RELANE();
            pg8::Sched S = pg8::make_sched_(c.G, c.bid, OB, 1024, HT, 1024, 256, 4); S.cross = 1; S.bS1 = 1024l * 1024;
            pg8::EpiF8 E{(unsigned char*)HSUB, 0, 0, 1024, 64.0f};
            pg8::gemm_phase<pg8::EpiF8, false, 2>(lds, S, E, 512, c.tid); SEAM(pb + 10);
        }
        if (IN(pb + 11)) { RELANE();
            ln_phase<10 | 64>(c, nullptr, XB, lng + DM, lnb + DM, nullptr, nullptr, INP(29) + (size_t)li * 1024 * 16, AFFT, INV, X8, HSUB);
            SEAM(pb + 11); }
        if (IN(pb + 12)) { RELANE(); topk_phase(c, AFFT, IDX, GATE, INV); SEAM(pb + 12); }
        if (IN(pb + 13)) { RELANE();
            pg8::Sched S = pg8::make_sched_(c.G, c.bid, X8, 1024, WGU, 1024, 16, 8);
            S.nb2 = 16; S.total = 2 * 16 * 16 * 8; S.aS1 = (long)NGRP_TOK * 1024; S.aS2 = 0; S.bS1 = 0; S.bS2 = 2048l * 1024; S.GI = IDX; S.giS1 = 16 * CAP; S.giS2 = CAP; S.gather = 1;
#if MOE_DOWN_FP8
            pg8::EpiSwiGLU8 E{HB};
            pg8::gemm_phase<pg8::EpiSwiGLU8, true, 2>(lds, S, E, 512, c.tid); SEAM(pb + 13);
#else
            pg8::EpiSwiGLU E{HB};
            pg8::gemm_phase<pg8::EpiSwiGLU, true, 2>(lds, S, E, 512, c.tid); SEAM(pb + 13);
#endif
        }
        if (IN(pb + 14)) { RELANE();
#if MOE_DOWN_FP8
            pg8::Sched S = pg8::make_sched_(c.G, c.bid, HB, 1024, WD, 1024, 16, 4);
            S.nb2 = 16; S.total = 2 * 16 * 16 * 4; S.aS1 = 16l * CAP * 1024; S.aS2 = (long)CAP * 1024; S.bS1 = 0; S.bS2 = 1024l * 1024;
            pg8::EpiF8 E{(unsigned char*)YE, 16l * CAP * 1024, (long)CAP * 1024, 1024, 8.0f};
            pg8::gemm_phase<pg8::EpiF8, false, 2>(lds, S, E, 512, c.tid); SEAM(pb + 14);
#else
            pg8::Sched S = pg8::make_sched_(c.G, c.bid, HB, 2048, WD, 2048, 16, 4);
            S.nb2 = 16; S.total = 2 * 16 * 16 * 4; S.aS1 = 16l * CAP * 2048; S.aS2 = (long)CAP * 2048; S.bS1 = 0; S.bS2 = 1024l * 2048;
            pg8::EpiBf16 E{YE, 16l * CAP * 1024, (long)CAP * 1024, 1024, GATE, 16 * CAP, CAP, 0, 1.0f};
            pg8::gemm_phase<pg8::EpiBf16, false>(lds, S, E, 1024, c.tid); SEAM(pb + 14);
#endif
        }
        if (IN(pb + 15)) { RELANE();
            const float* gsc = MOE_DOWN_FP8 ? GATE : nullptr;
            if (li == 1) ln_phase<5>(c, nullptr, XB, lng + 2 * DM, lnb + 2 * DM, YE, INV, nullptr, nullptr, nullptr, UH, nullptr, gsc);
            else if (li == 3) ln_phase<17>(c, XF, XB, lng + 2 * DM, lnb + 2 * DM, YE, INV, nullptr, nullptr, nullptr, nullptr, nullptr, gsc);
            else if (li == 0) ln_phase<33>(c, nullptr, XB, lng + 2 * DM, lnb + 2 * DM, YE, INV, nullptr, nullptr, nullptr, X8, nullptr, gsc);
            else ln_phase<1>(c, nullptr, XB, lng + 2 * DM, lnb + 2 * DM, YE, INV, nullptr, nullptr, nullptr, nullptr, nullptr, gsc);
            SEAM(pb + 15);
        }
}

__global__ void __launch_bounds__(512, 2) fwd_kernel(Params P) {
    extern __shared__ __attribute__((aligned(16))) unsigned char lds_raw[];
    LAS unsigned char* lds = (LAS unsigned char*)lds_raw;
    Ctx c; c.lds = lds; c.tid = threadIdx.x; c.lane = c.tid & 63; c.wave = __builtin_amdgcn_readfirstlane(c.tid >> 6); c.G = gridDim.x; c.bid = blockIdx.x;
    c.gw = c.bid * 8 + c.wave; c.ngw = c.G * 8;
    volatile LAS unsigned* misc = (volatile LAS unsigned*)(lds + LDS_MISC);
    if (c.tid < 4) misc[c.tid] = 0u;
    if (c.tid < 33) ((LAS unsigned long long*)(lds + LDS_MISC + 64))[c.tid] = (unsigned long long)P.in[c.tid];
    __syncthreads();
    unsigned char* ws = P.ws;
    const int lo0 = P.ph_lo, hi0 = P.ph_hi;
    XcdBarrier bar; bar.bar = (unsigned*)(ws + WS_CTL) + (size_t)P.li * XCD_BAR_WORDS; bar.x = 0; bar.st = misc;
    if (hi0 - lo0 > 1) bar = xcd_barrier_post(bar.bar, misc);
    float* XF = P.out;
    { const int lo = lo0, hi = hi0;
    if (IN(0)) {
        unsigned char* wsl = ws;
        init_x(c, INP(0), INP(1), XB, X8);
        cvt_copy_bf16(c, INP(2), MEMB, (long)2048 * DM);
        cvt_copy_bf16(c, INP(3), MEMB + (long)2048 * DM, (long)1024 * DM);
    } }
    layer_body<0>(c, lds, ws, XF, bar, lo0, hi0); layer_body<1>(c, lds, ws, XF, bar, lo0, hi0); layer_body<2>(c, lds, ws, XF, bar, lo0, hi0); layer_body<3>(c, lds, ws, XF, bar, lo0, hi0);
}

constexpr int N_PHASES = 65;
static bool phase_exists(int k) {
    if (k == 0) return true;
    const int li = (k - 1) / 16, r = (k - 1) % 16;
    if (r == 7) return false;
    if (r == 4) return li == 0 || li == 2;
    return true;
}

#ifndef MK_PER_PHASE
#define MK_PER_PHASE 0
#endif

extern "C" void kernel_launch(void* const* d_in, const int* in_sizes, int n_in, void* d_out, int out_size, void* d_ws, size_t ws_size, hipStream_t stream) {
    static int grid = 0;
    if (grid == 0) {
        if (n_in != 33 || out_size != NTOK * DM || ws_size < WS_END) { fprintf(stderr, "kernel_launch: unexpected shapes (n_in %d out %d ws %zu need %zu)\n", n_in, out_size, ws_size, (size_t)WS_END); grid = -1; return; }
        int dev = 0, cus = 0, per_cu = 0;
        if (hipGetDevice(&dev) != hipSuccess || hipDeviceGetAttribute(&cus, hipDeviceAttributeMultiprocessorCount, dev) != hipSuccess) { grid = -1; return; }
        if (hipFuncSetAttribute((const void*)fwd_kernel, hipFuncAttributeMaxDynamicSharedMemorySize, LDS_BYTES) != hipSuccess) { fprintf(stderr, "kernel_launch: hipFuncSetAttribute failed\n"); grid = -1; return; }
        if (hipOccupancyMaxActiveBlocksPerMultiprocessor(&per_cu, (const void*)fwd_kernel, 512, LDS_BYTES) != hipSuccess || per_cu < 1) { fprintf(stderr, "kernel_launch: occupancy query says %d\n", per_cu); (void)hipGetLastError(); }
        grid = cus;
    }
    if (grid < 0) return;
    (void)hipMemsetAsync((char*)d_ws + WS_CTL, 0, CTL_BYTES, stream);
    Params p{};
    for (int i = 0; i < 33; ++i) p.in[i] = (const float*)d_in[i];
    p.out = (float*)d_out; p.ws = (unsigned char*)d_ws; p.pad = 0;
#if MK_PER_PHASE
    int li = 0;
    for (int k = 0; k < N_PHASES; ++k) { if (!phase_exists(k)) continue; p.ph_lo = k; p.ph_hi = k + 1; p.li = li++;
        hipLaunchKernelGGL(fwd_kernel, dim3(grid), dim3(512), LDS_BYTES, stream, p); }
#else
    p.ph_lo = 0; p.ph_hi = N_PHASES; p.li = 0;
    hipLaunchKernelGGL(fwd_kernel, dim3(grid), dim3(512), LDS_BYTES, stream, p);
#if defined(PROBE_LO)
    p.ph_lo = PROBE_LO; p.ph_hi = PROBE_HI; p.li = 1; p.out = (float*)((unsigned char*)d_ws + WS_R2);
    hipLaunchKernelGGL(fwd_kernel, dim3(grid), dim3(512), LDS_BYTES, stream, p);
#endif
#endif
}
```
